# Optimizing an MI355X kernel written in HIP

```python
import jax, jax.numpy as jnp
from jax import lax
import numpy as np

D_MODEL = 1024
BATCH = 16
SEQ = 2048
DEPTH = 4

N_MIXERS = 2
N_MLA_LAYERS = (DEPTH + 1) // 2
N_GMLP_LAYERS = DEPTH // 2
MLA_HEADS = 8
QK_NOPE_DIM = 128
QK_ROPE_DIM = 64
V_HEAD_DIM = 128
Q_LORA_RANK = 384
KV_LORA_RANK = 256
ROPE_BASE = 10000.0
Q_BLOCK = 128
GMLP_CHUNK = 128
GMLP_HALF = 2 * D_MODEL
GMLP_GROUPS = 8
GMLP_GROUP_DIM = GMLP_HALF // GMLP_GROUPS
D_FF = 4 * D_MODEL
PLE_DIM = 256
NORM_EPS = 1e-6
MAX_POS_OFFSET = 4096

kernel_name = "hybrid_mla_chunked_gmlp_trunk"


def rms_norm(x, g):
    xf = x.astype(jnp.float32)
    y = xf * lax.rsqrt(jnp.mean(xf * xf, axis=-1, keepdims=True) + NORM_EPS)
    return (y * g.astype(jnp.float32)).astype(x.dtype)


def layer_norm(x, g, b):
    xf = x.astype(jnp.float32)
    mu = jnp.mean(xf, axis=-1, keepdims=True)
    xc = xf - mu
    y = xc * lax.rsqrt(jnp.mean(xc * xc, axis=-1, keepdims=True) + NORM_EPS)
    return (y * g.astype(jnp.float32) + b.astype(jnp.float32)).astype(x.dtype)


def rope_cos_sin(positions):
    inv_freq = ROPE_BASE ** (-(jnp.arange(0, QK_ROPE_DIM, 2, dtype=jnp.float32) / QK_ROPE_DIM))
    ang = positions.astype(jnp.float32)[..., None] * inv_freq
    return jnp.cos(ang), jnp.sin(ang)


def apply_rope(x, cos, sin):
    x1, x2 = jnp.split(x.astype(jnp.float32), 2, axis=-1)
    return jnp.concatenate([x1 * cos - x2 * sin, x2 * cos + x1 * sin], axis=-1).astype(x.dtype)


def mla_mixer(hn, cos, sin, w_down, q_lora_g, kv_lora_g, w_uq, w_ukv,
              q_nope_g, q_rope_g, k_nope_g, k_rope_g, w_out):
    B, S, _ = hn.shape
    H = MLA_HEADS
    lat = hn @ w_down
    c_q, c_kv, k_rope = jnp.split(lat, [Q_LORA_RANK, Q_LORA_RANK + KV_LORA_RANK], axis=-1)
    c_q = rms_norm(c_q, q_lora_g)
    c_kv = rms_norm(c_kv, kv_lora_g)
    q = (c_q @ w_uq).reshape(B, S, H, QK_NOPE_DIM + QK_ROPE_DIM)
    q_nope, q_rope = jnp.split(q, [QK_NOPE_DIM], axis=-1)
    kv = (c_kv @ w_ukv).reshape(B, S, H, QK_NOPE_DIM + V_HEAD_DIM)
    k_nope, v = jnp.split(kv, [QK_NOPE_DIM], axis=-1)
    q_nope = rms_norm(q_nope, q_nope_g)
    q_rope = apply_rope(rms_norm(q_rope, q_rope_g), cos[:, :, None], sin[:, :, None])
    k_nope = rms_norm(k_nope, k_nope_g)
    k_rope = apply_rope(rms_norm(k_rope, k_rope_g), cos, sin)
    scale = (QK_NOPE_DIM + QK_ROPE_DIM) ** -0.5
    outs = []
    for j in range(S // Q_BLOCK):
        q0 = j * Q_BLOCK
        kend = q0 + Q_BLOCK
        s = (jnp.einsum('bqhd,bkhd->bhqk', q_nope[:, q0:kend], k_nope[:, :kend])
             + jnp.einsum('bqhr,bkr->bhqk', q_rope[:, q0:kend], k_rope[:, :kend]))
        s = s.astype(jnp.float32) * scale
        causal = jnp.arange(kend)[None, :] <= (q0 + jnp.arange(Q_BLOCK))[:, None]
        s = jnp.where(causal, s, -jnp.inf)
        pr = jax.nn.softmax(s, axis=-1).astype(v.dtype)
        outs.append(jnp.einsum('bhqk,bkhd->bqhd', pr, v[:, :kend]))
    o = jnp.concatenate(outs, axis=1).reshape(B, S, H * V_HEAD_DIM)
    return o @ w_out


def gmlp_mixer(hn, w_in, ln_g, ln_b, w_s, b_s, w_out):
    B, S, _ = hn.shape
    z = jax.nn.gelu(hn @ w_in)
    u, v = jnp.split(z, 2, axis=-1)
    v = layer_norm(v, ln_g, ln_b)
    v = v.reshape(B, S // GMLP_CHUNK, GMLP_CHUNK, GMLP_GROUPS, GMLP_GROUP_DIM)
    mask = jnp.tril(jnp.ones((GMLP_CHUNK, GMLP_CHUNK), dtype=w_s.dtype))
    ws = w_s * mask
    sv = jnp.einsum('gts,bnsgd->bntgd', ws, v) + b_s.T[None, None, :, :, None]
    y = u * sv.reshape(B, S, GMLP_HALF)
    return y @ w_out


def setup_inputs(seed: int = 0) -> dict:
    key = jax.random.key(seed)
    ks = iter(jax.random.split(key, 40))

    def nrm(shape, scale):
        return jax.random.normal(next(ks), shape, dtype=jnp.float32) * scale

    def gain(shape):
        return 1.0 + nrm(shape, 0.02)

    nA, nB, D = N_MLA_LAYERS, N_GMLP_LAYERS, D_MODEL
    x = nrm((BATCH, SEQ, D), 1.0)
    p = nrm((DEPTH, BATCH, SEQ, PLE_DIM), 1.0)
    offs = jax.random.randint(next(ks), (BATCH, 1), 0, MAX_POS_OFFSET, dtype=jnp.int32)
    positions = offs + jnp.arange(SEQ, dtype=jnp.int32)[None, :]
    down_w = Q_LORA_RANK + KV_LORA_RANK + QK_ROPE_DIM
    return {
        "x": x,
        "p": p,
        "positions": positions,
        "norm_mix": gain((DEPTH, D)),
        "norm_ffn": gain((DEPTH, D)),
        "norm_ple": gain((DEPTH, D)),
        "mla_w_down": nrm((nA, D, down_w), D ** -0.5),
        "mla_q_lora_g": gain((nA, Q_LORA_RANK)),
        "mla_kv_lora_g": gain((nA, KV_LORA_RANK)),
        "mla_w_uq": nrm((nA, Q_LORA_RANK, MLA_HEADS * (QK_NOPE_DIM + QK_ROPE_DIM)), Q_LORA_RANK ** -0.5),
        "mla_w_ukv": nrm((nA, KV_LORA_RANK, MLA_HEADS * (QK_NOPE_DIM + V_HEAD_DIM)), KV_LORA_RANK ** -0.5),
        "mla_q_nope_g": gain((nA, QK_NOPE_DIM)),
        "mla_q_rope_g": gain((nA, QK_ROPE_DIM)),
        "mla_k_nope_g": gain((nA, QK_NOPE_DIM)),
        "mla_k_rope_g": gain((nA, QK_ROPE_DIM)),
        "mla_w_out": nrm((nA, MLA_HEADS * V_HEAD_DIM, D), 0.5 * (MLA_HEADS * V_HEAD_DIM) ** -0.5),
        "gmlp_w_in": nrm((nB, D, 2 * GMLP_HALF), D ** -0.5),
        "gmlp_ln_g": gain((nB, GMLP_HALF)),
        "gmlp_ln_b": nrm((nB, GMLP_HALF), 0.02),
        "gmlp_w_s": nrm((nB, GMLP_GROUPS, GMLP_CHUNK, GMLP_CHUNK), GMLP_CHUNK ** -0.5),
        "gmlp_b_s": 1.0 + nrm((nB, GMLP_GROUPS, GMLP_CHUNK), 0.1),
        "gmlp_w_out": nrm((nB, GMLP_HALF, D), 0.5 * GMLP_HALF ** -0.5),
        "ffn_w_up": nrm((DEPTH, D, D_FF), D ** -0.5),
        "ffn_w_down": nrm((DEPTH, D_FF, D), 0.5 * D_FF ** -0.5),
        "ple_w_gate": nrm((DEPTH, D, D), D ** -0.5),
        "ple_w_proj": nrm((DEPTH, PLE_DIM, D), PLE_DIM ** -0.5),
    }


def reference(x, p, positions, norm_mix, norm_ffn, norm_ple,
              mla_w_down, mla_q_lora_g, mla_kv_lora_g, mla_w_uq, mla_w_ukv,
              mla_q_nope_g, mla_q_rope_g, mla_k_nope_g, mla_k_rope_g, mla_w_out,
              gmlp_w_in, gmlp_ln_g, gmlp_ln_b, gmlp_w_s, gmlp_b_s, gmlp_w_out,
              ffn_w_up, ffn_w_down, ple_w_gate, ple_w_proj):
    cos, sin = rope_cos_sin(positions)
    h = x
    for i in range(DEPTH):
        hn = rms_norm(h, norm_mix[i])
        j = i // N_MIXERS
        if i % N_MIXERS == 0:
            mix = mla_mixer(hn, cos, sin, mla_w_down[j], mla_q_lora_g[j], mla_kv_lora_g[j],
                            mla_w_uq[j], mla_w_ukv[j], mla_q_nope_g[j], mla_q_rope_g[j],
                            mla_k_nope_g[j], mla_k_rope_g[j], mla_w_out[j])
        else:
            mix = gmlp_mixer(hn, gmlp_w_in[j], gmlp_ln_g[j], gmlp_ln_b[j],
                             gmlp_w_s[j], gmlp_b_s[j], gmlp_w_out[j])
        h = h + mix
        hn = rms_norm(h, norm_ffn[i])
        h = h + jnp.square(jax.nn.relu(hn @ ffn_w_up[i])) @ ffn_w_down[i]
        hn = rms_norm(h, norm_ple[i])
        h = h + jax.nn.sigmoid(hn @ ple_w_gate[i]) * (p[i] @ ple_w_proj[i])
    return h
```

```cpp
#include <hip/hip_runtime.h>
#include <hip/hip_cooperative_groups.h>
#include <cstdio>
#include <cstdint>
namespace cg = cooperative_groups;

#ifndef DBG_NOGATE
#define DBG_NOGATE 0
#endif
#ifndef DBG_GATE_NOSS
#define DBG_GATE_NOSS 0
#endif
#ifndef DBG_REPS
#define DBG_REPS 1
#endif
#ifndef ONE_LAUNCH
#define ONE_LAUNCH 1
#endif

#define LAS __attribute__((address_space(3)))
typedef unsigned short bf16_t;
typedef short bf16x8 __attribute__((ext_vector_type(8)));
typedef short s16x4 __attribute__((ext_vector_type(4)));
typedef float f32x4 __attribute__((ext_vector_type(4)));
typedef float f32x2 __attribute__((ext_vector_type(2)));
typedef float f32x16 __attribute__((ext_vector_type(16)));
typedef unsigned u32x4 __attribute__((ext_vector_type(4)));
typedef unsigned u32x2 __attribute__((ext_vector_type(2)));

constexpr int T = 32768, DM = 1024, SEQ = 2048, NB = 16, DFF = 4096, PLE = 256, DEPTH = 4;
constexpr int NH = 8, QLR = 384, KVLR = 256, ROPE = 64, LATP = 768;
constexpr int QP = 1536, KVP = 2048, ZP = 4096;
constexpr float EPS = 1e-6f;
constexpr float QSCALE = 0.07216878364870322f * 1.4426950408889634f;

constexpr size_t MiB = 1u << 20;
constexpr size_t OFF_SS = 0;
constexpr size_t OFF_W = 2621440;
constexpr size_t OFF_HB = 112 * MiB;
constexpr size_t OFF_FF = 176 * MiB;
constexpr size_t OFF_PB = 448 * MiB;
constexpr size_t WS_NEED = 512 * MiB;
constexpr size_t WE_DOWN = 0, WE_UQ = WE_DOWN + 2ull * LATP * DM, WE_UKV = WE_UQ + 2ull * QP * QLR, WE_MOUT = WE_UKV + 2ull * KVP * KVLR,
                 WE_GIN = WE_MOUT + 2ull * DM * DM, WE_GOUT = WE_GIN + 2ull * ZP * DM, WE_UP = WE_GOUT + 2ull * DM * 2048,
                 WE_DN = WE_UP + 4ull * DFF * DM, WE_GATE = WE_DN + 4ull * DM * DFF, WE_PROJ = WE_GATE + 4ull * DM * DM, WE_END = WE_PROJ + 4ull * DM * PLE;
static_assert(OFF_W + WE_END * 2 <= OFF_HB, "weights fit");
constexpr size_t FF_Q = 0, FF_KV = 96 * MiB, FF_LAT = 224 * MiB;

struct Params { const float* in[26]; float* out; unsigned char* ws; int ph_lo, ph_hi; };

typedef __bf16 bf16x2_t __attribute__((ext_vector_type(2)));
__device__ __forceinline__ unsigned cvt_pk_bf16(float lo, float hi) { const f32x2 v = {lo, hi}; return __builtin_bit_cast(unsigned, __builtin_convertvector(v, bf16x2_t)); }
__device__ __forceinline__ float bf2f(unsigned short b) { return __uint_as_float((unsigned)b << 16); }
__device__ __forceinline__ float bflo(unsigned u) { return __uint_as_float(u << 16); }
__device__ __forceinline__ float bfhi(unsigned u) { return __uint_as_float(u & 0xffff0000u); }
__device__ __forceinline__ float fast_rcp(float x) { return __builtin_amdgcn_rcpf(x); }
__device__ __forceinline__ float fast_exp2(float x) { return __builtin_amdgcn_exp2f(x); }
__device__ __forceinline__ float gelu_tanh(float x) { const float y = x + 0.044715f * x * x * x; return x * fast_rcp(1.0f + fast_exp2(-2.3022082f * y)); }
__device__ __forceinline__ float sigmoidf_(float x) { return fast_rcp(1.0f + fast_exp2(-1.4426950409f * x)); }

namespace pg8 {
constexpr int BM = 256, BK = 64, HALF = 128, HTB = HALF * BK * 2, STAGE_BYTES = 8 * HTB, NXCD = 8, WGM = 8;
__host__ __device__ __forceinline__ int lds_byte(int r, int c) { const int st = (r >> 4) * 2 + (c >> 5), rr = r & 15, cc = c & 31, ob = rr * 64 + cc * 2; return st * 1024 + (ob ^ (((ob >> 9) & 1) << 5)); }
__host__ __device__ __forceinline__ void stage_rc(int b, int& R, int& C) { const int st = b / 1024, sb = b % 1024, swz = sb ^ (((sb >> 9) & 1) << 5); R = (st >> 1) * 16 + swz / 64; C = (st & 1) * 32 + (swz % 64) / 2; }
__host__ __device__ __forceinline__ int perm32(int rho) { const int n = rho >> 4, i = rho & 15; return 8 * (i >> 2) + 4 * n + (i & 3); }
struct Unit { int pm, pn; };
struct Gemm { const bf16_t* A; const bf16_t* Bt; int M, N, K, lda; };
struct StaticOrder {
    int nM, nN, nwg, G, c;
    __device__ void init(int M, int N, int G_, int c_) { nM = M / BM; nN = N / BM; nwg = nM * nN; G = G_; c = c_; }
    __device__ bool next(int i, Unit& u) const {
        const long L = (long)i * G + c; if (L >= nwg) return false;
        int wgid = (int)L; { const int q = nwg / NXCD, r = nwg % NXCD, xcd = wgid % NXCD, off = wgid / NXCD; wgid = (xcd < r ? xcd * (q + 1) : r * (q + 1) + (xcd - r) * q) + off; }
        const int nig = WGM * nN, gid = wgid / nig, fm = gid * WGM, gsz = (nM - fm) < WGM ? (nM - fm) : WGM;
        u.pm = fm + ((wgid % nig) % gsz); u.pn = (wgid % nig) / gsz; return true;
    }
};

template <int ACT, int STATS> struct EpiStore {
    static constexpr bool PERM = true;
    bf16_t* O; int ldc; const float* ss; float inv_n;
    __device__ __forceinline__ void operator()(const f32x4 (&acc)[2][2][4][2], const Unit& u, int wr, int wc, int fr, int fq) const {
        const int row0 = u.pm * BM + wr * 64 + fr, col0 = u.pn * BM + wc * 32 + 8 * fq;
#pragma unroll
        for (int ai = 0; ai < 2; ++ai)
#pragma unroll
            for (int m = 0; m < 4; ++m) {
                const int row = row0 + ai * HALF + m * 16;
                float rs = 1.0f;
                if (ss) { const f32x4* sp = (const f32x4*)(ss + (size_t)row * 16); const f32x4 a = sp[0], b = sp[1], c = sp[2], d = sp[3];
                    const float t = (((a[0] + a[1]) + (a[2] + a[3])) + ((b[0] + b[1]) + (b[2] + b[3]))) + (((c[0] + c[1]) + (c[2] + c[3])) + ((d[0] + d[1]) + (d[2] + d[3])));
                    rs = rsqrtf(t * inv_n + EPS); }
#pragma unroll
                for (int bj = 0; bj < 2; ++bj) {
                    f32x4 v0 = acc[ai][bj][m][0] * rs, v1 = acc[ai][bj][m][1] * rs;
                    if (ACT == 1) {
#pragma unroll
                        for (int e = 0; e < 4; ++e) { const float a = fmaxf(v0[e], 0.f), b = fmaxf(v1[e], 0.f); v0[e] = a * a; v1[e] = b * b; }
                    }
                    if (ACT == 2) {
#pragma unroll
                        for (int e = 0; e < 4; ++e) { v0[e] = gelu_tanh(v0[e]); v1[e] = gelu_tanh(v1[e]); }
                    }
                    if (ACT == 3) {
#pragma unroll
                        for (int e = 0; e < 4; ++e) { v0[e] = sigmoidf_(v0[e]); v1[e] = sigmoidf_(v1[e]); }
                    }
                    u32x4 w; w.x = cvt_pk_bf16(v0[0], v0[1]); w.y = cvt_pk_bf16(v0[2], v0[3]); w.z = cvt_pk_bf16(v1[0], v1[1]); w.w = cvt_pk_bf16(v1[2], v1[3]);
                    *(u32x4*)(O + (size_t)row * ldc + col0 + bj * HALF) = w;
                }
                asm volatile("" ::: "memory");
            }
    }
};
template <int MODE> struct EpiRes {
    static constexpr bool PERM = true;
    const float* hin; float* hout; bf16_t* hb; float* ssn; const bf16_t* pp;
    __device__ __forceinline__ void operator()(const f32x4 (&acc)[2][2][4][2], const Unit& u, int wr, int wc, int fr, int fq) const {
        const int row0 = u.pm * BM + wr * 64 + fr, col0 = u.pn * BM + wc * 32 + 8 * fq;
#pragma unroll
        for (int ai = 0; ai < 2; ++ai)
#pragma unroll
            for (int m = 0; m < 4; ++m) {
                const int row = row0 + ai * HALF + m * 16;
                float q = 0.f;
#pragma unroll
                for (int bj = 0; bj < 2; ++bj) {
                    const size_t off = (size_t)row * DM + col0 + bj * HALF;
                    f32x4 v0 = acc[ai][bj][m][0], v1 = acc[ai][bj][m][1];
                    const f32x4 h0 = *(const f32x4*)(hin + off), h1 = *(const f32x4*)(hin + off + 4);
                    if (MODE == 1 && !DBG_NOGATE) {
                        const u32x4 pw = *(const u32x4*)(pp + off);
                        v0[0] *= bflo(pw.x); v0[1] *= bfhi(pw.x); v0[2] *= bflo(pw.y); v0[3] *= bfhi(pw.y);
                        v1[0] *= bflo(pw.z); v1[1] *= bfhi(pw.z); v1[2] *= bflo(pw.w); v1[3] *= bfhi(pw.w);
                    }
                    v0 += h0; v1 += h1;
                    *(f32x4*)(hout + off) = v0; *(f32x4*)(hout + off + 4) = v1;
                    u32x4 w; w.x = cvt_pk_bf16(v0[0], v0[1]); w.y = cvt_pk_bf16(v0[2], v0[3]); w.z = cvt_pk_bf16(v1[0], v1[1]); w.w = cvt_pk_bf16(v1[2], v1[3]);
                    *(u32x4*)(hb + off) = w;
                    q += (v0[0] * v0[0] + v0[1] * v0[1]) + (v0[2] * v0[2] + v0[3] * v0[3]) + (v1[0] * v1[0] + v1[1] * v1[1]) + (v1[2] * v1[2] + v1[3] * v1[3]);
                }
                if (ssn) { q += __shfl_xor(q, 16); q += __shfl_xor(q, 32); if (fq == 0) ssn[(size_t)row * 16 + u.pn * 4 + wc] = q; }
                asm volatile("" ::: "memory");
            }
    }
};

#ifndef PG8_SP2
#define PG8_SP2 false
#endif
#ifndef PG8_ALIGN
#define PG8_ALIGN true
#endif
template <class Epi, bool ALIGN_EPI = PG8_ALIGN, bool SP2 = PG8_SP2>
__device__ __forceinline__ void gemm_phase(int tid, LAS unsigned char* lds, const Gemm g, const StaticOrder& S, const Epi& E) {
    const int wid = __builtin_amdgcn_readfirstlane(tid >> 6), lane = tid & 63, wr = wid >> 2, wc = wid & 3, fr = lane & 15, fq = lane >> 4;
    const int K = g.K, nt = K / BK, lda = g.lda;
    unsigned voffA[2], voffB[2];
#pragma unroll
    for (int i = 0; i < 2; ++i) { int R, C; stage_rc(tid * 16 + i * 8192, R, C); const int Rb = Epi::PERM ? ((R & ~31) + perm32(R & 31)) : R;
        voffA[i] = (unsigned)(R * lda + C) * 2u; voffB[i] = (unsigned)(Rb * K + C) * 2u; }
    const size_t kstep = (size_t)(BK * 2);
    const size_t hstepA = (size_t)HALF * lda * 2, hstepB = (size_t)HALF * K * 2;
    const size_t tstepA = 2 * hstepA, tstepB = 2 * hstepB;
    const unsigned ldsw = (unsigned)wid * 1024u;
    const int aoff = lds_byte(wr * 64 + fr, fq * 8), boff = lds_byte(wc * 32 + fr, fq * 8);
#define PG8_SA(b, h) (((b) * 2 + (h)) * HTB)
#define PG8_SB(b, h) ((4 + (b) * 2 + (h)) * HTB)
#define PG8_STAGE(bufoff, gbase, voff) do { _Pragma("unroll") for (int _i = 0; _i < 2; ++_i) \
        __builtin_amdgcn_global_load_lds((const unsigned*)((const char*)(gbase) + (voff)[_i]), (LAS unsigned*)(lds + (bufoff) + ldsw + _i * 8192), 16, 0, 0); } while (0)
#define PG8_LDA(dst, b, h) do { _Pragma("unroll") for (int m = 0; m < 4; ++m) _Pragma("unroll") for (int k = 0; k < 2; ++k) dst[m][k] = *(const LAS bf16x8*)(lds + PG8_SA(b, h) + aoff + m * 2048 + k * 1024); } while (0)
#define PG8_LDB(dst, b, h) do { _Pragma("unroll") for (int n = 0; n < 2; ++n) _Pragma("unroll") for (int k = 0; k < 2; ++k) dst[n][k] = *(const LAS bf16x8*)(lds + PG8_SB(b, h) + boff + n * 2048 + k * 1024); } while (0)
#define PG8_MMA(ai, bj, At, Bt) do { __builtin_amdgcn_s_setprio(1); _Pragma("unroll") for (int m = 0; m < 4; ++m) _Pragma("unroll") for (int n = 0; n < 2; ++n) _Pragma("unroll") for (int k = 0; k < 2; ++k) \
        acc[ai][bj][m][n] = __builtin_amdgcn_mfma_f32_16x16x32_bf16(Bt[n][k], At[m][k], acc[ai][bj][m][n], 0, 0, 0); __builtin_amdgcn_s_setprio(0); } while (0)
#define PG8_WAIT_V(n) asm volatile("s_waitcnt vmcnt(" #n ")" ::: "memory")
#define PG8_WAIT_L(n) asm volatile("s_waitcnt lgkmcnt(" #n ")" ::: "memory")
#define PG8_BAR __builtin_amdgcn_s_barrier()
#define PG8_SCHED __builtin_amdgcn_sched_barrier(0)
    Unit cur, nxt; int ui = 0;
    if (!S.next(0, cur)) return;
    f32x4 acc[2][2][4][2];
#pragma unroll
    for (int a = 0; a < 2; ++a)
#pragma unroll
        for (int b = 0; b < 2; ++b)
#pragma unroll
            for (int m = 0; m < 4; ++m)
#pragma unroll
                for (int n = 0; n < 2; ++n) acc[a][b][m][n] = (f32x4){0.f, 0.f, 0.f, 0.f};
    bf16x8 At[4][2], B0[2][2], B1[2][2];
    const char* cA = (const char*)g.A + (size_t)cur.pm * tstepA; const char* cB = (const char*)g.Bt + (size_t)cur.pn * tstepB;
    if constexpr (SP2) {
    PG8_STAGE(PG8_SB(0, 0), cB, voffB); PG8_STAGE(PG8_SB(0, 1), cB + hstepB, voffB); PG8_STAGE(PG8_SA(0, 0), cA, voffA); PG8_STAGE(PG8_SA(0, 1), cA + hstepA, voffA);
    if (wr == 1) PG8_BAR;
    PG8_WAIT_V(2); PG8_BAR;
    PG8_STAGE(PG8_SB(1, 0), cB + kstep, voffB); PG8_STAGE(PG8_SA(1, 0), cA + kstep, voffA); PG8_STAGE(PG8_SB(1, 1), cB + hstepB + kstep, voffB);
    PG8_WAIT_V(6); PG8_BAR;
    } else {
    PG8_STAGE(PG8_SB(0, 0), cB, voffB); PG8_STAGE(PG8_SA(0, 0), cA, voffA); PG8_STAGE(PG8_SB(0, 1), cB + hstepB, voffB); PG8_STAGE(PG8_SA(0, 1), cA + hstepA, voffA);
    if (wr == 1) PG8_BAR;
    PG8_WAIT_V(4); PG8_BAR;
    PG8_STAGE(PG8_SB(1, 0), cB + kstep, voffB); PG8_STAGE(PG8_SA(1, 0), cA + kstep, voffA); PG8_STAGE(PG8_SB(1, 1), cB + hstepB + kstep, voffB);
    PG8_WAIT_V(6); PG8_BAR;
    }
    for (;;) {
        const bool has_next = S.next(ui + 1, nxt);
        const char* nA = has_next ? (const char*)g.A + (size_t)nxt.pm * tstepA : cA; const char* nB = has_next ? (const char*)g.Bt + (size_t)nxt.pn * tstepB : cB;
        for (int t = 0; t < nt; t += 2) {
            const bool last = (t == nt - 2);
            const char* a1 = cA + (size_t)(t + 1) * kstep;
            const char* a2 = last ? nA : cA + (size_t)(t + 2) * kstep; const char* b2 = last ? nB : cB + (size_t)(t + 2) * kstep;
            const char* a3 = a2 + kstep; const char* b3 = b2 + kstep;
            if constexpr (SP2) {
            PG8_LDB(B0, 0, 0); PG8_LDB(B1, 0, 1); PG8_SCHED; PG8_LDA(At, 0, 0); PG8_STAGE(PG8_SA(1, 1), a1 + hstepA, voffA);
            PG8_WAIT_V(8); PG8_WAIT_L(0); PG8_BAR; PG8_MMA(0, 0, At, B0); PG8_MMA(0, 1, At, B1); PG8_BAR; PG8_SCHED;
            PG8_LDA(At, 0, 1); PG8_STAGE(PG8_SB(0, 0), b2, voffB); PG8_STAGE(PG8_SB(0, 1), b2 + hstepB, voffB); PG8_STAGE(PG8_SA(0, 0), a2, voffA);
            PG8_WAIT_V(8); PG8_WAIT_L(0); PG8_BAR; PG8_MMA(1, 0, At, B0); PG8_MMA(1, 1, At, B1); PG8_BAR; PG8_SCHED;
            PG8_LDB(B0, 1, 0); PG8_LDB(B1, 1, 1); PG8_SCHED; PG8_LDA(At, 1, 0); PG8_STAGE(PG8_SA(0, 1), a2 + hstepA, voffA);
            PG8_WAIT_V(8); PG8_WAIT_L(0); PG8_BAR; PG8_MMA(0, 0, At, B0); PG8_MMA(0, 1, At, B1); PG8_BAR; PG8_SCHED;
            PG8_LDA(At, 1, 1); PG8_STAGE(PG8_SB(1, 0), b3, voffB); PG8_STAGE(PG8_SB(1, 1), b3 + hstepB, voffB); PG8_STAGE(PG8_SA(1, 0), a3, voffA);
            PG8_WAIT_V(8); PG8_WAIT_L(0); PG8_BAR; PG8_MMA(1, 0, At, B0); PG8_MMA(1, 1, At, B1); PG8_BAR; PG8_SCHED;
            } else {
            PG8_LDB(B0, 0, 0); PG8_SCHED; PG8_LDA(At, 0, 0); PG8_STAGE(PG8_SA(1, 1), a1 + hstepA, voffA);
            PG8_WAIT_L(8); PG8_BAR; PG8_WAIT_L(0); PG8_MMA(0, 0, At, B0); PG8_BAR; PG8_SCHED;
            PG8_LDB(B1, 0, 1); PG8_STAGE(PG8_SB(0, 0), b2, voffB);
            PG8_BAR; PG8_WAIT_L(0); PG8_MMA(0, 1, At, B1); PG8_BAR;
            PG8_LDA(At, 0, 1); PG8_STAGE(PG8_SA(0, 0), a2, voffA);
            PG8_BAR; PG8_WAIT_L(0); PG8_MMA(1, 0, At, B0); PG8_BAR; PG8_SCHED;
            PG8_STAGE(PG8_SB(0, 1), b2 + hstepB, voffB);
            PG8_WAIT_V(6); PG8_BAR; PG8_MMA(1, 1, At, B1); PG8_BAR;
            PG8_LDB(B0, 1, 0); PG8_SCHED; PG8_LDA(At, 1, 0); PG8_STAGE(PG8_SA(0, 1), a2 + hstepA, voffA);
            PG8_WAIT_L(8); PG8_BAR; PG8_WAIT_L(0); PG8_MMA(0, 0, At, B0); PG8_BAR; PG8_SCHED;
            PG8_LDB(B1, 1, 1); PG8_STAGE(PG8_SB(1, 0), b3, voffB);
            PG8_BAR; PG8_WAIT_L(0); PG8_MMA(0, 1, At, B1); PG8_BAR;
            PG8_LDA(At, 1, 1); PG8_STAGE(PG8_SA(1, 0), a3, voffA);
            PG8_BAR; PG8_WAIT_L(0); PG8_MMA(1, 0, At, B0); PG8_BAR; PG8_SCHED;
            PG8_STAGE(PG8_SB(1, 1), b3 + hstepB, voffB);
            PG8_WAIT_V(6); PG8_BAR; PG8_MMA(1, 1, At, B1); PG8_BAR;
            }
        }
        if constexpr (ALIGN_EPI) { if (wr == 0) PG8_BAR; }
        E(acc, cur, wr, wc, fr, fq);
        if (!has_next) break;
#pragma unroll
        for (int a = 0; a < 2; ++a)
#pragma unroll
            for (int b = 0; b < 2; ++b)
#pragma unroll
                for (int m = 0; m < 4; ++m)
#pragma unroll
                    for (int n = 0; n < 2; ++n) acc[a][b][m][n] = (f32x4){0.f, 0.f, 0.f, 0.f};
        cur = nxt; cA = nA; cB = nB; ++ui;
        if constexpr (ALIGN_EPI) { if (wr == 1) PG8_BAR; }
    }
    PG8_WAIT_V(0);
    if constexpr (!ALIGN_EPI) { if (wr == 0) PG8_BAR; }
    PG8_BAR;
#undef PG8_SA
#undef PG8_SB
#undef PG8_STAGE
#undef PG8_LDA
#undef PG8_LDB
#undef PG8_MMA
#undef PG8_WAIT_V
#undef PG8_WAIT_L
#undef PG8_BAR
#undef PG8_SCHED
}
}

__constant__ double kInvFreq[32] = {
    1.0, 0.7498942093324559, 0.5623413251903491, 0.4216965034285822, 0.31622776601683794, 0.23713737056616552, 0.1778279410038923, 0.1333521432163324,
    0.1, 0.07498942093324558, 0.05623413251903491, 0.04216965034285822, 0.03162277660168379, 0.023713737056616554, 0.01778279410038923, 0.01333521432163324,
    0.01, 0.007498942093324558, 0.005623413251903491, 0.004216965034285823, 0.0031622776601683794, 0.0023713737056616554, 0.001778279410038923, 0.001333521432163324,
    0.001, 0.0007498942093324559, 0.0005623413251903491, 0.0004216965034285823, 0.00031622776601683794, 0.00023713737056616554, 0.0001778279410038923, 0.0001333521432163324};

__device__ __forceinline__ float wave_sum(float v) {
#pragma unroll
    for (int o = 1; o < 64; o <<= 1) v += __shfl_xor(v, o);
    return v;
}
__device__ __forceinline__ void unpack8(const u32x4 w, float (&f)[8]) { f[0] = bflo(w.x); f[1] = bfhi(w.x); f[2] = bflo(w.y); f[3] = bfhi(w.y); f[4] = bflo(w.z); f[5] = bfhi(w.z); f[6] = bflo(w.w); f[7] = bfhi(w.w); }
__device__ __forceinline__ u32x4 pack8(const float (&f)[8]) { u32x4 w; w.x = cvt_pk_bf16(f[0], f[1]); w.y = cvt_pk_bf16(f[2], f[3]); w.z = cvt_pk_bf16(f[4], f[5]); w.w = cvt_pk_bf16(f[6], f[7]); return w; }

struct WDesc { const float* W; const float* gamma; bf16_t* dst; int K, N, Npad, mode, items; };
__device__ __forceinline__ WDesc wdesc(const Params& P, int id) {
    WDesc d; bf16_t* wb = (bf16_t*)(P.ws + OFF_W); d.gamma = nullptr; d.mode = 0;
    if (id < 12) {
        const int j = id & 1, f = id >> 1;
        switch (f) {
            case 0: d.W = P.in[6] + (size_t)j * DM * 704; d.K = DM; d.N = 704; d.Npad = LATP; d.dst = wb + WE_DOWN + (size_t)j * LATP * DM; d.gamma = P.in[3] + (2 * j) * DM; break;
            case 1: d.W = P.in[9] + (size_t)j * QLR * QP; d.K = QLR; d.N = QP; d.Npad = QP; d.dst = wb + WE_UQ + (size_t)j * QP * QLR; d.gamma = P.in[7] + j * QLR; d.mode = 1; break;
            case 2: d.W = P.in[10] + (size_t)j * KVLR * KVP; d.K = KVLR; d.N = KVP; d.Npad = KVP; d.dst = wb + WE_UKV + (size_t)j * KVP * KVLR; d.gamma = P.in[8] + j * KVLR; break;
            case 3: d.W = P.in[15] + (size_t)j * DM * DM; d.K = DM; d.N = DM; d.Npad = DM; d.dst = wb + WE_MOUT + (size_t)j * DM * DM; break;
            case 4: d.W = P.in[16] + (size_t)j * DM * ZP; d.K = DM; d.N = ZP; d.Npad = ZP; d.dst = wb + WE_GIN + (size_t)j * ZP * DM; d.gamma = P.in[3] + (2 * j + 1) * DM; break;
            default: d.W = P.in[21] + (size_t)j * 2048 * DM; d.K = 2048; d.N = DM; d.Npad = DM; d.dst = wb + WE_GOUT + (size_t)j * DM * 2048; break;
        }
    } else {
        const int i = (id - 12) & 3, f = (id - 12) >> 2;
        switch (f) {
            case 0: d.W = P.in[22] + (size_t)i * DM * DFF; d.K = DM; d.N = DFF; d.Npad = DFF; d.dst = wb + WE_UP + (size_t)i * DFF * DM; d.gamma = P.in[4] + i * DM; break;
            case 1: d.W = P.in[23] + (size_t)i * DFF * DM; d.K = DFF; d.N = DM; d.Npad = DM; d.dst = wb + WE_DN + (size_t)i * DM * DFF; break;
            case 2: d.W = P.in[24] + (size_t)i * DM * DM; d.K = DM; d.N = DM; d.Npad = DM; d.dst = wb + WE_GATE + (size_t)i * DM * DM; d.gamma = P.in[5] + i * DM; break;
            default: d.W = P.in[25] + (size_t)i * PLE * DM; d.K = PLE; d.N = DM; d.Npad = DM; d.dst = wb + WE_PROJ + (size_t)i * DM * PLE; break;
        }
    }
    d.items = (d.K / 64) * (d.Npad / 32);
    return d;
}
__device__ __forceinline__ void conv_item(const WDesc& d, int item, float* scr, int lane) {
    const int nblk = d.Npad / 32, kb = item / nblk, nb = item % nblk, k0 = 64 * kb, n0 = 32 * nb;
    int sn0 = n0;
    if (d.mode == 1) { if (n0 < 1024) sn0 = (n0 >> 7) * 192 + (n0 & 127); else { const int r = n0 - 1024; sn0 = (r >> 6) * 192 + 128 + (r & 63); } }
    const bool valid = sn0 < d.N;
#pragma unroll 8
    for (int i = 0; i < 32; ++i) { const int kk = 2 * i + (lane >> 5);
        float v = valid ? d.W[(size_t)(k0 + kk) * d.N + sn0 + (lane & 31)] : 0.f;
        if (d.gamma) v *= d.gamma[k0 + kk];
        scr[kk * 33 + (lane & 31)] = v; }
    asm volatile("s_waitcnt lgkmcnt(0)" ::: "memory");
    const int c = lane & 7;
#pragma unroll
    for (int j = 0; j < 4; ++j) { const int n = (lane >> 3) + 8 * j; const float* s = scr + (8 * c) * 33 + n;
        u32x4 o; o.x = cvt_pk_bf16(s[0 * 33], s[1 * 33]); o.y = cvt_pk_bf16(s[2 * 33], s[3 * 33]); o.z = cvt_pk_bf16(s[4 * 33], s[5 * 33]); o.w = cvt_pk_bf16(s[6 * 33], s[7 * 33]);
        *(u32x4*)(d.dst + (size_t)(n0 + n) * d.K + k0 + 8 * c) = o; }
    asm volatile("s_waitcnt lgkmcnt(0)" ::: "memory");
}
__device__ __forceinline__ void p0_prologue(int tid, const Params& P, unsigned char* lds) {
    const int lane = tid & 63, wave = __builtin_amdgcn_readfirstlane(tid >> 6);
    const int gw = blockIdx.x * 8 + wave, NGW = gridDim.x * 8;
    const size_t gt = (size_t)blockIdx.x * 512 + tid, NGT = (size_t)gridDim.x * 512;
    float* scr = (float*)(lds + wave * 8704);
    int total = 0;
    for (int id = 0; id < 28; ++id) total += wdesc(P, id).items;
    for (int it = gw; it < total; it += NGW) {
        int r = it, id = 0; WDesc d = wdesc(P, 0);
        while (r >= d.items) { r -= d.items; ++id; d = wdesc(P, id); }
        conv_item(d, r, scr, lane);
    }
    { const f32x4* src = (const f32x4*)P.in[1]; u32x4* dst = (u32x4*)(P.ws + OFF_PB); const size_t n8 = (size_t)DEPTH * T * PLE / 8;
      for (size_t i = gt; i < n8; i += NGT) { const f32x4 a = src[2 * i], b = src[2 * i + 1]; u32x4 w; w.x = cvt_pk_bf16(a[0], a[1]); w.y = cvt_pk_bf16(a[2], a[3]); w.z = cvt_pk_bf16(b[0], b[1]); w.w = cvt_pk_bf16(b[2], b[3]); dst[i] = w; } }
    { float* ssp = (float*)(P.ws + OFF_SS); bf16_t* hb = (bf16_t*)(P.ws + OFF_HB);
      for (int row = gw; row < T; row += NGW) {
          const f32x4* xr = (const f32x4*)(P.in[0] + (size_t)row * DM) + lane; float s = 0.f;
          unsigned long long* o8 = (unsigned long long*)(hb + (size_t)row * DM) + lane;
#pragma unroll
          for (int j = 0; j < 4; ++j) { const f32x4 v = xr[64 * j]; s += (v[0] * v[0] + v[1] * v[1]) + (v[2] * v[2] + v[3] * v[3]);
              o8[64 * j] = (unsigned long long)cvt_pk_bf16(v[0], v[1]) | ((unsigned long long)cvt_pk_bf16(v[2], v[3]) << 32); }
          s = wave_sum(s); if (lane < 16) ssp[(size_t)row * 16 + lane] = (lane == 0) ? s : 0.f; } }
}

__device__ __forceinline__ void r2_phase(int tid, const Params& P, int j) {
    const int lane = tid & 63, wave = __builtin_amdgcn_readfirstlane(tid >> 6);
    const int gw = blockIdx.x * 8 + wave, NGW = gridDim.x * 8;
    bf16_t* Q = (bf16_t*)(P.ws + OFF_FF + FF_Q); bf16_t* KV = (bf16_t*)(P.ws + OFF_FF + FF_KV); bf16_t* LAT = (bf16_t*)(P.ws + OFF_FF + FF_LAT);
    const float* gqn = P.in[11] + j * 128; const float* gqr = P.in[12] + j * 64; const float* gkn = P.in[13] + j * 128; const float* gkr = P.in[14] + j * 64;
    const int* pos = (const int*)P.in[2];
    float g_qn[2][8], g_kn[2][8], g_qr[8], g_kr[8];
#pragma unroll
    for (int i = 0; i < 2; ++i)
#pragma unroll
        for (int e = 0; e < 8; ++e) { const int d = (8 * lane + 512 * i + e) & 127; g_qn[i][e] = gqn[d] * QSCALE; g_kn[i][e] = gkn[d]; }
#pragma unroll
    for (int e = 0; e < 8; ++e) { const int r = 8 * (lane & 7) + e; g_qr[e] = gqr[r] * QSCALE; g_kr[e] = gkr[r]; }
    const double invf = kInvFreq[lane & 31];
    for (int row = gw; row < T; row += NGW) {
        float rq, rkv;
        { u32x4 z4 = {0u, 0u, 0u, 0u};
          const u32x4 lq = (lane < 48) ? *(const u32x4*)(LAT + (size_t)row * LATP + 8 * lane) : z4;
          const u32x4 lk = (lane < 32) ? *(const u32x4*)(LAT + (size_t)row * LATP + QLR + 8 * lane) : z4;
          float a[8], b[8]; unpack8(lq, a); unpack8(lk, b); float sa = 0.f, sb = 0.f;
#pragma unroll
          for (int e = 0; e < 8; ++e) { sa += a[e] * a[e]; sb += b[e] * b[e]; }
          rq = rsqrtf(wave_sum(sa) * (1.0f / QLR) + EPS); rkv = rsqrtf(wave_sum(sb) * (1.0f / KVLR) + EPS); }
        const double ang = (double)pos[row] * invf; double rev = ang * 0.15915494309189535; rev -= floor(rev);
        const float cs = __builtin_amdgcn_cosf((float)rev), sn = __builtin_amdgcn_sinf((float)rev);
        float cj[8], sj[8];
#pragma unroll
        for (int e = 0; e < 8; ++e) { cj[e] = __shfl(cs, 8 * (lane & 3) + e); sj[e] = __shfl(sn, 8 * (lane & 3) + e); }
#pragma unroll
        for (int i = 0; i < 2; ++i) {
            const int idx = 8 * lane + 512 * i, head = idx >> 7, d = idx & 127;
            u32x4* qp = (u32x4*)(Q + (size_t)row * QP + idx); u32x4* kp = (u32x4*)(KV + (size_t)row * KVP + head * 256 + d);
            float a[8], b[8]; unpack8(*qp, a); unpack8(*kp, b);
            { u32x4* vp = (u32x4*)(KV + (size_t)row * KVP + head * 256 + 128 + d); float vv[8]; unpack8(*vp, vv);
#pragma unroll
              for (int e = 0; e < 8; ++e) vv[e] *= rkv;
              *vp = pack8(vv); }
            float sa = 0.f, sb = 0.f;
#pragma unroll
            for (int e = 0; e < 8; ++e) { a[e] *= rq; b[e] *= rkv; sa += a[e] * a[e]; sb += b[e] * b[e]; }
#pragma unroll
            for (int o = 1; o < 16; o <<= 1) { sa += __shfl_xor(sa, o); sb += __shfl_xor(sb, o); }
            const float ra = rsqrtf(sa * (1.0f / 128) + EPS), rb = rsqrtf(sb * (1.0f / 128) + EPS);
#pragma unroll
            for (int e = 0; e < 8; ++e) { a[e] = a[e] * ra * g_qn[i][e]; b[e] = b[e] * rb * g_kn[i][e]; }
            *qp = pack8(a); *kp = pack8(b);
        }
        {
            u32x4* qp = (u32x4*)(Q + (size_t)row * QP + 1024 + 8 * lane); u32x4* kp = (u32x4*)(LAT + (size_t)row * LATP + 640 + 8 * (lane & 7));
            float a[8], b[8]; unpack8(*qp, a); unpack8(*kp, b);
            float sa = 0.f, sb = 0.f;
#pragma unroll
            for (int e = 0; e < 8; ++e) { a[e] *= rq; sa += a[e] * a[e]; sb += b[e] * b[e]; }
#pragma unroll
            for (int o = 1; o < 8; o <<= 1) { sa += __shfl_xor(sa, o); sb += __shfl_xor(sb, o); }
            const float ra = rsqrtf(sa * (1.0f / 64) + EPS), rb = rsqrtf(sb * (1.0f / 64) + EPS);
            const bool hi = (lane & 4) != 0;
#pragma unroll
            for (int e = 0; e < 8; ++e) {
                const float ya = a[e] * ra * g_qr[e], yb = b[e] * rb * g_kr[e];
                const float pa = __shfl_xor(ya, 4), pb = __shfl_xor(yb, 4);
                a[e] = hi ? (ya * cj[e] + pa * sj[e]) : (ya * cj[e] - pa * sj[e]);
                b[e] = hi ? (yb * cj[e] + pb * sj[e]) : (yb * cj[e] - pb * sj[e]);
            }
            *qp = pack8(a); if (lane < 8) *kp = pack8(b);
        }
    }
}

constexpr int KROW = 400, VROW = 288, KTILE = 64 * KROW, VTILE = 64 * VROW;
__device__ __forceinline__ void attn_unit(int tid, unsigned char* lds, const bf16_t* Q, const bf16_t* KV, const bf16_t* KR, bf16_t* O, int b, int h, int qb) {
    const int lane = tid & 63, w = __builtin_amdgcn_readfirstlane(tid >> 6), r = lane & 15, g = lane >> 4;
    const int row0 = b * SEQ + qb * 128, qrow = row0 + 16 * w + r;
    bf16x8 qf[6];
#pragma unroll
    for (int ks = 0; ks < 4; ++ks) qf[ks] = *(const bf16x8*)(Q + (size_t)qrow * QP + h * 128 + 32 * ks + 8 * g);
#pragma unroll
    for (int ks = 0; ks < 2; ++ks) qf[4 + ks] = *(const bf16x8*)(Q + (size_t)qrow * QP + 1024 + h * 64 + 32 * ks + 8 * g);
    const int ntiles = 2 * qb + 2, last_tile = 2 * qb + (w >> 2);
    const int kn_row0 = tid >> 4, kn_ch = tid & 15;
    const int kr_row = tid >> 3, kr_ch = tid & 7;
    const bf16_t* gk = KV + (size_t)(b * SEQ) * KVP + h * 256;
    const bf16_t* gr = KR + (size_t)(b * SEQ) * LATP;
    u32x4 sk0, sk1, sr, sv0, sv1;
#define ATT_LOAD(t) do { const size_t kb = (size_t)(t) * 64; \
        sk0 = *(const u32x4*)(gk + (kb + kn_row0) * KVP + kn_ch * 8); sk1 = *(const u32x4*)(gk + (kb + kn_row0 + 32) * KVP + kn_ch * 8); \
        sv0 = *(const u32x4*)(gk + (kb + kn_row0) * KVP + 128 + kn_ch * 8); sv1 = *(const u32x4*)(gk + (kb + kn_row0 + 32) * KVP + 128 + kn_ch * 8); \
        sr = *(const u32x4*)(gr + (kb + kr_row) * LATP + kr_ch * 8); } while (0)
#define ATT_STORE(buf) do { unsigned char* kb_ = lds + (buf) * KTILE; unsigned char* vb_ = lds + 2 * KTILE + (buf) * VTILE; \
        *(u32x4*)(kb_ + kn_row0 * KROW + kn_ch * 16) = sk0; *(u32x4*)(kb_ + (kn_row0 + 32) * KROW + kn_ch * 16) = sk1; \
        *(u32x4*)(kb_ + kr_row * KROW + 256 + kr_ch * 16) = sr; \
        *(u32x4*)(vb_ + kn_row0 * VROW + kn_ch * 16) = sv0; *(u32x4*)(vb_ + (kn_row0 + 32) * VROW + kn_ch * 16) = sv1; } while (0)
    f32x4 o[8];
#pragma unroll
    for (int i = 0; i < 8; ++i) o[i] = (f32x4){0.f, 0.f, 0.f, 0.f};
    float m = -1e30f, l = 0.f;
    ATT_LOAD(0); ATT_STORE(0);
    __syncthreads();
    const int q4 = r >> 2, p4 = lane & 3;
    const int vtr_off = (4 * g + q4) * VROW + (4 * p4) * 2;
    const int qidx = qb * 128 + 16 * w + r;
    for (int t = 0; t < ntiles; ++t) {
        const bool more = (t + 1 < ntiles);
        if (more) ATT_LOAD(t + 1);
        if (t <= last_tile) {
            const unsigned char* Kb = lds + (t & 1) * KTILE; const unsigned char* Vb = lds + 2 * KTILE + (t & 1) * VTILE;
            f32x4 p[4];
#pragma unroll
            for (int kb = 0; kb < 4; ++kb) {
                p[kb] = (f32x4){0.f, 0.f, 0.f, 0.f};
#pragma unroll
                for (int ks = 0; ks < 6; ++ks) {
                    const bf16x8 a = *(const bf16x8*)(Kb + (16 * kb + r) * KROW + ks * 64 + g * 16);
                    p[kb] = __builtin_amdgcn_mfma_f32_16x16x32_bf16(a, qf[ks], p[kb], 0, 0, 0);
                }
            }
            if (t * 64 + 63 > qb * 128 + 16 * w) {
#pragma unroll
                for (int kb = 0; kb < 4; ++kb)
#pragma unroll
                    for (int i = 0; i < 4; ++i) { const int kk = t * 64 + 16 * kb + 4 * g + i; if (kk > qidx) p[kb][i] = -1e30f; }
            }
            float mx = fmaxf(fmaxf(p[0][0], p[0][1]), fmaxf(p[0][2], p[0][3]));
#pragma unroll
            for (int kb = 1; kb < 4; ++kb) mx = fmaxf(mx, fmaxf(fmaxf(p[kb][0], p[kb][1]), fmaxf(p[kb][2], p[kb][3])));
            mx = fmaxf(mx, __shfl_xor(mx, 16)); mx = fmaxf(mx, __shfl_xor(mx, 32));
            const float mn = fmaxf(m, mx), alpha = fast_exp2(m - mn); m = mn;
            float rsum = 0.f;
#pragma unroll
            for (int kb = 0; kb < 4; ++kb)
#pragma unroll
                for (int i = 0; i < 4; ++i) { p[kb][i] = fast_exp2(p[kb][i] - mn); rsum += p[kb][i]; }
            l = l * alpha + rsum;
#pragma unroll
            for (int i = 0; i < 8; ++i) o[i] *= alpha;
            bf16x8 pb[2];
#pragma unroll
            for (int kk = 0; kk < 2; ++kk) {
                u32x4 pw; pw.x = cvt_pk_bf16(p[2 * kk][0], p[2 * kk][1]); pw.y = cvt_pk_bf16(p[2 * kk][2], p[2 * kk][3]);
                pw.z = cvt_pk_bf16(p[2 * kk + 1][0], p[2 * kk + 1][1]); pw.w = cvt_pk_bf16(p[2 * kk + 1][2], p[2 * kk + 1][3]);
                pb[kk] = __builtin_bit_cast(bf16x8, pw);
            }
#pragma unroll
            for (int db = 0; db < 8; ++db)
#pragma unroll
                for (int kk = 0; kk < 2; ++kk) {
                    const LAS unsigned char* vp = (const LAS unsigned char*)(Vb + vtr_off + (32 * kk) * VROW + db * 32);
                    const s16x4 lo = __builtin_bit_cast(s16x4, __builtin_amdgcn_ds_read_tr16_b64_v4i16((LAS s16x4*)vp));
                    const s16x4 hi = __builtin_bit_cast(s16x4, __builtin_amdgcn_ds_read_tr16_b64_v4i16((LAS s16x4*)(vp + 16 * VROW)));
                    const bf16x8 vf = __builtin_shufflevector(lo, hi, 0, 1, 2, 3, 4, 5, 6, 7);
                    o[db] = __builtin_amdgcn_mfma_f32_16x16x32_bf16(vf, pb[kk], o[db], 0, 0, 0);
                }
        }
        if (more) ATT_STORE((t + 1) & 1);
        __syncthreads();
    }
    l += __shfl_xor(l, 16); l += __shfl_xor(l, 32);
    const float inv = fast_rcp(l);
    bf16_t* orow = O + (size_t)qrow * QP + h * 128 + 4 * g;
#pragma unroll
    for (int db = 0; db < 8; ++db) {
        u32x2 wv; wv.x = cvt_pk_bf16(o[db][0] * inv, o[db][1] * inv); wv.y = cvt_pk_bf16(o[db][2] * inv, o[db][3] * inv);
        *(u32x2*)(orow + 16 * db) = wv;
    }
#undef ATT_LOAD
#undef ATT_STORE
}
__device__ __forceinline__ void attn_phase(int tid, const Params& P, unsigned char* lds) {
    bf16_t* Q = (bf16_t*)(P.ws + OFF_FF + FF_Q); const bf16_t* KV = (const bf16_t*)(P.ws + OFF_FF + FF_KV); const bf16_t* KR = (const bf16_t*)(P.ws + OFF_FF + FF_LAT) + 640;
    for (int pr = blockIdx.x; pr < 1024; pr += gridDim.x) {
        const int bh = pr >> 3, x = pr & 7, b = bh >> 3, h = bh & 7;
        attn_unit(tid, lds, Q, KV, KR, Q, b, h, 15 - x);
        attn_unit(tid, lds, Q, KV, KR, Q, b, h, x);
    }
}

constexpr int SROW = 576;
constexpr int SGU_STAT_OFF = 128 * SROW;
__device__ __forceinline__ void sgu_phase(int tid, const Params& P, unsigned char* lds, int j) {
    const int lane = tid & 63, w = __builtin_amdgcn_readfirstlane(tid >> 6), r = lane & 31, hh = lane >> 5;
    bf16_t* Z = (bf16_t*)(P.ws + OFF_FF);
    const float* lng = P.in[17] + j * 2048; const float* lnb = P.in[18] + j * 2048;
    const float* wsp = P.in[19] + (size_t)j * 8 * 128 * 128; const float* bsp = P.in[20] + j * 8 * 128;
    const int q4 = (lane & 15) >> 2, p4 = lane & 3, colblk = (lane >> 4) & 1;
    f32x2* stl = (f32x2*)(lds + SGU_STAT_OFF);
    for (int unit = blockIdx.x; unit < 256; unit += gridDim.x) {
        const int row0 = unit * 128;
        for (int rr = 0; rr < 16; ++rr) {
            const int row = 16 * w + rr; float s1 = 0.f, s2 = 0.f;
#pragma unroll
            for (int i = 0; i < 4; ++i) { float v[8]; unpack8(*(const u32x4*)(Z + (size_t)(row0 + row) * ZP + 2048 + 8 * lane + 512 * i), v);
#pragma unroll
                for (int e = 0; e < 8; ++e) { s1 += v[e]; s2 += v[e] * v[e]; } }
            s1 = wave_sum(s1); s2 = wave_sum(s2);
            const float mu = s1 * (1.0f / 2048), var = s2 * (1.0f / 2048) - mu * mu;
            if (lane == 0) stl[row] = (f32x2){mu, rsqrtf(fmaxf(var, 0.f) + EPS)};
        }
        __syncthreads();
        for (int g = 0; g < 8; ++g) {
#pragma unroll 2
            for (int i = 0; i < 8; ++i) {
                const int chunk = tid + 512 * i, row = chunk >> 5, ch = chunk & 31, col = g * 256 + ch * 8;
                float v[8]; unpack8(*(const u32x4*)(Z + (size_t)(row0 + row) * ZP + 2048 + col), v);
                const f32x2 st = stl[row]; const float mu = st.x, rstd = st.y;
                const f32x4 g0 = *(const f32x4*)(lng + col), g1 = *(const f32x4*)(lng + col + 4), b0 = *(const f32x4*)(lnb + col), b1 = *(const f32x4*)(lnb + col + 4);
#pragma unroll
                for (int e = 0; e < 4; ++e) { v[e] = (v[e] - mu) * rstd * g0[e] + b0[e]; v[4 + e] = (v[4 + e] - mu) * rstd * g1[e] + b1[e]; }
                *(u32x4*)(lds + row * SROW + ch * 16) = pack8(v);
            }
            __syncthreads();
            bf16x8 af[8];
#pragma unroll
            for (int ks = 0; ks < 8; ++ks) {
                const LAS unsigned char* vp = (const LAS unsigned char*)(lds + (16 * ks + 8 * hh + q4) * SROW + (32 * w + 16 * colblk + 4 * p4) * 2);
                const s16x4 lo = __builtin_bit_cast(s16x4, __builtin_amdgcn_ds_read_tr16_b64_v4i16((LAS s16x4*)vp));
                const s16x4 hi = __builtin_bit_cast(s16x4, __builtin_amdgcn_ds_read_tr16_b64_v4i16((LAS s16x4*)(vp + 4 * SROW)));
                af[ks] = __builtin_shufflevector(lo, hi, 0, 1, 2, 3, 4, 5, 6, 7);
            }
            const float* wg = wsp + (size_t)g * 128 * 128;
#pragma unroll
            for (int tb = 0; tb < 4; ++tb) {
                f32x16 acc;
#pragma unroll
                for (int e = 0; e < 16; ++e) acc[e] = 0.f;
                const int t = 32 * tb + r;
#pragma unroll
                for (int ks = 0; ks < 8; ++ks) {
                    if (ks <= 2 * tb + 1) {
                        const int s0 = 16 * ks + 8 * hh;
                        const f32x4 w0 = *(const f32x4*)(wg + t * 128 + s0), w1 = *(const f32x4*)(wg + t * 128 + s0 + 4);
                        float wv[8] = {w0[0], w0[1], w0[2], w0[3], w1[0], w1[1], w1[2], w1[3]};
#pragma unroll
                        for (int e = 0; e < 8; ++e) if (s0 + e > t) wv[e] = 0.f;
                        const bf16x8 bfr = __builtin_bit_cast(bf16x8, pack8(wv));
                        acc = __builtin_amdgcn_mfma_f32_32x32x16_bf16(af[ks], bfr, acc, 0, 0, 0);
                    }
                }
                const float bias = bsp[g * 128 + t];
                bf16_t* up = Z + (size_t)(row0 + t) * ZP + g * 256 + 32 * w + 4 * hh;
#pragma unroll
                for (int i4 = 0; i4 < 4; ++i4) {
                    const u32x2 uu = *(const u32x2*)(up + 8 * i4);
                    u32x2 y; y.x = cvt_pk_bf16(bflo(uu.x) * (acc[4 * i4] + bias), bfhi(uu.x) * (acc[4 * i4 + 1] + bias));
                    y.y = cvt_pk_bf16(bflo(uu.y) * (acc[4 * i4 + 2] + bias), bfhi(uu.y) * (acc[4 * i4 + 3] + bias));
                    *(u32x2*)(up + 8 * i4) = y;
                }
            }
            __syncthreads();
        }
    }
}

constexpr int NPHASE = 1 + 9 * DEPTH;
__device__ __forceinline__ int otid(int t) { asm volatile("" : "+v"(t)); return t; }
__device__ __forceinline__ Params load_params() {
    Params P{};
#if defined(__HIP_DEVICE_COMPILE__)
    typedef const __attribute__((address_space(4))) unsigned long long* kp_t;
    kp_t kp = (kp_t)__builtin_amdgcn_kernarg_segment_ptr(); asm volatile("" : "+s"(kp));
#pragma unroll
    for (int i = 0; i < 26; ++i) P.in[i] = (const float*)kp[i];
    P.out = (float*)kp[26]; P.ws = (unsigned char*)kp[27];
#endif
    return P;
}
__host__ __device__ __forceinline__ bool phase_nonempty(int ph) {
    if (ph == 0) return true;
    const int layer = (ph - 1) / 9, slot = (ph - 1) % 9;
    if ((layer & 1) && (slot == 3 || slot == 4)) return false;
    return true;
}

__global__ void __launch_bounds__(512) fwd_megakernel(Params Parg) {
    extern __shared__ __attribute__((aligned(16))) unsigned char lds[];
    LAS unsigned char* ldsl = (LAS unsigned char*)lds;
    const int wv0 = __builtin_amdgcn_readfirstlane((int)threadIdx.x >> 6);
    __builtin_amdgcn_fence(__ATOMIC_ACQUIRE, "agent");
    bool first = true;
    for (int ph = Parg.ph_lo; ph < Parg.ph_hi; ++ph) {
        if (!phase_nonempty(ph)) continue;
        if (!first) cg::this_grid().sync();
        first = false;
        const Params P = load_params();
        unsigned char* ws = P.ws;
        bf16_t* wb = (bf16_t*)(ws + OFF_W);
        bf16_t* hb = (bf16_t*)(ws + OFF_HB);
        float* SS = (float*)(ws + OFF_SS);
        const int G = gridDim.x, c = blockIdx.x;
        int tid; asm volatile("v_mbcnt_lo_u32_b32 %0, -1, 0\n\tv_mbcnt_hi_u32_b32 %0, -1, %0" : "=v"(tid)); tid = (tid + wv0 * 64) & 511;
#ifndef NO_P0
        if (ph == 0) { p0_prologue(otid(tid), P, lds); continue; }
#else
        if (ph == 0) continue;
#endif
        const int layer = (ph - 1) / 9, slot = (ph - 1) % 9, j = layer >> 1;
        const bool mla = (layer & 1) == 0;
        float* ss_mix = SS; float* ss_ffn = SS; float* ss_ple = SS;
        float* ss_next = (layer + 1 < DEPTH) ? SS : nullptr;
        const float* hin = (layer == 0) ? P.in[0] : P.out;
        pg8::StaticOrder S;
        if (slot == 0) {
            if (mla) {
                pg8::Gemm g{hb, wb + WE_DOWN + (size_t)j * LATP * DM, T, LATP, DM, DM}; S.init(T, LATP, G, c);
                pg8::EpiStore<0, 0> E{(bf16_t*)(ws + OFF_FF + FF_LAT), LATP, ss_mix, 1.0f / DM};
                pg8::gemm_phase(otid(tid), ldsl, g, S, E);
            } else {
                pg8::Gemm g{hb, wb + WE_GIN + (size_t)j * ZP * DM, T, ZP, DM, DM}; S.init(T, ZP, G, c);
                pg8::EpiStore<2, 0> E{(bf16_t*)(ws + OFF_FF), ZP, ss_mix, 1.0f / DM};
                pg8::gemm_phase(otid(tid), ldsl, g, S, E);
            }
        } else if (slot == 1) {
            if (mla) {
                { pg8::Gemm g{(const bf16_t*)(ws + OFF_FF + FF_LAT), wb + WE_UQ + (size_t)j * QP * QLR, T, QP, QLR, LATP}; S.init(T, QP, G, c);
                  pg8::EpiStore<0, 0> E{(bf16_t*)(ws + OFF_FF + FF_Q), QP, nullptr, 0.f};
                  pg8::gemm_phase(otid(tid), ldsl, g, S, E); }
                { pg8::Gemm g{(const bf16_t*)(ws + OFF_FF + FF_LAT) + QLR, wb + WE_UKV + (size_t)j * KVP * KVLR, T, KVP, KVLR, LATP}; S.init(T, KVP, G, c);
                  pg8::EpiStore<0, 0> E{(bf16_t*)(ws + OFF_FF + FF_KV), KVP, nullptr, 0.f};
                  pg8::gemm_phase(otid(tid), ldsl, g, S, E); }
            } else {
#ifndef NO_SGU
                sgu_phase(otid(tid), P, lds, j);
#endif
            }
        } else if (slot == 2) {
            if (mla) {
#ifndef NO_R2
                r2_phase(otid(tid), P, j);
#endif
            } else {
                pg8::Gemm g{(const bf16_t*)(ws + OFF_FF), wb + WE_GOUT + (size_t)j * DM * 2048, T, DM, 2048, ZP}; S.init(T, DM, G, c);
                pg8::EpiRes<0> E{hin, P.out, hb, ss_ffn, nullptr};
                pg8::gemm_phase(otid(tid), ldsl, g, S, E);
            }
        } else if (slot == 3) {
#ifndef NO_ATT
            attn_phase(otid(tid), P, lds);
#endif
        } else if (slot == 4) {
            pg8::Gemm g{(const bf16_t*)(ws + OFF_FF + FF_Q), wb + WE_MOUT + (size_t)j * DM * DM, T, DM, DM, QP}; S.init(T, DM, G, c);
            pg8::EpiRes<0> E{hin, P.out, hb, ss_ffn, nullptr};
            pg8::gemm_phase(otid(tid), ldsl, g, S, E);
        } else if (slot == 5) {
            pg8::Gemm g{hb, wb + WE_UP + (size_t)layer * DFF * DM, T, DFF, DM, DM}; S.init(T, DFF, G, c);
            pg8::EpiStore<1, 0> E{(bf16_t*)(ws + OFF_FF), DFF, ss_ffn, 1.0f / DM};
            pg8::gemm_phase(otid(tid), ldsl, g, S, E);
        } else if (slot == 6) {
            pg8::Gemm g{(const bf16_t*)(ws + OFF_FF), wb + WE_DN + (size_t)layer * DM * DFF, T, DM, DFF, DFF}; S.init(T, DM, G, c);
            pg8::EpiRes<0> E{P.out, P.out, hb, ss_ple, nullptr};
            pg8::gemm_phase(otid(tid), ldsl, g, S, E);
        } else if (slot == 7) {
            pg8::Gemm g{hb, wb + WE_GATE + (size_t)layer * DM * DM, T, DM, DM, DM}; S.init(T, DM, G, c);
            pg8::EpiStore<3, 0> E{(bf16_t*)(ws + OFF_FF), DM, ss_ple, 1.0f / DM};
            pg8::gemm_phase(otid(tid), ldsl, g, S, E);
        } else {
            pg8::Gemm g{(const bf16_t*)(ws + OFF_PB) + (size_t)layer * T * PLE, wb + WE_PROJ + (size_t)layer * DM * PLE, T, DM, PLE, PLE}; S.init(T, DM, G, c);
            pg8::EpiRes<1> E{P.out, P.out, hb, ss_next, (const bf16_t*)(ws + OFF_FF)};
            pg8::gemm_phase(otid(tid), ldsl, g, S, E);
        }
    }
    asm volatile("s_waitcnt vmcnt(0)" ::: "memory");
    __builtin_amdgcn_fence(__ATOMIC_RELEASE, "agent");
    asm volatile("s_waitcnt vmcnt(0)" ::: "memory");
}


#ifdef DBG_CHECK
__global__ void dbg_check(const bf16_t* A, int lda, const bf16_t* Bt, int K, const bf16_t* C, int ldc, int N, const float* ss, int act, float* out) {
    const unsigned s = blockIdx.x * blockDim.x + threadIdx.x;
    const unsigned hsh = s * 2654435761u; const int row = (hsh >> 8) % T; const int col = (s * 40503u + (hsh >> 3)) % N;
    float acc = 0.f;
    for (int k = 0; k < K; ++k) acc += bf2f(A[(size_t)row * lda + k]) * bf2f(Bt[(size_t)col * K + k]);
    if (ss) acc *= rsqrtf(ss[row] * (1.0f / DM) + EPS);
    if (act == 3) acc = 1.0f / (1.0f + expf(-acc));
    if (act == 1) { acc = fmaxf(acc, 0.f); acc *= acc; }
    const float got = bf2f(C[(size_t)row * ldc + col]);
    if (!(fabsf(got - acc) <= 0.03f + 0.03f * fabsf(acc))) atomicAdd(out + 4096, 1.0f);
}
#endif

#ifdef DBG_CHECK
__global__ void dbg_check_ss(const float* h, const float* ss, float* out) {
    const int row = blockIdx.x * blockDim.x + threadIdx.x; if (row >= T) return;
    float a = 0.f; for (int k = 0; k < DM; ++k) { const float v = h[(size_t)row * DM + k]; a += v * v; }
    const float got = ss[row];
    if (!(fabsf(got - a) <= 1e-3f * fabsf(a))) out[(size_t)row * DM] = 1e30f;
}
#endif

#ifdef DBG_CHECK
__global__ void dbg_zero(float* out) { out[4096 + threadIdx.x] = 0.f; out[8192 + threadIdx.x] = 0.f; }
__global__ void dbg_reduce(float* out) {
    float bc = 0.f, br = 0.f; int ic = 0, ir = 0;
    for (int i = 0; i < 256; ++i) { if (out[4096 + i] > bc) { bc = out[4096 + i]; ic = i; } if (out[8192 + i] > br) { br = out[8192 + i]; ir = i; } }
    float v = 1e6f * out[4096];
    for (int i = 0; i < 256; ++i) { out[4096 + i] = 0.f; out[8192 + i] = 0.f; }
    out[0] = v; out[1] = 1e-3f * bc; out[2] = 1e-3f * br;
}
#endif
constexpr int LDS_BYTES = 131072;
extern "C" void kernel_launch(void* const* d_in, const int* in_sizes, int n_in, void* d_out, int out_size, void* d_ws, size_t ws_size, hipStream_t stream) {
    static int grid = 0;
    if (grid == 0) {
        if (n_in != 26 || out_size != T * DM || ws_size < WS_NEED) { fprintf(stderr, "kernel_launch: unexpected problem (n_in %d out %d ws %zu)\n", n_in, out_size, ws_size); grid = -1; return; }
        int dev = 0, cus = 0, per_cu = 0;
        hipGetDevice(&dev); hipDeviceGetAttribute(&cus, hipDeviceAttributeMultiprocessorCount, dev);
        hipFuncSetAttribute((const void*)fwd_megakernel, hipFuncAttributeMaxDynamicSharedMemorySize, LDS_BYTES);
        hipOccupancyMaxActiveBlocksPerMultiprocessor(&per_cu, (const void*)fwd_megakernel, 512, LDS_BYTES);
        if (per_cu < 1) { fprintf(stderr, "kernel_launch: occupancy query says %d blocks/CU\n", per_cu); per_cu = 1; }
        (void)hipGetLastError();
        grid = cus;
    }
    if (grid < 0) return;
    Params p{};
    for (int i = 0; i < 26; ++i) p.in[i] = (const float*)d_in[i];
    p.out = (float*)d_out; p.ws = (unsigned char*)d_ws;
#if ONE_LAUNCH
    p.ph_lo = 0; p.ph_hi = NPHASE;
    for (int rep = 0; rep < DBG_REPS; ++rep)
    { void* args[] = {&p}; hipError_t e = hipLaunchCooperativeKernel((const void*)fwd_megakernel, dim3(grid), dim3(512), args, LDS_BYTES, stream);
      if (e != hipSuccess) fprintf(stderr, "cooperative launch failed: %s (grid %d)\n", hipGetErrorString(e), grid); }
#else
#ifndef DBG_STOP
#define DBG_STOP (NPHASE - 1)
#endif
    for (int ph = 0; ph <= DBG_STOP; ++ph) {
        if (!phase_nonempty(ph)) continue;
        p.ph_lo = ph; p.ph_hi = ph + 1;
#ifdef DBG_NANFILL
        if (ph == DBG_NANFILL) (void)hipMemsetAsync((char*)d_ws + OFF_FF, 0xFF, 64 * MiB, stream);
#endif
        void* args[] = {&p}; hipError_t e = hipLaunchCooperativeKernel((const void*)fwd_megakernel, dim3(grid), dim3(512), args, LDS_BYTES, stream);
        if (e != hipSuccess) { fprintf(stderr, "cooperative launch failed: %s (grid %d, phase %d)\n", hipGetErrorString(e), grid, ph); break; }
    }
#ifdef DBG_CHECK
    { unsigned char* ws = (unsigned char*)d_ws; bf16_t* wb = (bf16_t*)(ws + OFF_W);
      dbg_zero<<<1, 256, 0, stream>>>((float*)d_out); DBG_CHECK; dbg_reduce<<<1, 1, 0, stream>>>((float*)d_out); }
#endif
#endif
}
```

```cpp
#include <hip/hip_runtime.h>
#include <hip/hip_cooperative_groups.h>
#include <cstdio>
#include <cstdint>
namespace cg = cooperative_groups;

#ifndef DBG_NOGATE
#define DBG_NOGATE 0
#endif
#ifndef DBG_GATE_NOSS
#define DBG_GATE_NOSS 0
#endif
#ifndef DBG_REPS
#define DBG_REPS 1
#endif
#ifndef ONE_LAUNCH
#define ONE_LAUNCH 1
#endif

#define LAS __attribute__((address_space(3)))
typedef unsigned short bf16_t;
typedef short bf16x8 __attribute__((ext_vector_type(8)));
typedef short s16x4 __attribute__((ext_vector_type(4)));
typedef float f32x4 __attribute__((ext_vector_type(4)));
typedef float f32x2 __attribute__((ext_vector_type(2)));
typedef float f32x16 __attribute__((ext_vector_type(16)));
typedef unsigned u32x4 __attribute__((ext_vector_type(4)));
typedef unsigned u32x2 __attribute__((ext_vector_type(2)));

constexpr int T = 32768, DM = 1024, SEQ = 2048, NB = 16, DFF = 4096, PLE = 256, DEPTH = 4;
constexpr int NH = 8, QLR = 384, KVLR = 256, ROPE = 64, LATP = 768;
constexpr int QP = 1536, KVP = 2048, ZP = 4096;
constexpr float EPS = 1e-6f;
constexpr float QSCALE = 0.07216878364870322f * 1.4426950408889634f;

constexpr size_t MiB = 1u << 20;
constexpr size_t OFF_SS = 0;
constexpr size_t OFF_W = 2621440;
constexpr size_t OFF_HB = 112 * MiB;
constexpr size_t OFF_FF = 176 * MiB;
constexpr size_t OFF_PB = 448 * MiB;
constexpr size_t WS_NEED = 512 * MiB;
constexpr size_t OFF_BAR = 2 * MiB;
#define XCD_BAR_WORDS 3456
constexpr size_t WE_DOWN = 0, WE_UQ = WE_DOWN + 2ull * LATP * DM, WE_UKV = WE_UQ + 2ull * QP * QLR, WE_MOUT = WE_UKV + 2ull * KVP * KVLR,
                 WE_GIN = WE_MOUT + 2ull * DM * DM, WE_GOUT = WE_GIN + 2ull * ZP * DM, WE_UP = WE_GOUT + 2ull * DM * 2048,
                 WE_DN = WE_UP + 4ull * DFF * DM, WE_GATE = WE_DN + 4ull * DM * DFF, WE_PROJ = WE_GATE + 4ull * DM * DM, WE_END = WE_PROJ + 4ull * DM * PLE;
static_assert(OFF_W + WE_END * 2 <= OFF_HB, "weights fit");
constexpr size_t FF_Q = 0, FF_KV = 96 * MiB, FF_LAT = 224 * MiB;

struct Params { const float* in[26]; float* out; unsigned char* ws; int ph_lo, ph_hi; };

typedef __bf16 bf16x2_t __attribute__((ext_vector_type(2)));
__device__ __forceinline__ unsigned cvt_pk_bf16(float lo, float hi) { const f32x2 v = {lo, hi}; return __builtin_bit_cast(unsigned, __builtin_convertvector(v, bf16x2_t)); }
__device__ __forceinline__ float bf2f(unsigned short b) { return __uint_as_float((unsigned)b << 16); }
__device__ __forceinline__ float bflo(unsigned u) { return __uint_as_float(u << 16); }
__device__ __forceinline__ float bfhi(unsigned u) { return __uint_as_float(u & 0xffff0000u); }
__device__ __forceinline__ float fast_rcp(float x) { return __builtin_amdgcn_rcpf(x); }
__device__ __forceinline__ float fast_exp2(float x) { return __builtin_amdgcn_exp2f(x); }
__device__ __forceinline__ float gelu_tanh(float x) { const float y = x + 0.044715f * x * x * x; return x * fast_rcp(1.0f + fast_exp2(-2.3022082f * y)); }
__device__ __forceinline__ float sigmoidf_(float x) { return fast_rcp(1.0f + fast_exp2(-1.4426950409f * x)); }

namespace pg8 {
constexpr int BM = 256, BK = 64, HALF = 128, HTB = HALF * BK * 2, STAGE_BYTES = 8 * HTB, NXCD = 8, WGM = 8;
__host__ __device__ __forceinline__ int lds_byte(int r, int c) { const int st = (r >> 4) * 2 + (c >> 5), rr = r & 15, cc = c & 31, ob = rr * 64 + cc * 2; return st * 1024 + (ob ^ (((ob >> 9) & 1) << 5)); }
__host__ __device__ __forceinline__ void stage_rc(int b, int& R, int& C) { const int st = b / 1024, sb = b % 1024, swz = sb ^ (((sb >> 9) & 1) << 5); R = (st >> 1) * 16 + swz / 64; C = (st & 1) * 32 + (swz % 64) / 2; }
__host__ __device__ __forceinline__ int perm32(int rho) { const int n = rho >> 4, i = rho & 15; return 8 * (i >> 2) + 4 * n + (i & 3); }
struct Unit { int pm, pn; };
struct Gemm { const bf16_t* A; const bf16_t* Bt; int M, N, K, lda; };
struct StaticOrder {
    int nM, nN, nwg, G, c;
    __device__ void init(int M, int N, int G_, int c_) { nM = M / BM; nN = N / BM; nwg = nM * nN; G = G_; c = c_; }
    __device__ bool next(int i, Unit& u) const {
        const long L = (long)i * G + c; if (L >= nwg) return false;
        int wgid = (int)L; { const int q = nwg / NXCD, r = nwg % NXCD, xcd = wgid % NXCD, off = wgid / NXCD; wgid = (xcd < r ? xcd * (q + 1) : r * (q + 1) + (xcd - r) * q) + off; }
        const int nig = WGM * nN, gid = wgid / nig, fm = gid * WGM, gsz = (nM - fm) < WGM ? (nM - fm) : WGM;
        u.pm = fm + ((wgid % nig) % gsz); u.pn = (wgid % nig) / gsz; return true;
    }
};

template <int ACT, int STATS> struct EpiStore {
    static constexpr bool PERM = true;
    bf16_t* O; int ldc; const float* ss; float inv_n;
    __device__ __forceinline__ void operator()(const f32x4 (&acc)[2][2][4][2], const Unit& u, int wr, int wc, int fr, int fq) const {
        const int row0 = u.pm * BM + wr * 64 + fr, col0 = u.pn * BM + wc * 32 + 8 * fq;
#pragma unroll
        for (int ai = 0; ai < 2; ++ai)
#pragma unroll
            for (int m = 0; m < 4; ++m) {
                const int row = row0 + ai * HALF + m * 16;
                float rs = 1.0f;
                if (ss) { const f32x4* sp = (const f32x4*)(ss + (size_t)row * 16); const f32x4 a = sp[0], b = sp[1], c = sp[2], d = sp[3];
                    const float t = (((a[0] + a[1]) + (a[2] + a[3])) + ((b[0] + b[1]) + (b[2] + b[3]))) + (((c[0] + c[1]) + (c[2] + c[3])) + ((d[0] + d[1]) + (d[2] + d[3])));
                    rs = rsqrtf(t * inv_n + EPS); }
#pragma unroll
                for (int bj = 0; bj < 2; ++bj) {
                    f32x4 v0 = acc[ai][bj][m][0] * rs, v1 = acc[ai][bj][m][1] * rs;
                    if (ACT == 1) {
#pragma unroll
                        for (int e = 0; e < 4; ++e) { const float a = fmaxf(v0[e], 0.f), b = fmaxf(v1[e], 0.f); v0[e] = a * a; v1[e] = b * b; }
                    }
                    if (ACT == 2) {
#pragma unroll
                        for (int e = 0; e < 4; ++e) { v0[e] = gelu_tanh(v0[e]); v1[e] = gelu_tanh(v1[e]); }
                    }
                    if (ACT == 3) {
#pragma unroll
                        for (int e = 0; e < 4; ++e) { v0[e] = sigmoidf_(v0[e]); v1[e] = sigmoidf_(v1[e]); }
                    }
                    u32x4 w; w.x = cvt_pk_bf16(v0[0], v0[1]); w.y = cvt_pk_bf16(v0[2], v0[3]); w.z = cvt_pk_bf16(v1[0], v1[1]); w.w = cvt_pk_bf16(v1[2], v1[3]);
                    *(u32x4*)(O + (size_t)row * ldc + col0 + bj * HALF) = w;
                }
                asm volatile("" ::: "memory");
            }
    }
};
template <int MODE> struct EpiRes {
    static constexpr bool PERM = true;
    const float* hin; float* hout; bf16_t* hb; float* ssn; const bf16_t* pp;
    __device__ __forceinline__ void operator()(const f32x4 (&acc)[2][2][4][2], const Unit& u, int wr, int wc, int fr, int fq) const {
        const int row0 = u.pm * BM + wr * 64 + fr, col0 = u.pn * BM + wc * 32 + 8 * fq;
#pragma unroll
        for (int ai = 0; ai < 2; ++ai)
#pragma unroll
            for (int m = 0; m < 4; ++m) {
                const int row = row0 + ai * HALF + m * 16;
                float q = 0.f;
#pragma unroll
                for (int bj = 0; bj < 2; ++bj) {
                    const size_t off = (size_t)row * DM + col0 + bj * HALF;
                    f32x4 v0 = acc[ai][bj][m][0], v1 = acc[ai][bj][m][1];
                    const f32x4 h0 = *(const f32x4*)(hin + off), h1 = *(const f32x4*)(hin + off + 4);
                    if (MODE == 1 && !DBG_NOGATE) {
                        const u32x4 pw = *(const u32x4*)(pp + off);
                        v0[0] *= bflo(pw.x); v0[1] *= bfhi(pw.x); v0[2] *= bflo(pw.y); v0[3] *= bfhi(pw.y);
                        v1[0] *= bflo(pw.z); v1[1] *= bfhi(pw.z); v1[2] *= bflo(pw.w); v1[3] *= bfhi(pw.w);
                    }
                    v0 += h0; v1 += h1;
                    *(f32x4*)(hout + off) = v0; *(f32x4*)(hout + off + 4) = v1;
                    u32x4 w; w.x = cvt_pk_bf16(v0[0], v0[1]); w.y = cvt_pk_bf16(v0[2], v0[3]); w.z = cvt_pk_bf16(v1[0], v1[1]); w.w = cvt_pk_bf16(v1[2], v1[3]);
                    *(u32x4*)(hb + off) = w;
                    q += (v0[0] * v0[0] + v0[1] * v0[1]) + (v0[2] * v0[2] + v0[3] * v0[3]) + (v1[0] * v1[0] + v1[1] * v1[1]) + (v1[2] * v1[2] + v1[3] * v1[3]);
                }
                if (ssn) { q += __shfl_xor(q, 16); q += __shfl_xor(q, 32); if (fq == 0) ssn[(size_t)row * 16 + u.pn * 4 + wc] = q; }
                asm volatile("" ::: "memory");
            }
    }
};

#ifndef PG8_SP2
#define PG8_SP2 true
#endif
#ifndef PG8_ALIGN
#define PG8_ALIGN true
#endif
template <class Epi, bool ALIGN_EPI = PG8_ALIGN, bool SP2 = PG8_SP2>
__device__ __forceinline__ void gemm_phase(int tid, LAS unsigned char* lds, const Gemm g, const StaticOrder& S, const Epi& E) {
    const int wid = __builtin_amdgcn_readfirstlane(tid >> 6), lane = tid & 63, wr = wid >> 2, wc = wid & 3, fr = lane & 15, fq = lane >> 4;
    const int K = g.K, nt = K / BK, lda = g.lda;
    unsigned voffA[2], voffB[2];
#pragma unroll
    for (int i = 0; i < 2; ++i) { int R, C; stage_rc(tid * 16 + i * 8192, R, C); const int Rb = Epi::PERM ? ((R & ~31) + perm32(R & 31)) : R;
        voffA[i] = (unsigned)(R * lda + C) * 2u; voffB[i] = (unsigned)(Rb * K + C) * 2u; }
    const size_t kstep = (size_t)(BK * 2);
    const size_t hstepA = (size_t)HALF * lda * 2, hstepB = (size_t)HALF * K * 2;
    const size_t tstepA = 2 * hstepA, tstepB = 2 * hstepB;
    const unsigned ldsw = (unsigned)wid * 1024u;
    const int aoff = lds_byte(wr * 64 + fr, fq * 8), boff = lds_byte(wc * 32 + fr, fq * 8);
#define PG8_SA(b, h) (((b) * 2 + (h)) * HTB)
#define PG8_SB(b, h) ((4 + (b) * 2 + (h)) * HTB)
#define PG8_STAGE(bufoff, gbase, voff) do { _Pragma("unroll") for (int _i = 0; _i < 2; ++_i) \
        __builtin_amdgcn_global_load_lds((const unsigned*)((const char*)(gbase) + (voff)[_i]), (LAS unsigned*)(lds + (bufoff) + ldsw + _i * 8192), 16, 0, 0); } while (0)
#define PG8_LDA(dst, b, h) do { _Pragma("unroll") for (int m = 0; m < 4; ++m) _Pragma("unroll") for (int k = 0; k < 2; ++k) dst[m][k] = *(const LAS bf16x8*)(lds + PG8_SA(b, h) + aoff + m * 2048 + k * 1024); } while (0)
#define PG8_LDB(dst, b, h) do { _Pragma("unroll") for (int n = 0; n < 2; ++n) _Pragma("unroll") for (int k = 0; k < 2; ++k) dst[n][k] = *(const LAS bf16x8*)(lds + PG8_SB(b, h) + boff + n * 2048 + k * 1024); } while (0)
#define PG8_MMA(ai, bj, At, Bt) do { __builtin_amdgcn_s_setprio(1); _Pragma("unroll") for (int m = 0; m < 4; ++m) _Pragma("unroll") for (int n = 0; n < 2; ++n) _Pragma("unroll") for (int k = 0; k < 2; ++k) \
        acc[ai][bj][m][n] = __builtin_amdgcn_mfma_f32_16x16x32_bf16(Bt[n][k], At[m][k], acc[ai][bj][m][n], 0, 0, 0); __builtin_amdgcn_s_setprio(0); } while (0)
#define PG8_WAIT_V(n) asm volatile("s_waitcnt vmcnt(" #n ")" ::: "memory")
#define PG8_WAIT_L(n) asm volatile("s_waitcnt lgkmcnt(" #n ")" ::: "memory")
#define PG8_BAR __builtin_amdgcn_s_barrier()
#define PG8_SCHED __builtin_amdgcn_sched_barrier(0)
    Unit cur, nxt; int ui = 0;
    if (!S.next(0, cur)) return;
    f32x4 acc[2][2][4][2];
#pragma unroll
    for (int a = 0; a < 2; ++a)
#pragma unroll
        for (int b = 0; b < 2; ++b)
#pragma unroll
            for (int m = 0; m < 4; ++m)
#pragma unroll
                for (int n = 0; n < 2; ++n) acc[a][b][m][n] = (f32x4){0.f, 0.f, 0.f, 0.f};
    bf16x8 At[4][2], B0[2][2], B1[2][2];
    const char* cA = (const char*)g.A + (size_t)cur.pm * tstepA; const char* cB = (const char*)g.Bt + (size_t)cur.pn * tstepB;
    if constexpr (SP2) {
    PG8_STAGE(PG8_SB(0, 0), cB, voffB); PG8_STAGE(PG8_SB(0, 1), cB + hstepB, voffB); PG8_STAGE(PG8_SA(0, 0), cA, voffA); PG8_STAGE(PG8_SA(0, 1), cA + hstepA, voffA);
    if (wr == 1) PG8_BAR;
    PG8_WAIT_V(2); PG8_BAR;
    PG8_STAGE(PG8_SB(1, 0), cB + kstep, voffB); PG8_STAGE(PG8_SA(1, 0), cA + kstep, voffA); PG8_STAGE(PG8_SB(1, 1), cB + hstepB + kstep, voffB);
    PG8_WAIT_V(6); PG8_BAR;
    } else {
    PG8_STAGE(PG8_SB(0, 0), cB, voffB); PG8_STAGE(PG8_SA(0, 0), cA, voffA); PG8_STAGE(PG8_SB(0, 1), cB + hstepB, voffB); PG8_STAGE(PG8_SA(0, 1), cA + hstepA, voffA);
    if (wr == 1) PG8_BAR;
    PG8_WAIT_V(4); PG8_BAR;
    PG8_STAGE(PG8_SB(1, 0), cB + kstep, voffB); PG8_STAGE(PG8_SA(1, 0), cA + kstep, voffA); PG8_STAGE(PG8_SB(1, 1), cB + hstepB + kstep, voffB);
    PG8_WAIT_V(6); PG8_BAR;
    }
    for (;;) {
        const bool has_next = S.next(ui + 1, nxt);
        const char* nA = has_next ? (const char*)g.A + (size_t)nxt.pm * tstepA : cA; const char* nB = has_next ? (const char*)g.Bt + (size_t)nxt.pn * tstepB : cB;
        for (int t = 0; t < nt; t += 2) {
            const bool last = (t == nt - 2);
            const char* a1 = cA + (size_t)(t + 1) * kstep;
            const char* a2 = last ? nA : cA + (size_t)(t + 2) * kstep; const char* b2 = last ? nB : cB + (size_t)(t + 2) * kstep;
            const char* a3 = a2 + kstep; const char* b3 = b2 + kstep;
            if constexpr (SP2) {
            PG8_LDB(B0, 0, 0); PG8_LDB(B1, 0, 1); PG8_SCHED; PG8_LDA(At, 0, 0); PG8_STAGE(PG8_SA(1, 1), a1 + hstepA, voffA);
            PG8_WAIT_V(8); PG8_WAIT_L(0); PG8_BAR; PG8_MMA(0, 0, At, B0); PG8_MMA(0, 1, At, B1); PG8_BAR; PG8_SCHED;
            PG8_LDA(At, 0, 1); PG8_STAGE(PG8_SB(0, 0), b2, voffB); PG8_STAGE(PG8_SB(0, 1), b2 + hstepB, voffB); PG8_STAGE(PG8_SA(0, 0), a2, voffA);
            PG8_WAIT_V(8); PG8_WAIT_L(0); PG8_BAR; PG8_MMA(1, 0, At, B0); PG8_MMA(1, 1, At, B1); PG8_BAR; PG8_SCHED;
            PG8_LDB(B0, 1, 0); PG8_LDB(B1, 1, 1); PG8_SCHED; PG8_LDA(At, 1, 0); PG8_STAGE(PG8_SA(0, 1), a2 + hstepA, voffA);
            PG8_WAIT_V(8); PG8_WAIT_L(0); PG8_BAR; PG8_MMA(0, 0, At, B0); PG8_MMA(0, 1, At, B1); PG8_BAR; PG8_SCHED;
            PG8_LDA(At, 1, 1); PG8_STAGE(PG8_SB(1, 0), b3, voffB); PG8_STAGE(PG8_SB(1, 1), b3 + hstepB, voffB); PG8_STAGE(PG8_SA(1, 0), a3, voffA);
            PG8_WAIT_V(8); PG8_WAIT_L(0); PG8_BAR; PG8_MMA(1, 0, At, B0); PG8_MMA(1, 1, At, B1); PG8_BAR; PG8_SCHED;
            } else {
            PG8_LDB(B0, 0, 0); PG8_SCHED; PG8_LDA(At, 0, 0); PG8_STAGE(PG8_SA(1, 1), a1 + hstepA, voffA);
            PG8_WAIT_L(8); PG8_BAR; PG8_WAIT_L(0); PG8_MMA(0, 0, At, B0); PG8_BAR; PG8_SCHED;
            PG8_LDB(B1, 0, 1); PG8_STAGE(PG8_SB(0, 0), b2, voffB);
            PG8_BAR; PG8_WAIT_L(0); PG8_MMA(0, 1, At, B1); PG8_BAR;
            PG8_LDA(At, 0, 1); PG8_STAGE(PG8_SA(0, 0), a2, voffA);
            PG8_BAR; PG8_WAIT_L(0); PG8_MMA(1, 0, At, B0); PG8_BAR; PG8_SCHED;
            PG8_STAGE(PG8_SB(0, 1), b2 + hstepB, voffB);
            PG8_WAIT_V(6); PG8_BAR; PG8_MMA(1, 1, At, B1); PG8_BAR;
            PG8_LDB(B0, 1, 0); PG8_SCHED; PG8_LDA(At, 1, 0); PG8_STAGE(PG8_SA(0, 1), a2 + hstepA, voffA);
            PG8_WAIT_L(8); PG8_BAR; PG8_WAIT_L(0); PG8_MMA(0, 0, At, B0); PG8_BAR; PG8_SCHED;
            PG8_LDB(B1, 1, 1); PG8_STAGE(PG8_SB(1, 0), b3, voffB);
            PG8_BAR; PG8_WAIT_L(0); PG8_MMA(0, 1, At, B1); PG8_BAR;
            PG8_LDA(At, 1, 1); PG8_STAGE(PG8_SA(1, 0), a3, voffA);
            PG8_BAR; PG8_WAIT_L(0); PG8_MMA(1, 0, At, B0); PG8_BAR; PG8_SCHED;
            PG8_STAGE(PG8_SB(1, 1), b3 + hstepB, voffB);
            PG8_WAIT_V(6); PG8_BAR; PG8_MMA(1, 1, At, B1); PG8_BAR;
            }
        }
        if constexpr (ALIGN_EPI) { if (wr == 0) PG8_BAR; }
        E(acc, cur, wr, wc, fr, fq);
        if (!has_next) break;
#pragma unroll
        for (int a = 0; a < 2; ++a)
#pragma unroll
            for (int b = 0; b < 2; ++b)
#pragma unroll
                for (int m = 0; m < 4; ++m)
#pragma unroll
                    for (int n = 0; n < 2; ++n) acc[a][b][m][n] = (f32x4){0.f, 0.f, 0.f, 0.f};
        cur = nxt; cA = nA; cB = nB; ++ui;
        if constexpr (ALIGN_EPI) { if (wr == 1) PG8_BAR; }
    }
    PG8_WAIT_V(0);
    if constexpr (!ALIGN_EPI) { if (wr == 0) PG8_BAR; }
    PG8_BAR;
#undef PG8_SA
#undef PG8_SB
#undef PG8_STAGE
#undef PG8_LDA
#undef PG8_LDB
#undef PG8_MMA
#undef PG8_WAIT_V
#undef PG8_WAIT_L
#undef PG8_BAR
#undef PG8_SCHED
}
}

__constant__ double kInvFreq[32] = {
    1.0, 0.7498942093324559, 0.5623413251903491, 0.4216965034285822, 0.31622776601683794, 0.23713737056616552, 0.1778279410038923, 0.1333521432163324,
    0.1, 0.07498942093324558, 0.05623413251903491, 0.04216965034285822, 0.03162277660168379, 0.023713737056616554, 0.01778279410038923, 0.01333521432163324,
    0.01, 0.007498942093324558, 0.005623413251903491, 0.004216965034285823, 0.0031622776601683794, 0.0023713737056616554, 0.001778279410038923, 0.001333521432163324,
    0.001, 0.0007498942093324559, 0.0005623413251903491, 0.0004216965034285823, 0.00031622776601683794, 0.00023713737056616554, 0.0001778279410038923, 0.0001333521432163324};

__device__ __forceinline__ float wave_sum(float v) {
#pragma unroll
    for (int o = 1; o < 64; o <<= 1) v += __shfl_xor(v, o);
    return v;
}
__device__ __forceinline__ void unpack8(const u32x4 w, float (&f)[8]) { f[0] = bflo(w.x); f[1] = bfhi(w.x); f[2] = bflo(w.y); f[3] = bfhi(w.y); f[4] = bflo(w.z); f[5] = bfhi(w.z); f[6] = bflo(w.w); f[7] = bfhi(w.w); }
__device__ __forceinline__ u32x4 pack8(const float (&f)[8]) { u32x4 w; w.x = cvt_pk_bf16(f[0], f[1]); w.y = cvt_pk_bf16(f[2], f[3]); w.z = cvt_pk_bf16(f[4], f[5]); w.w = cvt_pk_bf16(f[6], f[7]); return w; }

struct WDesc { const float* W; const float* gamma; bf16_t* dst; int K, N, Npad, mode, items; };
__device__ __forceinline__ WDesc wdesc(const Params& P, int id) {
    WDesc d; bf16_t* wb = (bf16_t*)(P.ws + OFF_W); d.gamma = nullptr; d.mode = 0;
    if (id < 12) {
        const int j = id & 1, f = id >> 1;
        switch (f) {
            case 0: d.W = P.in[6] + (size_t)j * DM * 704; d.K = DM; d.N = 704; d.Npad = LATP; d.dst = wb + WE_DOWN + (size_t)j * LATP * DM; d.gamma = P.in[3] + (2 * j) * DM; break;
            case 1: d.W = P.in[9] + (size_t)j * QLR * QP; d.K = QLR; d.N = QP; d.Npad = QP; d.dst = wb + WE_UQ + (size_t)j * QP * QLR; d.gamma = P.in[7] + j * QLR; d.mode = 1; break;
            case 2: d.W = P.in[10] + (size_t)j * KVLR * KVP; d.K = KVLR; d.N = KVP; d.Npad = KVP; d.dst = wb + WE_UKV + (size_t)j * KVP * KVLR; d.gamma = P.in[8] + j * KVLR; break;
            case 3: d.W = P.in[15] + (size_t)j * DM * DM; d.K = DM; d.N = DM; d.Npad = DM; d.dst = wb + WE_MOUT + (size_t)j * DM * DM; break;
            case 4: d.W = P.in[16] + (size_t)j * DM * ZP; d.K = DM; d.N = ZP; d.Npad = ZP; d.dst = wb + WE_GIN + (size_t)j * ZP * DM; d.gamma = P.in[3] + (2 * j + 1) * DM; break;
            default: d.W = P.in[21] + (size_t)j * 2048 * DM; d.K = 2048; d.N = DM; d.Npad = DM; d.dst = wb + WE_GOUT + (size_t)j * DM * 2048; break;
        }
    } else {
        const int i = (id - 12) & 3, f = (id - 12) >> 2;
        switch (f) {
            case 0: d.W = P.in[22] + (size_t)i * DM * DFF; d.K = DM; d.N = DFF; d.Npad = DFF; d.dst = wb + WE_UP + (size_t)i * DFF * DM; d.gamma = P.in[4] + i * DM; break;
            case 1: d.W = P.in[23] + (size_t)i * DFF * DM; d.K = DFF; d.N = DM; d.Npad = DM; d.dst = wb + WE_DN + (size_t)i * DM * DFF; break;
            case 2: d.W = P.in[24] + (size_t)i * DM * DM; d.K = DM; d.N = DM; d.Npad = DM; d.dst = wb + WE_GATE + (size_t)i * DM * DM; d.gamma = P.in[5] + i * DM; break;
            default: d.W = P.in[25] + (size_t)i * PLE * DM; d.K = PLE; d.N = DM; d.Npad = DM; d.dst = wb + WE_PROJ + (size_t)i * DM * PLE; break;
        }
    }
    d.items = (d.K / 64) * (d.Npad / 32);
    return d;
}
__device__ __forceinline__ void conv_item(const WDesc& d, int item, float* scr, int lane) {
    const int nblk = d.Npad / 32, kb = item / nblk, nb = item % nblk, k0 = 64 * kb, n0 = 32 * nb;
    int sn0 = n0;
    if (d.mode == 1) { if (n0 < 1024) sn0 = (n0 >> 7) * 192 + (n0 & 127); else { const int r = n0 - 1024; sn0 = (r >> 6) * 192 + 128 + (r & 63); } }
    const bool valid = sn0 < d.N;
#pragma unroll 8
    for (int i = 0; i < 32; ++i) { const int kk = 2 * i + (lane >> 5);
        float v = valid ? d.W[(size_t)(k0 + kk) * d.N + sn0 + (lane & 31)] : 0.f;
        if (d.gamma) v *= d.gamma[k0 + kk];
        scr[kk * 33 + (lane & 31)] = v; }
    asm volatile("s_waitcnt lgkmcnt(0)" ::: "memory");
    const int c = lane & 7;
#pragma unroll
    for (int j = 0; j < 4; ++j) { const int n = (lane >> 3) + 8 * j; const float* s = scr + (8 * c) * 33 + n;
        u32x4 o; o.x = cvt_pk_bf16(s[0 * 33], s[1 * 33]); o.y = cvt_pk_bf16(s[2 * 33], s[3 * 33]); o.z = cvt_pk_bf16(s[4 * 33], s[5 * 33]); o.w = cvt_pk_bf16(s[6 * 33], s[7 * 33]);
        *(u32x4*)(d.dst + (size_t)(n0 + n) * d.K + k0 + 8 * c) = o; }
    asm volatile("s_waitcnt lgkmcnt(0)" ::: "memory");
}
__device__ __forceinline__ void p0_prologue(int tid, const Params& P, unsigned char* lds) {
    const int lane = tid & 63, wave = __builtin_amdgcn_readfirstlane(tid >> 6);
    const int gw = blockIdx.x * 8 + wave, NGW = gridDim.x * 8;
    const size_t gt = (size_t)blockIdx.x * 512 + tid, NGT = (size_t)gridDim.x * 512;
    float* scr = (float*)(lds + wave * 8704);
    int total = 0;
    for (int id = 0; id < 28; ++id) total += wdesc(P, id).items;
    for (int it = gw; it < total; it += NGW) {
        int r = it, id = 0; WDesc d = wdesc(P, 0);
        while (r >= d.items) { r -= d.items; ++id; d = wdesc(P, id); }
        conv_item(d, r, scr, lane);
    }
    { unsigned* bw = (unsigned*)(P.ws + OFF_BAR); for (size_t i = gt; i < XCD_BAR_WORDS; i += NGT) bw[i] = 0u; }
    { const f32x4* src = (const f32x4*)P.in[1]; u32x4* dst = (u32x4*)(P.ws + OFF_PB); const size_t n8 = (size_t)DEPTH * T * PLE / 8;
      for (size_t i = gt; i < n8; i += NGT) { const f32x4 a = src[2 * i], b = src[2 * i + 1]; u32x4 w; w.x = cvt_pk_bf16(a[0], a[1]); w.y = cvt_pk_bf16(a[2], a[3]); w.z = cvt_pk_bf16(b[0], b[1]); w.w = cvt_pk_bf16(b[2], b[3]); dst[i] = w; } }
    { float* ssp = (float*)(P.ws + OFF_SS); bf16_t* hb = (bf16_t*)(P.ws + OFF_HB);
      for (int row = gw; row < T; row += NGW) {
          const f32x4* xr = (const f32x4*)(P.in[0] + (size_t)row * DM) + lane; float s = 0.f;
          unsigned long long* o8 = (unsigned long long*)(hb + (size_t)row * DM) + lane;
#pragma unroll
          for (int j = 0; j < 4; ++j) { const f32x4 v = xr[64 * j]; s += (v[0] * v[0] + v[1] * v[1]) + (v[2] * v[2] + v[3] * v[3]);
              o8[64 * j] = (unsigned long long)cvt_pk_bf16(v[0], v[1]) | ((unsigned long long)cvt_pk_bf16(v[2], v[3]) << 32); }
          s = wave_sum(s); if (lane < 16) ssp[(size_t)row * 16 + lane] = (lane == 0) ? s : 0.f; } }
}

__device__ __forceinline__ void r2_phase(int tid, const Params& P, int j) {
    const int lane = tid & 63, wave = __builtin_amdgcn_readfirstlane(tid >> 6);
    const int gw = blockIdx.x * 8 + wave, NGW = gridDim.x * 8;
    bf16_t* Q = (bf16_t*)(P.ws + OFF_FF + FF_Q); bf16_t* KV = (bf16_t*)(P.ws + OFF_FF + FF_KV); bf16_t* LAT = (bf16_t*)(P.ws + OFF_FF + FF_LAT);
    const float* gqn = P.in[11] + j * 128; const float* gqr = P.in[12] + j * 64; const float* gkn = P.in[13] + j * 128; const float* gkr = P.in[14] + j * 64;
    const int* pos = (const int*)P.in[2];
    float g_qn[2][8], g_kn[2][8], g_qr[8], g_kr[8];
#pragma unroll
    for (int i = 0; i < 2; ++i)
#pragma unroll
        for (int e = 0; e < 8; ++e) { const int d = (8 * lane + 512 * i + e) & 127; g_qn[i][e] = gqn[d] * QSCALE; g_kn[i][e] = gkn[d]; }
#pragma unroll
    for (int e = 0; e < 8; ++e) { const int r = 8 * (lane & 7) + e; g_qr[e] = gqr[r] * QSCALE; g_kr[e] = gkr[r]; }
    const double invf = kInvFreq[lane & 31];
    for (int row = gw; row < T; row += NGW) {
        float rq, rkv;
        { u32x4 z4 = {0u, 0u, 0u, 0u};
          const u32x4 lq = (lane < 48) ? *(const u32x4*)(LAT + (size_t)row * LATP + 8 * lane) : z4;
          const u32x4 lk = (lane < 32) ? *(const u32x4*)(LAT + (size_t)row * LATP + QLR + 8 * lane) : z4;
          float a[8], b[8]; unpack8(lq, a); unpack8(lk, b); float sa = 0.f, sb = 0.f;
#pragma unroll
          for (int e = 0; e < 8; ++e) { sa += a[e] * a[e]; sb += b[e] * b[e]; }
          rq = rsqrtf(wave_sum(sa) * (1.0f / QLR) + EPS); rkv = rsqrtf(wave_sum(sb) * (1.0f / KVLR) + EPS); }
        const double ang = (double)pos[row] * invf; double rev = ang * 0.15915494309189535; rev -= floor(rev);
        const float cs = __builtin_amdgcn_cosf((float)rev), sn = __builtin_amdgcn_sinf((float)rev);
        float cj[8], sj[8];
#pragma unroll
        for (int e = 0; e < 8; ++e) { cj[e] = __shfl(cs, 8 * (lane & 3) + e); sj[e] = __shfl(sn, 8 * (lane & 3) + e); }
#pragma unroll
        for (int i = 0; i < 2; ++i) {
            const int idx = 8 * lane + 512 * i, head = idx >> 7, d = idx & 127;
            u32x4* qp = (u32x4*)(Q + (size_t)row * QP + idx); u32x4* kp = (u32x4*)(KV + (size_t)row * KVP + head * 256 + d);
            float a[8], b[8]; unpack8(*qp, a); unpack8(*kp, b);
            { u32x4* vp = (u32x4*)(KV + (size_t)row * KVP + head * 256 + 128 + d); float vv[8]; unpack8(*vp, vv);
#pragma unroll
              for (int e = 0; e < 8; ++e) vv[e] *= rkv;
              *vp = pack8(vv); }
            float sa = 0.f, sb = 0.f;
#pragma unroll
            for (int e = 0; e < 8; ++e) { a[e] *= rq; b[e] *= rkv; sa += a[e] * a[e]; sb += b[e] * b[e]; }
#pragma unroll
            for (int o = 1; o < 16; o <<= 1) { sa += __shfl_xor(sa, o); sb += __shfl_xor(sb, o); }
            const float ra = rsqrtf(sa * (1.0f / 128) + EPS), rb = rsqrtf(sb * (1.0f / 128) + EPS);
#pragma unroll
            for (int e = 0; e < 8; ++e) { a[e] = a[e] * ra * g_qn[i][e]; b[e] = b[e] * rb * g_kn[i][e]; }
            *qp = pack8(a); *kp = pack8(b);
        }
        {
            u32x4* qp = (u32x4*)(Q + (size_t)row * QP + 1024 + 8 * lane); u32x4* kp = (u32x4*)(LAT + (size_t)row * LATP + 640 + 8 * (lane & 7));
            float a[8], b[8]; unpack8(*qp, a); unpack8(*kp, b);
            float sa = 0.f, sb = 0.f;
#pragma unroll
            for (int e = 0; e < 8; ++e) { a[e] *= rq; sa += a[e] * a[e]; sb += b[e] * b[e]; }
#pragma unroll
            for (int o = 1; o < 8; o <<= 1) { sa += __shfl_xor(sa, o); sb += __shfl_xor(sb, o); }
            const float ra = rsqrtf(sa * (1.0f / 64) + EPS), rb = rsqrtf(sb * (1.0f / 64) + EPS);
            const bool hi = (lane & 4) != 0;
#pragma unroll
            for (int e = 0; e < 8; ++e) {
                const float ya = a[e] * ra * g_qr[e], yb = b[e] * rb * g_kr[e];
                const float pa = __shfl_xor(ya, 4), pb = __shfl_xor(yb, 4);
                a[e] = hi ? (ya * cj[e] + pa * sj[e]) : (ya * cj[e] - pa * sj[e]);
                b[e] = hi ? (yb * cj[e] + pb * sj[e]) : (yb * cj[e] - pb * sj[e]);
            }
            *qp = pack8(a); if (lane < 8) *kp = pack8(b);
        }
    }
}

constexpr int KROW = 400, VROW = 288, KTILE = 64 * KROW, VTILE = 64 * VROW;
__device__ __forceinline__ void attn_unit(int tid, unsigned char* lds, const bf16_t* Q, const bf16_t* KV, const bf16_t* KR, bf16_t* O, int b, int h, int qb) {
    const int lane = tid & 63, w = __builtin_amdgcn_readfirstlane(tid >> 6), r = lane & 15, g = lane >> 4;
    const int row0 = b * SEQ + qb * 128, qrow = row0 + 16 * w + r;
    bf16x8 qf[6];
#pragma unroll
    for (int ks = 0; ks < 4; ++ks) qf[ks] = *(const bf16x8*)(Q + (size_t)qrow * QP + h * 128 + 32 * ks + 8 * g);
#pragma unroll
    for (int ks = 0; ks < 2; ++ks) qf[4 + ks] = *(const bf16x8*)(Q + (size_t)qrow * QP + 1024 + h * 64 + 32 * ks + 8 * g);
    const int ntiles = 2 * qb + 2, last_tile = 2 * qb + (w >> 2);
    const int kn_row0 = tid >> 4, kn_ch = tid & 15;
    const int kr_row = tid >> 3, kr_ch = tid & 7;
    const bf16_t* gk = KV + (size_t)(b * SEQ) * KVP + h * 256;
    const bf16_t* gr = KR + (size_t)(b * SEQ) * LATP;
    u32x4 sk0, sk1, sr, sv0, sv1;
#define ATT_LOAD(t) do { const size_t kb = (size_t)(t) * 64; \
        sk0 = *(const u32x4*)(gk + (kb + kn_row0) * KVP + kn_ch * 8); sk1 = *(const u32x4*)(gk + (kb + kn_row0 + 32) * KVP + kn_ch * 8); \
        sv0 = *(const u32x4*)(gk + (kb + kn_row0) * KVP + 128 + kn_ch * 8); sv1 = *(const u32x4*)(gk + (kb + kn_row0 + 32) * KVP + 128 + kn_ch * 8); \
        sr = *(const u32x4*)(gr + (kb + kr_row) * LATP + kr_ch * 8); } while (0)
#define ATT_STORE(buf) do { unsigned char* kb_ = lds + (buf) * KTILE; unsigned char* vb_ = lds + 2 * KTILE + (buf) * VTILE; \
        *(u32x4*)(kb_ + kn_row0 * KROW + kn_ch * 16) = sk0; *(u32x4*)(kb_ + (kn_row0 + 32) * KROW + kn_ch * 16) = sk1; \
        *(u32x4*)(kb_ + kr_row * KROW + 256 + kr_ch * 16) = sr; \
        *(u32x4*)(vb_ + kn_row0 * VROW + kn_ch * 16) = sv0; *(u32x4*)(vb_ + (kn_row0 + 32) * VROW + kn_ch * 16) = sv1; } while (0)
    f32x4 o[8];
#pragma unroll
    for (int i = 0; i < 8; ++i) o[i] = (f32x4){0.f, 0.f, 0.f, 0.f};
    float m = -1e30f, l = 0.f;
    ATT_LOAD(0); ATT_STORE(0);
    __syncthreads();
    const int q4 = r >> 2, p4 = lane & 3;
    const int vtr_off = (4 * g + q4) * VROW + (4 * p4) * 2;
    const int qidx = qb * 128 + 16 * w + r;
    for (int t = 0; t < ntiles; ++t) {
        const bool more = (t + 1 < ntiles);
        if (more) ATT_LOAD(t + 1);
        if (t <= last_tile) {
            const unsigned char* Kb = lds + (t & 1) * KTILE; const unsigned char* Vb = lds + 2 * KTILE + (t & 1) * VTILE;
            f32x4 p[4];
#pragma unroll
            for (int kb = 0; kb < 4; ++kb) {
                p[kb] = (f32x4){0.f, 0.f, 0.f, 0.f};
#pragma unroll
                for (int ks = 0; ks < 6; ++ks) {
                    const bf16x8 a = *(const bf16x8*)(Kb + (16 * kb + r) * KROW + ks * 64 + g * 16);
                    p[kb] = __builtin_amdgcn_mfma_f32_16x16x32_bf16(a, qf[ks], p[kb], 0, 0, 0);
                }
            }
            if (t * 64 + 63 > qb * 128 + 16 * w) {
#pragma unroll
                for (int kb = 0; kb < 4; ++kb)
#pragma unroll
                    for (int i = 0; i < 4; ++i) { const int kk = t * 64 + 16 * kb + 4 * g + i; if (kk > qidx) p[kb][i] = -1e30f; }
            }
            float mx = fmaxf(fmaxf(p[0][0], p[0][1]), fmaxf(p[0][2], p[0][3]));
#pragma unroll
            for (int kb = 1; kb < 4; ++kb) mx = fmaxf(mx, fmaxf(fmaxf(p[kb][0], p[kb][1]), fmaxf(p[kb][2], p[kb][3])));
            mx = fmaxf(mx, __shfl_xor(mx, 16)); mx = fmaxf(mx, __shfl_xor(mx, 32));
            const float mn = fmaxf(m, mx), alpha = fast_exp2(m - mn); m = mn;
            float rsum = 0.f;
#pragma unroll
            for (int kb = 0; kb < 4; ++kb)
#pragma unroll
                for (int i = 0; i < 4; ++i) { p[kb][i] = fast_exp2(p[kb][i] - mn); rsum += p[kb][i]; }
            l = l * alpha + rsum;
#pragma unroll
            for (int i = 0; i < 8; ++i) o[i] *= alpha;
            bf16x8 pb[2];
#pragma unroll
            for (int kk = 0; kk < 2; ++kk) {
                u32x4 pw; pw.x = cvt_pk_bf16(p[2 * kk][0], p[2 * kk][1]); pw.y = cvt_pk_bf16(p[2 * kk][2], p[2 * kk][3]);
                pw.z = cvt_pk_bf16(p[2 * kk + 1][0], p[2 * kk + 1][1]); pw.w = cvt_pk_bf16(p[2 * kk + 1][2], p[2 * kk + 1][3]);
                pb[kk] = __builtin_bit_cast(bf16x8, pw);
            }
#pragma unroll
            for (int db = 0; db < 8; ++db)
#pragma unroll
                for (int kk = 0; kk < 2; ++kk) {
                    const LAS unsigned char* vp = (const LAS unsigned char*)(Vb + vtr_off + (32 * kk) * VROW + db * 32);
                    const s16x4 lo = __builtin_bit_cast(s16x4, __builtin_amdgcn_ds_read_tr16_b64_v4i16((LAS s16x4*)vp));
                    const s16x4 hi = __builtin_bit_cast(s16x4, __builtin_amdgcn_ds_read_tr16_b64_v4i16((LAS s16x4*)(vp + 16 * VROW)));
                    const bf16x8 vf = __builtin_shufflevector(lo, hi, 0, 1, 2, 3, 4, 5, 6, 7);
                    o[db] = __builtin_amdgcn_mfma_f32_16x16x32_bf16(vf, pb[kk], o[db], 0, 0, 0);
                }
        }
        if (more) ATT_STORE((t + 1) & 1);
        __syncthreads();
    }
    l += __shfl_xor(l, 16); l += __shfl_xor(l, 32);
    const float inv = fast_rcp(l);
    bf16_t* orow = O + (size_t)qrow * QP + h * 128 + 4 * g;
#pragma unroll
    for (int db = 0; db < 8; ++db) {
        u32x2 wv; wv.x = cvt_pk_bf16(o[db][0] * inv, o[db][1] * inv); wv.y = cvt_pk_bf16(o[db][2] * inv, o[db][3] * inv);
        *(u32x2*)(orow + 16 * db) = wv;
    }
#undef ATT_LOAD
#undef ATT_STORE
}
__device__ __forceinline__ void attn_phase(int tid, const Params& P, unsigned char* lds) {
    bf16_t* Q = (bf16_t*)(P.ws + OFF_FF + FF_Q); const bf16_t* KV = (const bf16_t*)(P.ws + OFF_FF + FF_KV); const bf16_t* KR = (const bf16_t*)(P.ws + OFF_FF + FF_LAT) + 640;
    for (int pr = blockIdx.x; pr < 1024; pr += gridDim.x) {
        const int bh = pr >> 3, x = pr & 7, b = bh >> 3, h = bh & 7;
        attn_unit(tid, lds, Q, KV, KR, Q, b, h, 15 - x);
        attn_unit(tid, lds, Q, KV, KR, Q, b, h, x);
    }
}

constexpr int SROW = 576;
constexpr int SGU_STAT_OFF = 128 * SROW;
__device__ __forceinline__ void sgu_phase(int tid, const Params& P, unsigned char* lds, int j) {
    const int lane = tid & 63, w = __builtin_amdgcn_readfirstlane(tid >> 6), r = lane & 31, hh = lane >> 5;
    bf16_t* Z = (bf16_t*)(P.ws + OFF_FF);
    const float* lng = P.in[17] + j * 2048; const float* lnb = P.in[18] + j * 2048;
    const float* wsp = P.in[19] + (size_t)j * 8 * 128 * 128; const float* bsp = P.in[20] + j * 8 * 128;
    const int q4 = (lane & 15) >> 2, p4 = lane & 3, colblk = (lane >> 4) & 1;
    f32x2* stl = (f32x2*)(lds + SGU_STAT_OFF);
    for (int unit = blockIdx.x; unit < 256; unit += gridDim.x) {
        const int row0 = unit * 128;
        for (int rr = 0; rr < 16; ++rr) {
            const int row = 16 * w + rr; float s1 = 0.f, s2 = 0.f;
#pragma unroll
            for (int i = 0; i < 4; ++i) { float v[8]; unpack8(*(const u32x4*)(Z + (size_t)(row0 + row) * ZP + 2048 + 8 * lane + 512 * i), v);
#pragma unroll
                for (int e = 0; e < 8; ++e) { s1 += v[e]; s2 += v[e] * v[e]; } }
            s1 = wave_sum(s1); s2 = wave_sum(s2);
            const float mu = s1 * (1.0f / 2048), var = s2 * (1.0f / 2048) - mu * mu;
            if (lane == 0) stl[row] = (f32x2){mu, rsqrtf(fmaxf(var, 0.f) + EPS)};
        }
        __syncthreads();
        for (int g = 0; g < 8; ++g) {
#pragma unroll 2
            for (int i = 0; i < 8; ++i) {
                const int chunk = tid + 512 * i, row = chunk >> 5, ch = chunk & 31, col = g * 256 + ch * 8;
                float v[8]; unpack8(*(const u32x4*)(Z + (size_t)(row0 + row) * ZP + 2048 + col), v);
                const f32x2 st = stl[row]; const float mu = st.x, rstd = st.y;
                const f32x4 g0 = *(const f32x4*)(lng + col), g1 = *(const f32x4*)(lng + col + 4), b0 = *(const f32x4*)(lnb + col), b1 = *(const f32x4*)(lnb + col + 4);
#pragma unroll
                for (int e = 0; e < 4; ++e) { v[e] = (v[e] - mu) * rstd * g0[e] + b0[e]; v[4 + e] = (v[4 + e] - mu) * rstd * g1[e] + b1[e]; }
                *(u32x4*)(lds + row * SROW + ch * 16) = pack8(v);
            }
            __syncthreads();
            bf16x8 af[8];
#pragma unroll
            for (int ks = 0; ks < 8; ++ks) {
                const LAS unsigned char* vp = (const LAS unsigned char*)(lds + (16 * ks + 8 * hh + q4) * SROW + (32 * w + 16 * colblk + 4 * p4) * 2);
                const s16x4 lo = __builtin_bit_cast(s16x4, __builtin_amdgcn_ds_read_tr16_b64_v4i16((LAS s16x4*)vp));
                const s16x4 hi = __builtin_bit_cast(s16x4, __builtin_amdgcn_ds_read_tr16_b64_v4i16((LAS s16x4*)(vp + 4 * SROW)));
                af[ks] = __builtin_shufflevector(lo, hi, 0, 1, 2, 3, 4, 5, 6, 7);
            }
            const float* wg = wsp + (size_t)g * 128 * 128;
#pragma unroll
            for (int tb = 0; tb < 4; ++tb) {
                f32x16 acc;
#pragma unroll
                for (int e = 0; e < 16; ++e) acc[e] = 0.f;
                const int t = 32 * tb + r;
#pragma unroll
                for (int ks = 0; ks < 8; ++ks) {
                    if (ks <= 2 * tb + 1) {
                        const int s0 = 16 * ks + 8 * hh;
                        const f32x4 w0 = *(const f32x4*)(wg + t * 128 + s0), w1 = *(const f32x4*)(wg + t * 128 + s0 + 4);
                        float wv[8] = {w0[0], w0[1], w0[2], w0[3], w1[0], w1[1], w1[2], w1[3]};
#pragma unroll
                        for (int e = 0; e < 8; ++e) if (s0 + e > t) wv[e] = 0.f;
                        const bf16x8 bfr = __builtin_bit_cast(bf16x8, pack8(wv));
                        acc = __builtin_amdgcn_mfma_f32_32x32x16_bf16(af[ks], bfr, acc, 0, 0, 0);
                    }
                }
                const float bias = bsp[g * 128 + t];
                bf16_t* up = Z + (size_t)(row0 + t) * ZP + g * 256 + 32 * w + 4 * hh;
#pragma unroll
                for (int i4 = 0; i4 < 4; ++i4) {
                    const u32x2 uu = *(const u32x2*)(up + 8 * i4);
                    u32x2 y; y.x = cvt_pk_bf16(bflo(uu.x) * (acc[4 * i4] + bias), bfhi(uu.x) * (acc[4 * i4 + 1] + bias));
                    y.y = cvt_pk_bf16(bflo(uu.y) * (acc[4 * i4 + 2] + bias), bfhi(uu.y) * (acc[4 * i4 + 3] + bias));
                    *(u32x2*)(up + 8 * i4) = y;
                }
            }
            __syncthreads();
        }
    }
}


#define XB_TMO      128
#define XB_XCNT(j)  (256  + 64 * (j))
#define XB_XSUB(j)  (1280 + 64 * (j))
#define XB_XGEN(j)  (2304 + 64 * (j))
#define XB_TOP      3328
#define XB_TOPGEN   3392
#define XB_SPIN_CAP (1u << 22)
__device__ __forceinline__ unsigned xb_ld(unsigned* p)              { return __hip_atomic_load(p, __ATOMIC_RELAXED, __HIP_MEMORY_SCOPE_AGENT); }
__device__ __forceinline__ unsigned xb_add(unsigned* p, unsigned v) { return __hip_atomic_fetch_add(p, v, __ATOMIC_RELAXED, __HIP_MEMORY_SCOPE_AGENT); }
__device__ __forceinline__ unsigned xb_xcc_id() { return (unsigned)__builtin_amdgcn_s_getreg((3 << 11) | 20) & 0xFu; }
#define XB_SPIN(cond, bar) do { unsigned _sp = 0; while (cond) { __builtin_amdgcn_s_sleep(1); \
    if ((++_sp & 255u) == 0u) { if (xb_ld(&(bar)[XB_TMO])) break; if (_sp > XB_SPIN_CAP) { atomicAdd(&(bar)[XB_TMO], 1u); break; } } } } while (0)
__device__ __forceinline__ void xcd_barrier_complete(unsigned* bar, unsigned x, unsigned& nloc, unsigned& nx) {
    const unsigned G = gridDim.x;
    unsigned sum, cnt, mine, sp = 0u;
    for (;;) {
        sum = 0u; cnt = 0u; mine = 0u;
#pragma unroll
        for (unsigned j = 0; j < 16; ++j) { const unsigned c = xb_ld(&bar[XB_XCNT(j)]); sum += c; cnt += (c > 0u) ? 1u : 0u; mine = (j == x) ? c : mine; }
        if (sum == G) break;
        __builtin_amdgcn_s_sleep(1);
        if ((++sp & 255u) == 0u) { if (xb_ld(&bar[XB_TMO])) break; if (sp > XB_SPIN_CAP) { atomicAdd(&bar[XB_TMO], 1u); break; } }
    }
    nloc = mine > 0u ? mine : 1u; nx = cnt > 0u ? cnt : 1u;
}
__device__ __forceinline__ void xcd_barrier(unsigned* bar, unsigned x, volatile LAS unsigned* st) {
    asm volatile("s_waitcnt vmcnt(0)" ::: "memory");
    __syncthreads();
    if (threadIdx.x == 0) {
        __builtin_amdgcn_s_waitcnt(0);
        unsigned nloc = st[0], nx = st[1];
        if (nloc == 0u) { xcd_barrier_complete(bar, x, nloc, nx); st[0] = nloc; st[1] = nx; }
        const unsigned old = xb_add(&bar[XB_XSUB(x)], 1u);
        const unsigned gen = old / nloc;
        if (old + 1u == (gen + 1u) * nloc) {
            __builtin_amdgcn_fence(__ATOMIC_RELEASE, "agent");
            asm volatile("s_waitcnt vmcnt(0)" ::: "memory");
            const unsigned og = xb_add(&bar[XB_TOP], 1u);
            const unsigned tg = og / nx;
            if (og + 1u == (tg + 1u) * nx) xb_add(&bar[XB_TOPGEN], 1u);
            else XB_SPIN(xb_ld(&bar[XB_TOPGEN]) == tg, bar);
            __builtin_amdgcn_fence(__ATOMIC_ACQUIRE, "agent");
            xb_add(&bar[XB_XGEN(x)], 1u);
            asm volatile("s_waitcnt vmcnt(0)" ::: "memory");
        } else {
            XB_SPIN(xb_ld(&bar[XB_XGEN(x)]) == gen, bar);
            __builtin_amdgcn_fence(__ATOMIC_ACQUIRE, "agent");
            asm volatile("s_waitcnt vmcnt(0)" ::: "memory");
        }
    }
    __syncthreads();
}

constexpr int NPHASE = 1 + 9 * DEPTH;
__device__ __forceinline__ int otid(int t) { asm volatile("" : "+v"(t)); return t; }
__device__ __forceinline__ Params load_params() {
    Params P{};
#if defined(__HIP_DEVICE_COMPILE__)
    typedef const __attribute__((address_space(4))) unsigned long long* kp_t;
    kp_t kp = (kp_t)__builtin_amdgcn_kernarg_segment_ptr(); asm volatile("" : "+s"(kp));
#pragma unroll
    for (int i = 0; i < 26; ++i) P.in[i] = (const float*)kp[i];
    P.out = (float*)kp[26]; P.ws = (unsigned char*)kp[27];
#endif
    return P;
}
__host__ __device__ __forceinline__ bool phase_nonempty(int ph) {
    if (ph == 0) return true;
    const int layer = (ph - 1) / 9, slot = (ph - 1) % 9;
    if ((layer & 1) && (slot == 3 || slot == 4)) return false;
    return true;
}

__global__ void __launch_bounds__(512) fwd_megakernel(Params Parg) {
    extern __shared__ __attribute__((aligned(16))) unsigned char lds[];
    LAS unsigned char* ldsl = (LAS unsigned char*)lds;
    const int wv0 = __builtin_amdgcn_readfirstlane((int)threadIdx.x >> 6);
    volatile LAS unsigned* bst = (volatile LAS unsigned*)(ldsl + 131072);
    if (threadIdx.x == 0) { bst[0] = 0u; bst[1] = 0u; }
    __syncthreads();
    unsigned* const bar = (unsigned*)(Parg.ws + OFF_BAR);
    const unsigned xcc = xb_xcc_id();
    int nseam = 0;
    bool first = true;
    for (int ph = Parg.ph_lo; ph < Parg.ph_hi; ++ph) {
        if (!phase_nonempty(ph)) continue;
        if (!first) {
            if (nseam == 0) { cg::this_grid().sync(); if (threadIdx.x == 0) (void)xb_add(&bar[XB_XCNT(xcc)], 1u); }
            else xcd_barrier(bar, xcc, bst);
            ++nseam;
        }
        first = false;
        const Params P = load_params();
        unsigned char* ws = P.ws;
        bf16_t* wb = (bf16_t*)(ws + OFF_W);
        bf16_t* hb = (bf16_t*)(ws + OFF_HB);
        float* SS = (float*)(ws + OFF_SS);
        const int G = gridDim.x, c = blockIdx.x;
        int tid; asm volatile("v_mbcnt_lo_u32_b32 %0, -1, 0\n\tv_mbcnt_hi_u32_b32 %0, -1, %0" : "=v"(tid)); tid = (tid + wv0 * 64) & 511;
#ifndef NO_P0
        if (ph == 0) { p0_prologue(otid(tid), P, lds); continue; }
#else
        if (ph == 0) continue;
#endif
        const int layer = (ph - 1) / 9, slot = (ph - 1) % 9, j = layer >> 1;
        const bool mla = (layer & 1) == 0;
        float* ss_mix = SS; float* ss_ffn = SS; float* ss_ple = SS;
        float* ss_next = (layer + 1 < DEPTH) ? SS : nullptr;
        const float* hin = (layer == 0) ? P.in[0] : P.out;
        pg8::StaticOrder S;
        if (slot == 0) {
            if (mla) {
                pg8::Gemm g{hb, wb + WE_DOWN + (size_t)j * LATP * DM, T, LATP, DM, DM}; S.init(T, LATP, G, c);
                pg8::EpiStore<0, 0> E{(bf16_t*)(ws + OFF_FF + FF_LAT), LATP, ss_mix, 1.0f / DM};
                pg8::gemm_phase(otid(tid), ldsl, g, S, E);
            } else {
                pg8::Gemm g{hb, wb + WE_GIN + (size_t)j * ZP * DM, T, ZP, DM, DM}; S.init(T, ZP, G, c);
                pg8::EpiStore<2, 0> E{(bf16_t*)(ws + OFF_FF), ZP, ss_mix, 1.0f / DM};
                pg8::gemm_phase(otid(tid), ldsl, g, S, E);
            }
        } else if (slot == 1) {
            if (mla) {
                { pg8::Gemm g{(const bf16_t*)(ws + OFF_FF + FF_LAT), wb + WE_UQ + (size_t)j * QP * QLR, T, QP, QLR, LATP}; S.init(T, QP, G, c);
                  pg8::EpiStore<0, 0> E{(bf16_t*)(ws + OFF_FF + FF_Q), QP, nullptr, 0.f};
                  pg8::gemm_phase(otid(tid), ldsl, g, S, E); }
                { pg8::Gemm g{(const bf16_t*)(ws + OFF_FF + FF_LAT) + QLR, wb + WE_UKV + (size_t)j * KVP * KVLR, T, KVP, KVLR, LATP}; S.init(T, KVP, G, c);
                  pg8::EpiStore<0, 0> E{(bf16_t*)(ws + OFF_FF + FF_KV), KVP, nullptr, 0.f};
                  pg8::gemm_phase(otid(tid), ldsl, g, S, E); }
            } else {
#ifndef NO_SGU
                sgu_phase(otid(tid), P, lds, j);
#endif
            }
        } else if (slot == 2) {
            if (mla) {
#ifndef NO_R2
                r2_phase(otid(tid), P, j);
#endif
            } else {
                pg8::Gemm g{(const bf16_t*)(ws + OFF_FF), wb + WE_GOUT + (size_t)j * DM * 2048, T, DM, 2048, ZP}; S.init(T, DM, G, c);
                pg8::EpiRes<0> E{hin, P.out, hb, ss_ffn, nullptr};
                pg8::gemm_phase(otid(tid), ldsl, g, S, E);
            }
        } else if (slot == 3) {
#ifndef NO_ATT
            attn_phase(otid(tid), P, lds);
#endif
        } else if (slot == 4) {
            pg8::Gemm g{(const bf16_t*)(ws + OFF_FF + FF_Q), wb + WE_MOUT + (size_t)j * DM * DM, T, DM, DM, QP}; S.init(T, DM, G, c);
            pg8::EpiRes<0> E{hin, P.out, hb, ss_ffn, nullptr};
            pg8::gemm_phase(otid(tid), ldsl, g, S, E);
        } else if (slot == 5) {
            pg8::Gemm g{hb, wb + WE_UP + (size_t)layer * DFF * DM, T, DFF, DM, DM}; S.init(T, DFF, G, c);
            pg8::EpiStore<1, 0> E{(bf16_t*)(ws + OFF_FF), DFF, ss_ffn, 1.0f / DM};
            pg8::gemm_phase(otid(tid), ldsl, g, S, E);
        } else if (slot == 6) {
            pg8::Gemm g{(const bf16_t*)(ws + OFF_FF), wb + WE_DN + (size_t)layer * DM * DFF, T, DM, DFF, DFF}; S.init(T, DM, G, c);
            pg8::EpiRes<0> E{P.out, P.out, hb, ss_ple, nullptr};
            pg8::gemm_phase(otid(tid), ldsl, g, S, E);
        } else if (slot == 7) {
            pg8::Gemm g{hb, wb + WE_GATE + (size_t)layer * DM * DM, T, DM, DM, DM}; S.init(T, DM, G, c);
            pg8::EpiStore<3, 0> E{(bf16_t*)(ws + OFF_FF), DM, ss_ple, 1.0f / DM};
            pg8::gemm_phase(otid(tid), ldsl, g, S, E);
        } else {
            pg8::Gemm g{(const bf16_t*)(ws + OFF_PB) + (size_t)layer * T * PLE, wb + WE_PROJ + (size_t)layer * DM * PLE, T, DM, PLE, PLE}; S.init(T, DM, G, c);
            pg8::EpiRes<1> E{P.out, P.out, hb, ss_next, (const bf16_t*)(ws + OFF_FF)};
            pg8::gemm_phase(otid(tid), ldsl, g, S, E);
        }
    }
    asm volatile("s_waitcnt vmcnt(0)" ::: "memory");
    __builtin_amdgcn_fence(__ATOMIC_RELEASE, "agent");
    asm volatile("s_waitcnt vmcnt(0)" ::: "memory");
}


#ifdef DBG_CHECK
__global__ void dbg_check(const bf16_t* A, int lda, const bf16_t* Bt, int K, const bf16_t* C, int ldc, int N, const float* ss, int act, float* out) {
    const unsigned s = blockIdx.x * blockDim.x + threadIdx.x;
    const unsigned hsh = s * 2654435761u; const int row = (hsh >> 8) % T; const int col = (s * 40503u + (hsh >> 3)) % N;
    float acc = 0.f;
    for (int k = 0; k < K; ++k) acc += bf2f(A[(size_t)row * lda + k]) * bf2f(Bt[(size_t)col * K + k]);
    if (ss) acc *= rsqrtf(ss[row] * (1.0f / DM) + EPS);
    if (act == 3) acc = 1.0f / (1.0f + expf(-acc));
    if (act == 1) { acc = fmaxf(acc, 0.f); acc *= acc; }
    const float got = bf2f(C[(size_t)row * ldc + col]);
    if (!(fabsf(got - acc) <= 0.03f + 0.03f * fabsf(acc))) atomicAdd(out + 4096, 1.0f);
}
#endif

#ifdef DBG_CHECK
__global__ void dbg_check_ss(const float* h, const float* ss, float* out) {
    const int row = blockIdx.x * blockDim.x + threadIdx.x; if (row >= T) return;
    float a = 0.f; for (int k = 0; k < DM; ++k) { const float v = h[(size_t)row * DM + k]; a += v * v; }
    const float got = ss[row];
    if (!(fabsf(got - a) <= 1e-3f * fabsf(a))) out[(size_t)row * DM] = 1e30f;
}
#endif

#ifdef DBG_CHECK
__global__ void dbg_zero(float* out) { out[4096 + threadIdx.x] = 0.f; out[8192 + threadIdx.x] = 0.f; }
__global__ void dbg_reduce(float* out) {
    float bc = 0.f, br = 0.f; int ic = 0, ir = 0;
    for (int i = 0; i < 256; ++i) { if (out[4096 + i] > bc) { bc = out[4096 + i]; ic = i; } if (out[8192 + i] > br) { br = out[8192 + i]; ir = i; } }
    float v = 1e6f * out[4096];
    for (int i = 0; i < 256; ++i) { out[4096 + i] = 0.f; out[8192 + i] = 0.f; }
    out[0] = v; out[1] = 1e-3f * bc; out[2] = 1e-3f * br;
}
#endif
constexpr int LDS_BYTES = 131072 + 256;
extern "C" void kernel_launch(void* const* d_in, const int* in_sizes, int n_in, void* d_out, int out_size, void* d_ws, size_t ws_size, hipStream_t stream) {
    static int grid = 0;
    if (grid == 0) {
        if (n_in != 26 || out_size != T * DM || ws_size < WS_NEED) { fprintf(stderr, "kernel_launch: unexpected problem (n_in %d out %d ws %zu)\n", n_in, out_size, ws_size); grid = -1; return; }
        int dev = 0, cus = 0, per_cu = 0;
        hipGetDevice(&dev); hipDeviceGetAttribute(&cus, hipDeviceAttributeMultiprocessorCount, dev);
        hipFuncSetAttribute((const void*)fwd_megakernel, hipFuncAttributeMaxDynamicSharedMemorySize, LDS_BYTES);
        hipOccupancyMaxActiveBlocksPerMultiprocessor(&per_cu, (const void*)fwd_megakernel, 512, LDS_BYTES);
        if (per_cu < 1) { fprintf(stderr, "kernel_launch: occupancy query says %d blocks/CU\n", per_cu); per_cu = 1; }
        (void)hipGetLastError();
        grid = cus;
    }
    if (grid < 0) return;
    Params p{};
    for (int i = 0; i < 26; ++i) p.in[i] = (const float*)d_in[i];
    p.out = (float*)d_out; p.ws = (unsigned char*)d_ws;
#if ONE_LAUNCH
    p.ph_lo = 0; p.ph_hi = NPHASE;
    for (int rep = 0; rep < DBG_REPS; ++rep)
    { void* args[] = {&p}; hipError_t e = hipLaunchCooperativeKernel((const void*)fwd_megakernel, dim3(grid), dim3(512), args, LDS_BYTES, stream);
      if (e != hipSuccess) fprintf(stderr, "cooperative launch failed: %s (grid %d)\n", hipGetErrorString(e), grid); }
#else
#ifndef DBG_STOP
#define DBG_STOP (NPHASE - 1)
#endif
    for (int ph = 0; ph <= DBG_STOP; ++ph) {
        if (!phase_nonempty(ph)) continue;
        p.ph_lo = ph; p.ph_hi = ph + 1;
#ifdef DBG_NANFILL
        if (ph == DBG_NANFILL) (void)hipMemsetAsync((char*)d_ws + OFF_FF, 0xFF, 64 * MiB, stream);
#endif
        void* args[] = {&p}; hipError_t e = hipLaunchCooperativeKernel((const void*)fwd_megakernel, dim3(grid), dim3(512), args, LDS_BYTES, stream);
        if (e != hipSuccess) { fprintf(stderr, "cooperative launch failed: %s (grid %d, phase %d)\n", hipGetErrorString(e), grid, ph); break; }
    }
#ifdef DBG_CHECK
    { unsigned char* ws = (unsigned char*)d_ws; bf16_t* wb = (bf16_t*)(ws + OFF_W);
      dbg_zero<<<1, 256, 0, stream>>>((float*)d_out); DBG_CHECK; dbg_reduce<<<1, 1, 0, stream>>>((float*)d_out); }
#endif
#endif
}
```

```cpp
#include <hip/hip_runtime.h>
#include <hip/hip_cooperative_groups.h>
#include <cstdio>
#include <cstdint>
namespace cg = cooperative_groups;

#ifndef DBG_NOGATE
#define DBG_NOGATE 0
#endif
#ifndef DBG_GATE_NOSS
#define DBG_GATE_NOSS 0
#endif
#ifndef DBG_REPS
#define DBG_REPS 1
#endif
#ifndef ONE_LAUNCH
#define ONE_LAUNCH 1
#endif

#define LAS __attribute__((address_space(3)))
typedef unsigned short bf16_t;
typedef short bf16x8 __attribute__((ext_vector_type(8)));
typedef short s16x4 __attribute__((ext_vector_type(4)));
typedef float f32x4 __attribute__((ext_vector_type(4)));
typedef float f32x2 __attribute__((ext_vector_type(2)));
typedef float f32x16 __attribute__((ext_vector_type(16)));
typedef unsigned u32x4 __attribute__((ext_vector_type(4)));
typedef unsigned u32x2 __attribute__((ext_vector_type(2)));

constexpr int T = 32768, DM = 1024, SEQ = 2048, NB = 16, DFF = 4096, PLE = 256, DEPTH = 4;
constexpr int NH = 8, QLR = 384, KVLR = 256, ROPE = 64, LATP = 768;
constexpr int QP = 1536, KVP = 2048, ZP = 4096;
constexpr float EPS = 1e-6f;
constexpr float QSCALE = 0.07216878364870322f * 1.4426950408889634f;

constexpr size_t MiB = 1u << 20;
constexpr size_t OFF_SS = 0;
constexpr size_t OFF_W = 2621440;
constexpr size_t OFF_HB = 112 * MiB;
constexpr size_t OFF_FF = 176 * MiB;
constexpr size_t OFF_PB = 448 * MiB;
constexpr size_t WS_NEED = 512 * MiB;
constexpr size_t OFF_BAR = 2 * MiB;
#define XCD_BAR_WORDS 3456
constexpr size_t WE_DOWN = 0, WE_UQ = WE_DOWN + 2ull * LATP * DM, WE_UKV = WE_UQ + 2ull * QP * QLR, WE_MOUT = WE_UKV + 2ull * KVP * KVLR,
                 WE_GIN = WE_MOUT + 2ull * DM * DM, WE_GOUT = WE_GIN + 2ull * ZP * DM, WE_UP = WE_GOUT + 2ull * DM * 2048,
                 WE_DN = WE_UP + 4ull * DFF * DM, WE_GATE = WE_DN + 4ull * DM * DFF, WE_PROJ = WE_GATE + 4ull * DM * DM, WE_END = WE_PROJ + 4ull * DM * PLE;
static_assert(OFF_W + WE_END * 2 <= OFF_HB, "weights fit");
constexpr size_t FF_Q = 0, FF_KV = 96 * MiB, FF_LAT = 224 * MiB;

struct Params { const float* in[26]; float* out; unsigned char* ws; int ph_lo, ph_hi; };

typedef __bf16 bf16x2_t __attribute__((ext_vector_type(2)));
__device__ __forceinline__ unsigned cvt_pk_bf16(float lo, float hi) { const f32x2 v = {lo, hi}; return __builtin_bit_cast(unsigned, __builtin_convertvector(v, bf16x2_t)); }
__device__ __forceinline__ float bf2f(unsigned short b) { return __uint_as_float((unsigned)b << 16); }
__device__ __forceinline__ float bflo(unsigned u) { return __uint_as_float(u << 16); }
__device__ __forceinline__ float bfhi(unsigned u) { return __uint_as_float(u & 0xffff0000u); }
__device__ __forceinline__ float fast_rcp(float x) { return __builtin_amdgcn_rcpf(x); }
__device__ __forceinline__ float fast_exp2(float x) { return __builtin_amdgcn_exp2f(x); }
__device__ __forceinline__ float gelu_tanh(float x) { const float y = x + 0.044715f * x * x * x; return x * fast_rcp(1.0f + fast_exp2(-2.3022082f * y)); }
__device__ __forceinline__ float sigmoidf_(float x) { return fast_rcp(1.0f + fast_exp2(-1.4426950409f * x)); }

namespace pg8 {
constexpr int BM = 256, BK = 64, HALF = 128, HTB = HALF * BK * 2, STAGE_BYTES = 8 * HTB, NXCD = 8, WGM = 8;
__host__ __device__ __forceinline__ int lds_byte(int r, int c) { const int st = (r >> 4) * 2 + (c >> 5), rr = r & 15, cc = c & 31, ob = rr * 64 + cc * 2; return st * 1024 + (ob ^ (((ob >> 9) & 1) << 5)); }
__host__ __device__ __forceinline__ void stage_rc(int b, int& R, int& C) { const int st = b / 1024, sb = b % 1024, swz = sb ^ (((sb >> 9) & 1) << 5); R = (st >> 1) * 16 + swz / 64; C = (st & 1) * 32 + (swz % 64) / 2; }
__host__ __device__ __forceinline__ int perm32(int rho) { const int n = rho >> 4, i = rho & 15; return 8 * (i >> 2) + 4 * n + (i & 3); }
struct Unit { int pm, pn; };
struct Gemm { const bf16_t* A; const bf16_t* Bt; int M, N, K, lda; };
struct StaticOrder {
    int nM, nN, nwg, G, c;
    __device__ void init(int M, int N, int G_, int c_) { nM = M / BM; nN = N / BM; nwg = nM * nN; G = G_; c = c_; }
    __device__ bool next(int i, Unit& u) const {
        const long L = (long)i * G + c; if (L >= nwg) return false;
        int wgid = (int)L; { const int q = nwg / NXCD, r = nwg % NXCD, xcd = wgid % NXCD, off = wgid / NXCD; wgid = (xcd < r ? xcd * (q + 1) : r * (q + 1) + (xcd - r) * q) + off; }
        const int nig = WGM * nN, gid = wgid / nig, fm = gid * WGM, gsz = (nM - fm) < WGM ? (nM - fm) : WGM;
        u.pm = fm + ((wgid % nig) % gsz); u.pn = (wgid % nig) / gsz; return true;
    }
};

template <int ACT, int STATS> struct EpiStore {
    static constexpr bool PERM = true;
    bf16_t* O; int ldc; const float* ss; float inv_n;
    __device__ __forceinline__ void operator()(const f32x4 (&acc)[2][2][4][2], const Unit& u, int wr, int wc, int fr, int fq) const {
        const int row0 = u.pm * BM + wr * 64 + fr, col0 = u.pn * BM + wc * 32 + 8 * fq;
#pragma unroll
        for (int ai = 0; ai < 2; ++ai)
#pragma unroll
            for (int m = 0; m < 4; ++m) {
                const int row = row0 + ai * HALF + m * 16;
                float rs = 1.0f;
                if (ss) { const f32x4* sp = (const f32x4*)(ss + (size_t)row * 16); const f32x4 a = sp[0], b = sp[1], c = sp[2], d = sp[3];
                    const float t = (((a[0] + a[1]) + (a[2] + a[3])) + ((b[0] + b[1]) + (b[2] + b[3]))) + (((c[0] + c[1]) + (c[2] + c[3])) + ((d[0] + d[1]) + (d[2] + d[3])));
                    rs = rsqrtf(t * inv_n + EPS); }
#pragma unroll
                for (int bj = 0; bj < 2; ++bj) {
                    f32x4 v0 = acc[ai][bj][m][0] * rs, v1 = acc[ai][bj][m][1] * rs;
                    if (ACT == 1) {
#pragma unroll
                        for (int e = 0; e < 4; ++e) { const float a = fmaxf(v0[e], 0.f), b = fmaxf(v1[e], 0.f); v0[e] = a * a; v1[e] = b * b; }
                    }
                    if (ACT == 2) {
#pragma unroll
                        for (int e = 0; e < 4; ++e) { v0[e] = gelu_tanh(v0[e]); v1[e] = gelu_tanh(v1[e]); }
                    }
                    if (ACT == 3) {
#pragma unroll
                        for (int e = 0; e < 4; ++e) { v0[e] = sigmoidf_(v0[e]); v1[e] = sigmoidf_(v1[e]); }
                    }
                    u32x4 w; w.x = cvt_pk_bf16(v0[0], v0[1]); w.y = cvt_pk_bf16(v0[2], v0[3]); w.z = cvt_pk_bf16(v1[0], v1[1]); w.w = cvt_pk_bf16(v1[2], v1[3]);
                    *(u32x4*)(O + (size_t)row * ldc + col0 + bj * HALF) = w;
                }
                asm volatile("" ::: "memory");
            }
    }
};
template <int MODE> struct EpiRes {
    static constexpr bool PERM = true;
    static constexpr int MB = (MODE == 1) ? 2 : 4;
    const float* hin; float* hout; bf16_t* hb; float* ssn; const bf16_t* pp;
    __device__ __forceinline__ void operator()(const f32x4 (&acc)[2][2][4][2], const Unit& u, int wr, int wc, int fr, int fq) const {
        const int row0 = u.pm * BM + wr * 64 + fr, col0 = u.pn * BM + wc * 32 + 8 * fq;
#pragma unroll
        for (int ai = 0; ai < 2; ++ai)
#pragma unroll
            for (int mg = 0; mg < 4; mg += MB) {
                f32x4 hv[MB][2][2]; u32x4 pw[MB][2];
#pragma unroll
                for (int mm = 0; mm < MB; ++mm)
#pragma unroll
                    for (int bj = 0; bj < 2; ++bj) {
                        const size_t off = (size_t)(row0 + ai * HALF + (mg + mm) * 16) * DM + col0 + bj * HALF;
                        hv[mm][bj][0] = *(const f32x4*)(hin + off); hv[mm][bj][1] = *(const f32x4*)(hin + off + 4);
                        if (MODE == 1) pw[mm][bj] = *(const u32x4*)(pp + off);
                    }
#pragma unroll
                for (int mm = 0; mm < MB; ++mm) {
                    const int m = mg + mm, row = row0 + ai * HALF + m * 16;
                    float q = 0.f;
#pragma unroll
                    for (int bj = 0; bj < 2; ++bj) {
                        const size_t off = (size_t)row * DM + col0 + bj * HALF;
                        f32x4 v0 = acc[ai][bj][m][0], v1 = acc[ai][bj][m][1];
                        if (MODE == 1) {
                            const u32x4 g = pw[mm][bj];
                            v0[0] *= bflo(g.x); v0[1] *= bfhi(g.x); v0[2] *= bflo(g.y); v0[3] *= bfhi(g.y);
                            v1[0] *= bflo(g.z); v1[1] *= bfhi(g.z); v1[2] *= bflo(g.w); v1[3] *= bfhi(g.w);
                        }
                        v0 += hv[mm][bj][0]; v1 += hv[mm][bj][1];
                        *(f32x4*)(hout + off) = v0; *(f32x4*)(hout + off + 4) = v1;
                        u32x4 w; w.x = cvt_pk_bf16(v0[0], v0[1]); w.y = cvt_pk_bf16(v0[2], v0[3]); w.z = cvt_pk_bf16(v1[0], v1[1]); w.w = cvt_pk_bf16(v1[2], v1[3]);
                        *(u32x4*)(hb + off) = w;
                        q += (v0[0] * v0[0] + v0[1] * v0[1]) + (v0[2] * v0[2] + v0[3] * v0[3]) + (v1[0] * v1[0] + v1[1] * v1[1]) + (v1[2] * v1[2] + v1[3] * v1[3]);
                    }
                    if (ssn) { q += __shfl_xor(q, 16); q += __shfl_xor(q, 32); if (fq == 0) ssn[(size_t)row * 16 + u.pn * 4 + wc] = q; }
                }
                asm volatile("" ::: "memory");
            }
    }
};

#ifndef PG8_SP2
#define PG8_SP2 true
#endif
#ifndef PG8_ALIGN
#define PG8_ALIGN true
#endif
template <class Epi, bool ALIGN_EPI = PG8_ALIGN, bool SP2 = PG8_SP2>
__device__ __forceinline__ void gemm_phase(int tid, LAS unsigned char* lds, const Gemm g, const StaticOrder& S, const Epi& E) {
    const int wid = __builtin_amdgcn_readfirstlane(tid >> 6), lane = tid & 63, wr = wid >> 2, wc = wid & 3, fr = lane & 15, fq = lane >> 4;
    const int K = g.K, nt = K / BK, lda = g.lda;
    unsigned voffA[2], voffB[2];
#pragma unroll
    for (int i = 0; i < 2; ++i) { int R, C; stage_rc(tid * 16 + i * 8192, R, C); const int Rb = Epi::PERM ? ((R & ~31) + perm32(R & 31)) : R;
        voffA[i] = (unsigned)(R * lda + C) * 2u; voffB[i] = (unsigned)(Rb * K + C) * 2u; }
    const size_t kstep = (size_t)(BK * 2);
    const size_t hstepA = (size_t)HALF * lda * 2, hstepB = (size_t)HALF * K * 2;
    const size_t tstepA = 2 * hstepA, tstepB = 2 * hstepB;
    const unsigned ldsw = (unsigned)wid * 1024u;
    const int aoff = lds_byte(wr * 64 + fr, fq * 8), boff = lds_byte(wc * 32 + fr, fq * 8);
#define PG8_SA(b, h) (((b) * 2 + (h)) * HTB)
#define PG8_SB(b, h) ((4 + (b) * 2 + (h)) * HTB)
#define PG8_STAGE(bufoff, gbase, voff) do { _Pragma("unroll") for (int _i = 0; _i < 2; ++_i) \
        __builtin_amdgcn_global_load_lds((const unsigned*)((const char*)(gbase) + (voff)[_i]), (LAS unsigned*)(lds + (bufoff) + ldsw + _i * 8192), 16, 0, 0); } while (0)
#define PG8_LDA(dst, b, h) do { _Pragma("unroll") for (int m = 0; m < 4; ++m) _Pragma("unroll") for (int k = 0; k < 2; ++k) dst[m][k] = *(const LAS bf16x8*)(lds + PG8_SA(b, h) + aoff + m * 2048 + k * 1024); } while (0)
#define PG8_LDB(dst, b, h) do { _Pragma("unroll") for (int n = 0; n < 2; ++n) _Pragma("unroll") for (int k = 0; k < 2; ++k) dst[n][k] = *(const LAS bf16x8*)(lds + PG8_SB(b, h) + boff + n * 2048 + k * 1024); } while (0)
#define PG8_MMA(ai, bj, At, Bt) do { __builtin_amdgcn_s_setprio(1); _Pragma("unroll") for (int m = 0; m < 4; ++m) _Pragma("unroll") for (int n = 0; n < 2; ++n) _Pragma("unroll") for (int k = 0; k < 2; ++k) \
        acc[ai][bj][m][n] = __builtin_amdgcn_mfma_f32_16x16x32_bf16(Bt[n][k], At[m][k], acc[ai][bj][m][n], 0, 0, 0); __builtin_amdgcn_s_setprio(0); } while (0)
#define PG8_WAIT_V(n) asm volatile("s_waitcnt vmcnt(" #n ")" ::: "memory")
#define PG8_WAIT_L(n) asm volatile("s_waitcnt lgkmcnt(" #n ")" ::: "memory")
#define PG8_BAR __builtin_amdgcn_s_barrier()
#define PG8_SCHED __builtin_amdgcn_sched_barrier(0)
    Unit cur, nxt; int ui = 0;
    if (!S.next(0, cur)) return;
    f32x4 acc[2][2][4][2];
#pragma unroll
    for (int a = 0; a < 2; ++a)
#pragma unroll
        for (int b = 0; b < 2; ++b)
#pragma unroll
            for (int m = 0; m < 4; ++m)
#pragma unroll
                for (int n = 0; n < 2; ++n) acc[a][b][m][n] = (f32x4){0.f, 0.f, 0.f, 0.f};
    bf16x8 At[4][2], B0[2][2], B1[2][2];
    const char* cA = (const char*)g.A + (size_t)cur.pm * tstepA; const char* cB = (const char*)g.Bt + (size_t)cur.pn * tstepB;
    if constexpr (SP2) {
    PG8_STAGE(PG8_SB(0, 0), cB, voffB); PG8_STAGE(PG8_SB(0, 1), cB + hstepB, voffB); PG8_STAGE(PG8_SA(0, 0), cA, voffA); PG8_STAGE(PG8_SA(0, 1), cA + hstepA, voffA);
    if (wr == 1) PG8_BAR;
    PG8_WAIT_V(2); PG8_BAR;
    PG8_STAGE(PG8_SB(1, 0), cB + kstep, voffB); PG8_STAGE(PG8_SA(1, 0), cA + kstep, voffA); PG8_STAGE(PG8_SB(1, 1), cB + hstepB + kstep, voffB);
    PG8_WAIT_V(6); PG8_BAR;
    } else {
    PG8_STAGE(PG8_SB(0, 0), cB, voffB); PG8_STAGE(PG8_SA(0, 0), cA, voffA); PG8_STAGE(PG8_SB(0, 1), cB + hstepB, voffB); PG8_STAGE(PG8_SA(0, 1), cA + hstepA, voffA);
    if (wr == 1) PG8_BAR;
    PG8_WAIT_V(4); PG8_BAR;
    PG8_STAGE(PG8_SB(1, 0), cB + kstep, voffB); PG8_STAGE(PG8_SA(1, 0), cA + kstep, voffA); PG8_STAGE(PG8_SB(1, 1), cB + hstepB + kstep, voffB);
    PG8_WAIT_V(6); PG8_BAR;
    }
    for (;;) {
        const bool has_next = S.next(ui + 1, nxt);
        const char* nA = has_next ? (const char*)g.A + (size_t)nxt.pm * tstepA : cA; const char* nB = has_next ? (const char*)g.Bt + (size_t)nxt.pn * tstepB : cB;
        for (int t = 0; t < nt; t += 2) {
            const bool last = (t == nt - 2);
            const char* a1 = cA + (size_t)(t + 1) * kstep;
            const char* a2 = last ? nA : cA + (size_t)(t + 2) * kstep; const char* b2 = last ? nB : cB + (size_t)(t + 2) * kstep;
            const char* a3 = a2 + kstep; const char* b3 = b2 + kstep;
            if constexpr (SP2) {
            PG8_LDB(B0, 0, 0); PG8_LDB(B1, 0, 1); PG8_SCHED; PG8_LDA(At, 0, 0); PG8_STAGE(PG8_SA(1, 1), a1 + hstepA, voffA);
            PG8_WAIT_V(8); PG8_WAIT_L(0); PG8_BAR; PG8_MMA(0, 0, At, B0); PG8_MMA(0, 1, At, B1); PG8_BAR; PG8_SCHED;
            PG8_LDA(At, 0, 1); PG8_STAGE(PG8_SB(0, 0), b2, voffB); PG8_STAGE(PG8_SB(0, 1), b2 + hstepB, voffB); PG8_STAGE(PG8_SA(0, 0), a2, voffA);
            PG8_WAIT_V(8); PG8_WAIT_L(0); PG8_BAR; PG8_MMA(1, 0, At, B0); PG8_MMA(1, 1, At, B1); PG8_BAR; PG8_SCHED;
            PG8_LDB(B0, 1, 0); PG8_LDB(B1, 1, 1); PG8_SCHED; PG8_LDA(At, 1, 0); PG8_STAGE(PG8_SA(0, 1), a2 + hstepA, voffA);
            PG8_WAIT_V(8); PG8_WAIT_L(0); PG8_BAR; PG8_MMA(0, 0, At, B0); PG8_MMA(0, 1, At, B1); PG8_BAR; PG8_SCHED;
            PG8_LDA(At, 1, 1); PG8_STAGE(PG8_SB(1, 0), b3, voffB); PG8_STAGE(PG8_SB(1, 1), b3 + hstepB, voffB); PG8_STAGE(PG8_SA(1, 0), a3, voffA);
            PG8_WAIT_V(8); PG8_WAIT_L(0); PG8_BAR; PG8_MMA(1, 0, At, B0); PG8_MMA(1, 1, At, B1); PG8_BAR; PG8_SCHED;
            } else {
            PG8_LDB(B0, 0, 0); PG8_SCHED; PG8_LDA(At, 0, 0); PG8_STAGE(PG8_SA(1, 1), a1 + hstepA, voffA);
            PG8_WAIT_L(8); PG8_BAR; PG8_WAIT_L(0); PG8_MMA(0, 0, At, B0); PG8_BAR; PG8_SCHED;
            PG8_LDB(B1, 0, 1); PG8_STAGE(PG8_SB(0, 0), b2, voffB);
            PG8_BAR; PG8_WAIT_L(0); PG8_MMA(0, 1, At, B1); PG8_BAR;
            PG8_LDA(At, 0, 1); PG8_STAGE(PG8_SA(0, 0), a2, voffA);
            PG8_BAR; PG8_WAIT_L(0); PG8_MMA(1, 0, At, B0); PG8_BAR; PG8_SCHED;
            PG8_STAGE(PG8_SB(0, 1), b2 + hstepB, voffB);
            PG8_WAIT_V(6); PG8_BAR; PG8_MMA(1, 1, At, B1); PG8_BAR;
            PG8_LDB(B0, 1, 0); PG8_SCHED; PG8_LDA(At, 1, 0); PG8_STAGE(PG8_SA(0, 1), a2 + hstepA, voffA);
            PG8_WAIT_L(8); PG8_BAR; PG8_WAIT_L(0); PG8_MMA(0, 0, At, B0); PG8_BAR; PG8_SCHED;
            PG8_LDB(B1, 1, 1); PG8_STAGE(PG8_SB(1, 0), b3, voffB);
            PG8_BAR; PG8_WAIT_L(0); PG8_MMA(0, 1, At, B1); PG8_BAR;
            PG8_LDA(At, 1, 1); PG8_STAGE(PG8_SA(1, 0), a3, voffA);
            PG8_BAR; PG8_WAIT_L(0); PG8_MMA(1, 0, At, B0); PG8_BAR; PG8_SCHED;
            PG8_STAGE(PG8_SB(1, 1), b3 + hstepB, voffB);
            PG8_WAIT_V(6); PG8_BAR; PG8_MMA(1, 1, At, B1); PG8_BAR;
            }
        }
        if constexpr (ALIGN_EPI) { if (wr == 0) PG8_BAR; }
        E(acc, cur, wr, wc, fr, fq);
        if (!has_next) break;
#pragma unroll
        for (int a = 0; a < 2; ++a)
#pragma unroll
            for (int b = 0; b < 2; ++b)
#pragma unroll
                for (int m = 0; m < 4; ++m)
#pragma unroll
                    for (int n = 0; n < 2; ++n) acc[a][b][m][n] = (f32x4){0.f, 0.f, 0.f, 0.f};
        cur = nxt; cA = nA; cB = nB; ++ui;
        if constexpr (ALIGN_EPI) { if (wr == 1) PG8_BAR; }
    }
    PG8_WAIT_V(0);
    if constexpr (!ALIGN_EPI) { if (wr == 0) PG8_BAR; }
    PG8_BAR;
#undef PG8_SA
#undef PG8_SB
#undef PG8_STAGE
#undef PG8_LDA
#undef PG8_LDB
#undef PG8_MMA
#undef PG8_WAIT_V
#undef PG8_WAIT_L
#undef PG8_BAR
#undef PG8_SCHED
}
}

__constant__ double kInvFreq[32] = {
    1.0, 0.7498942093324559, 0.5623413251903491, 0.4216965034285822, 0.31622776601683794, 0.23713737056616552, 0.1778279410038923, 0.1333521432163324,
    0.1, 0.07498942093324558, 0.05623413251903491, 0.04216965034285822, 0.03162277660168379, 0.023713737056616554, 0.01778279410038923, 0.01333521432163324,
    0.01, 0.007498942093324558, 0.005623413251903491, 0.004216965034285823, 0.0031622776601683794, 0.0023713737056616554, 0.001778279410038923, 0.001333521432163324,
    0.001, 0.0007498942093324559, 0.0005623413251903491, 0.0004216965034285823, 0.00031622776601683794, 0.00023713737056616554, 0.0001778279410038923, 0.0001333521432163324};

__device__ __forceinline__ float wave_sum(float v) {
#pragma unroll
    for (int o = 1; o < 64; o <<= 1) v += __shfl_xor(v, o);
    return v;
}
__device__ __forceinline__ void unpack8(const u32x4 w, float (&f)[8]) { f[0] = bflo(w.x); f[1] = bfhi(w.x); f[2] = bflo(w.y); f[3] = bfhi(w.y); f[4] = bflo(w.z); f[5] = bfhi(w.z); f[6] = bflo(w.w); f[7] = bfhi(w.w); }
__device__ __forceinline__ u32x4 pack8(const float (&f)[8]) { u32x4 w; w.x = cvt_pk_bf16(f[0], f[1]); w.y = cvt_pk_bf16(f[2], f[3]); w.z = cvt_pk_bf16(f[4], f[5]); w.w = cvt_pk_bf16(f[6], f[7]); return w; }

struct WDesc { const float* W; const float* gamma; bf16_t* dst; int K, N, Npad, mode, items; };
__device__ __forceinline__ WDesc wdesc(const Params& P, int id) {
    WDesc d; bf16_t* wb = (bf16_t*)(P.ws + OFF_W); d.gamma = nullptr; d.mode = 0;
    if (id < 12) {
        const int j = id & 1, f = id >> 1;
        switch (f) {
            case 0: d.W = P.in[6] + (size_t)j * DM * 704; d.K = DM; d.N = 704; d.Npad = LATP; d.dst = wb + WE_DOWN + (size_t)j * LATP * DM; d.gamma = P.in[3] + (2 * j) * DM; break;
            case 1: d.W = P.in[9] + (size_t)j * QLR * QP; d.K = QLR; d.N = QP; d.Npad = QP; d.dst = wb + WE_UQ + (size_t)j * QP * QLR; d.gamma = P.in[7] + j * QLR; d.mode = 1; break;
            case 2: d.W = P.in[10] + (size_t)j * KVLR * KVP; d.K = KVLR; d.N = KVP; d.Npad = KVP; d.dst = wb + WE_UKV + (size_t)j * KVP * KVLR; d.gamma = P.in[8] + j * KVLR; break;
            case 3: d.W = P.in[15] + (size_t)j * DM * DM; d.K = DM; d.N = DM; d.Npad = DM; d.dst = wb + WE_MOUT + (size_t)j * DM * DM; break;
            case 4: d.W = P.in[16] + (size_t)j * DM * ZP; d.K = DM; d.N = ZP; d.Npad = ZP; d.dst = wb + WE_GIN + (size_t)j * ZP * DM; d.gamma = P.in[3] + (2 * j + 1) * DM; break;
            default: d.W = P.in[21] + (size_t)j * 2048 * DM; d.K = 2048; d.N = DM; d.Npad = DM; d.dst = wb + WE_GOUT + (size_t)j * DM * 2048; break;
        }
    } else {
        const int i = (id - 12) & 3, f = (id - 12) >> 2;
        switch (f) {
            case 0: d.W = P.in[22] + (size_t)i * DM * DFF; d.K = DM; d.N = DFF; d.Npad = DFF; d.dst = wb + WE_UP + (size_t)i * DFF * DM; d.gamma = P.in[4] + i * DM; break;
            case 1: d.W = P.in[23] + (size_t)i * DFF * DM; d.K = DFF; d.N = DM; d.Npad = DM; d.dst = wb + WE_DN + (size_t)i * DM * DFF; break;
            case 2: d.W = P.in[24] + (size_t)i * DM * DM; d.K = DM; d.N = DM; d.Npad = DM; d.dst = wb + WE_GATE + (size_t)i * DM * DM; d.gamma = P.in[5] + i * DM; break;
            default: d.W = P.in[25] + (size_t)i * PLE * DM; d.K = PLE; d.N = DM; d.Npad = DM; d.dst = wb + WE_PROJ + (size_t)i * DM * PLE; break;
        }
    }
    d.items = (d.K / 64) * (d.Npad / 32);
    return d;
}
__device__ __forceinline__ void conv_item(const WDesc& d, int item, float* scr, int lane) {
    const int nblk = d.Npad / 32, kb = item / nblk, nb = item % nblk, k0 = 64 * kb, n0 = 32 * nb;
    int sn0 = n0;
    if (d.mode == 1) { if (n0 < 1024) sn0 = (n0 >> 7) * 192 + (n0 & 127); else { const int r = n0 - 1024; sn0 = (r >> 6) * 192 + 128 + (r & 63); } }
    const bool valid = sn0 < d.N;
#pragma unroll
    for (int i = 0; i < 32; ++i) { const int kk = 2 * i + (lane >> 5);
        float v = valid ? d.W[(size_t)(k0 + kk) * d.N + sn0 + (lane & 31)] : 0.f;
        if (d.gamma) v *= d.gamma[k0 + kk];
        scr[kk * 33 + (lane & 31)] = v; }
    asm volatile("s_waitcnt lgkmcnt(0)" ::: "memory");
    const int c = lane & 7;
#pragma unroll
    for (int j = 0; j < 4; ++j) { const int n = (lane >> 3) + 8 * j; const float* s = scr + (8 * c) * 33 + n;
        u32x4 o; o.x = cvt_pk_bf16(s[0 * 33], s[1 * 33]); o.y = cvt_pk_bf16(s[2 * 33], s[3 * 33]); o.z = cvt_pk_bf16(s[4 * 33], s[5 * 33]); o.w = cvt_pk_bf16(s[6 * 33], s[7 * 33]);
        *(u32x4*)(d.dst + (size_t)(n0 + n) * d.K + k0 + 8 * c) = o; }
    asm volatile("s_waitcnt lgkmcnt(0)" ::: "memory");
}
__device__ __forceinline__ void p0_prologue(int tid, const Params& P, unsigned char* lds) {
    const int lane = tid & 63, wave = __builtin_amdgcn_readfirstlane(tid >> 6);
    const int gw = blockIdx.x * 8 + wave, NGW = gridDim.x * 8;
    const size_t gt = (size_t)blockIdx.x * 512 + tid, NGT = (size_t)gridDim.x * 512;
    float* scr = (float*)(lds + wave * 8704);
    int total = 0;
    for (int id = 0; id < 28; ++id) total += wdesc(P, id).items;
    for (int it = gw; it < total; it += NGW) {
        int r = it, id = 0; WDesc d = wdesc(P, 0);
        while (r >= d.items) { r -= d.items; ++id; d = wdesc(P, id); }
        conv_item(d, r, scr, lane);
    }
    { unsigned* bw = (unsigned*)(P.ws + OFF_BAR); for (size_t i = gt; i < XCD_BAR_WORDS; i += NGT) bw[i] = 0u; }
    { const f32x4* src = (const f32x4*)P.in[1]; u32x4* dst = (u32x4*)(P.ws + OFF_PB); const size_t n8 = (size_t)DEPTH * T * PLE / 8;
      for (size_t i0 = gt; i0 < n8; i0 += 4 * NGT) {
          f32x4 a[4], b[4];
#pragma unroll
          for (int u = 0; u < 4; ++u) { const size_t i = i0 + u * NGT; if (i < n8) { a[u] = src[2 * i]; b[u] = src[2 * i + 1]; } }
#pragma unroll
          for (int u = 0; u < 4; ++u) { const size_t i = i0 + u * NGT; if (i < n8) { u32x4 w; w.x = cvt_pk_bf16(a[u][0], a[u][1]); w.y = cvt_pk_bf16(a[u][2], a[u][3]); w.z = cvt_pk_bf16(b[u][0], b[u][1]); w.w = cvt_pk_bf16(b[u][2], b[u][3]); dst[i] = w; } } } }
    { float* ssp = (float*)(P.ws + OFF_SS); bf16_t* hb = (bf16_t*)(P.ws + OFF_HB);
#pragma unroll 2
      for (int row = gw; row < T; row += NGW) {
          const f32x4* xr = (const f32x4*)(P.in[0] + (size_t)row * DM) + lane; float s = 0.f;
          unsigned long long* o8 = (unsigned long long*)(hb + (size_t)row * DM) + lane;
#pragma unroll
          for (int j = 0; j < 4; ++j) { const f32x4 v = xr[64 * j]; s += (v[0] * v[0] + v[1] * v[1]) + (v[2] * v[2] + v[3] * v[3]);
              o8[64 * j] = (unsigned long long)cvt_pk_bf16(v[0], v[1]) | ((unsigned long long)cvt_pk_bf16(v[2], v[3]) << 32); }
          s = wave_sum(s); if (lane < 16) ssp[(size_t)row * 16 + lane] = (lane == 0) ? s : 0.f; } }
}

__device__ __forceinline__ void r2_phase(int tid, const Params& P, int j) {
    const int lane = tid & 63, wave = __builtin_amdgcn_readfirstlane(tid >> 6);
    const int gw = blockIdx.x * 8 + wave, NGW = gridDim.x * 8;
    bf16_t* Q = (bf16_t*)(P.ws + OFF_FF + FF_Q); bf16_t* KV = (bf16_t*)(P.ws + OFF_FF + FF_KV); bf16_t* LAT = (bf16_t*)(P.ws + OFF_FF + FF_LAT);
    const float* gqn = P.in[11] + j * 128; const float* gqr = P.in[12] + j * 64; const float* gkn = P.in[13] + j * 128; const float* gkr = P.in[14] + j * 64;
    const int* pos = (const int*)P.in[2];
    float g_qn[2][8], g_kn[2][8], g_qr[8], g_kr[8];
#pragma unroll
    for (int i = 0; i < 2; ++i)
#pragma unroll
        for (int e = 0; e < 8; ++e) { const int d = (8 * lane + 512 * i + e) & 127; g_qn[i][e] = gqn[d] * QSCALE; g_kn[i][e] = gkn[d]; }
#pragma unroll
    for (int e = 0; e < 8; ++e) { const int r = 8 * (lane & 7) + e; g_qr[e] = gqr[r] * QSCALE; g_kr[e] = gkr[r]; }
    const double invf = kInvFreq[lane & 31];
    for (int row = gw; row < T; row += NGW) {
        float rq, rkv;
        { u32x4 z4 = {0u, 0u, 0u, 0u};
          const u32x4 lq = (lane < 48) ? *(const u32x4*)(LAT + (size_t)row * LATP + 8 * lane) : z4;
          const u32x4 lk = (lane < 32) ? *(const u32x4*)(LAT + (size_t)row * LATP + QLR + 8 * lane) : z4;
          float a[8], b[8]; unpack8(lq, a); unpack8(lk, b); float sa = 0.f, sb = 0.f;
#pragma unroll
          for (int e = 0; e < 8; ++e) { sa += a[e] * a[e]; sb += b[e] * b[e]; }
          rq = rsqrtf(wave_sum(sa) * (1.0f / QLR) + EPS); rkv = rsqrtf(wave_sum(sb) * (1.0f / KVLR) + EPS); }
        const double ang = (double)pos[row] * invf; double rev = ang * 0.15915494309189535; rev -= floor(rev);
        const float cs = __builtin_amdgcn_cosf((float)rev), sn = __builtin_amdgcn_sinf((float)rev);
        float cj[8], sj[8];
#pragma unroll
        for (int e = 0; e < 8; ++e) { cj[e] = __shfl(cs, 8 * (lane & 3) + e); sj[e] = __shfl(sn, 8 * (lane & 3) + e); }
#pragma unroll
        for (int i = 0; i < 2; ++i) {
            const int idx = 8 * lane + 512 * i, head = idx >> 7, d = idx & 127;
            u32x4* qp = (u32x4*)(Q + (size_t)row * QP + idx); u32x4* kp = (u32x4*)(KV + (size_t)row * KVP + head * 256 + d);
            float a[8], b[8]; unpack8(*qp, a); unpack8(*kp, b);
            { u32x4* vp = (u32x4*)(KV + (size_t)row * KVP + head * 256 + 128 + d); float vv[8]; unpack8(*vp, vv);
#pragma unroll
              for (int e = 0; e < 8; ++e) vv[e] *= rkv;
              *vp = pack8(vv); }
            float sa = 0.f, sb = 0.f;
#pragma unroll
            for (int e = 0; e < 8; ++e) { a[e] *= rq; b[e] *= rkv; sa += a[e] * a[e]; sb += b[e] * b[e]; }
#pragma unroll
            for (int o = 1; o < 16; o <<= 1) { sa += __shfl_xor(sa, o); sb += __shfl_xor(sb, o); }
            const float ra = rsqrtf(sa * (1.0f / 128) + EPS), rb = rsqrtf(sb * (1.0f / 128) + EPS);
#pragma unroll
            for (int e = 0; e < 8; ++e) { a[e] = a[e] * ra * g_qn[i][e]; b[e] = b[e] * rb * g_kn[i][e]; }
            *qp = pack8(a); *kp = pack8(b);
        }
        {
            u32x4* qp = (u32x4*)(Q + (size_t)row * QP + 1024 + 8 * lane); u32x4* kp = (u32x4*)(LAT + (size_t)row * LATP + 640 + 8 * (lane & 7));
            float a[8], b[8]; unpack8(*qp, a); unpack8(*kp, b);
            float sa = 0.f, sb = 0.f;
#pragma unroll
            for (int e = 0; e < 8; ++e) { a[e] *= rq; sa += a[e] * a[e]; sb += b[e] * b[e]; }
#pragma unroll
            for (int o = 1; o < 8; o <<= 1) { sa += __shfl_xor(sa, o); sb += __shfl_xor(sb, o); }
            const float ra = rsqrtf(sa * (1.0f / 64) + EPS), rb = rsqrtf(sb * (1.0f / 64) + EPS);
            const bool hi = (lane & 4) != 0;
#pragma unroll
            for (int e = 0; e < 8; ++e) {
                const float ya = a[e] * ra * g_qr[e], yb = b[e] * rb * g_kr[e];
                const float pa = __shfl_xor(ya, 4), pb = __shfl_xor(yb, 4);
                a[e] = hi ? (ya * cj[e] + pa * sj[e]) : (ya * cj[e] - pa * sj[e]);
                b[e] = hi ? (yb * cj[e] + pb * sj[e]) : (yb * cj[e] - pb * sj[e]);
            }
            *qp = pack8(a); if (lane < 8) *kp = pack8(b);
        }
    }
}

constexpr int KROW = 400, VROW = 288, KTILE = 64 * KROW, VTILE = 64 * VROW;
__device__ __forceinline__ void attn_unit(int tid, unsigned char* lds, const bf16_t* Q, const bf16_t* KV, const bf16_t* KR, bf16_t* O, int b, int h, int qb) {
    const int lane = tid & 63, w = __builtin_amdgcn_readfirstlane(tid >> 6), r = lane & 15, g = lane >> 4;
    const int row0 = b * SEQ + qb * 256, qrow = row0 + 32 * w + r;
    bf16x8 qf[2][6];
#pragma unroll
    for (int rg = 0; rg < 2; ++rg) {
#pragma unroll
        for (int ks = 0; ks < 4; ++ks) qf[rg][ks] = *(const bf16x8*)(Q + (size_t)(qrow + 16 * rg) * QP + h * 128 + 32 * ks + 8 * g);
#pragma unroll
        for (int ks = 0; ks < 2; ++ks) qf[rg][4 + ks] = *(const bf16x8*)(Q + (size_t)(qrow + 16 * rg) * QP + 1024 + h * 64 + 32 * ks + 8 * g);
    }
    const int ntiles = 4 * qb + 4, last_tile = 4 * qb + (w >> 1);
    const int kn_row0 = tid >> 4, kn_ch = tid & 15;
    const int kr_row = tid >> 3, kr_ch = tid & 7;
    const bf16_t* gk = KV + (size_t)(b * SEQ) * KVP + h * 256;
    const bf16_t* gr = KR + (size_t)(b * SEQ) * LATP;
    u32x4 sk0, sk1, sr, sv0, sv1;
#define ATT_LOAD(t) do { const size_t kb = (size_t)(t) * 64; \
        sk0 = *(const u32x4*)(gk + (kb + kn_row0) * KVP + kn_ch * 8); sk1 = *(const u32x4*)(gk + (kb + kn_row0 + 32) * KVP + kn_ch * 8); \
        sv0 = *(const u32x4*)(gk + (kb + kn_row0) * KVP + 128 + kn_ch * 8); sv1 = *(const u32x4*)(gk + (kb + kn_row0 + 32) * KVP + 128 + kn_ch * 8); \
        sr = *(const u32x4*)(gr + (kb + kr_row) * LATP + kr_ch * 8); } while (0)
#define ATT_STORE(buf) do { unsigned char* kb_ = lds + (buf) * KTILE; unsigned char* vb_ = lds + 2 * KTILE + (buf) * VTILE; \
        *(u32x4*)(kb_ + kn_row0 * KROW + kn_ch * 16) = sk0; *(u32x4*)(kb_ + (kn_row0 + 32) * KROW + kn_ch * 16) = sk1; \
        *(u32x4*)(kb_ + kr_row * KROW + 256 + kr_ch * 16) = sr; \
        *(u32x4*)(vb_ + kn_row0 * VROW + kn_ch * 16) = sv0; *(u32x4*)(vb_ + (kn_row0 + 32) * VROW + kn_ch * 16) = sv1; } while (0)
    f32x4 o[2][8];
#pragma unroll
    for (int rg = 0; rg < 2; ++rg)
#pragma unroll
        for (int i = 0; i < 8; ++i) o[rg][i] = (f32x4){0.f, 0.f, 0.f, 0.f};
    float m[2] = {-1e30f, -1e30f}, l[2] = {0.f, 0.f};
    ATT_LOAD(0); ATT_STORE(0);
    __syncthreads();
    const int q4 = r >> 2, p4 = lane & 3;
    const int vtr_off = (4 * g + q4) * VROW + (4 * p4) * 2;
    const int qidx = qb * 256 + 32 * w + r;
    for (int t = 0; t < ntiles; ++t) {
        const bool more = (t + 1 < ntiles);
        if (more) ATT_LOAD(t + 1);
        if (t <= last_tile) {
            const unsigned char* Kb = lds + (t & 1) * KTILE; const unsigned char* Vb = lds + 2 * KTILE + (t & 1) * VTILE;
            f32x4 p[2][4];
#pragma unroll
            for (int kb = 0; kb < 4; ++kb) {
                p[0][kb] = (f32x4){0.f, 0.f, 0.f, 0.f}; p[1][kb] = (f32x4){0.f, 0.f, 0.f, 0.f};
#pragma unroll
                for (int ks = 0; ks < 6; ++ks) {
                    const bf16x8 a = *(const bf16x8*)(Kb + (16 * kb + r) * KROW + ks * 64 + g * 16);
                    p[0][kb] = __builtin_amdgcn_mfma_f32_16x16x32_bf16(a, qf[0][ks], p[0][kb], 0, 0, 0);
                    p[1][kb] = __builtin_amdgcn_mfma_f32_16x16x32_bf16(a, qf[1][ks], p[1][kb], 0, 0, 0);
                }
            }
            const bool diag = (t * 64 + 63 > qb * 256 + 32 * w);
            bf16x8 pb[2][2];
#pragma unroll
            for (int rg = 0; rg < 2; ++rg) {
                if (diag) {
#pragma unroll
                    for (int kb = 0; kb < 4; ++kb)
#pragma unroll
                        for (int i = 0; i < 4; ++i) { const int kk = t * 64 + 16 * kb + 4 * g + i; if (kk > qidx + 16 * rg) p[rg][kb][i] = -1e30f; }
                }
                float mx = fmaxf(fmaxf(p[rg][0][0], p[rg][0][1]), fmaxf(p[rg][0][2], p[rg][0][3]));
#pragma unroll
                for (int kb = 1; kb < 4; ++kb) mx = fmaxf(mx, fmaxf(fmaxf(p[rg][kb][0], p[rg][kb][1]), fmaxf(p[rg][kb][2], p[rg][kb][3])));
                mx = fmaxf(mx, __shfl_xor(mx, 16)); mx = fmaxf(mx, __shfl_xor(mx, 32));
                const float mn = fmaxf(m[rg], mx), alpha = fast_exp2(m[rg] - mn); m[rg] = mn;
                float rsum = 0.f;
#pragma unroll
                for (int kb = 0; kb < 4; ++kb)
#pragma unroll
                    for (int i = 0; i < 4; ++i) { p[rg][kb][i] = fast_exp2(p[rg][kb][i] - mn); rsum += p[rg][kb][i]; }
                l[rg] = l[rg] * alpha + rsum;
#pragma unroll
                for (int i = 0; i < 8; ++i) o[rg][i] *= alpha;
#pragma unroll
                for (int kk = 0; kk < 2; ++kk) {
                    u32x4 pw; pw.x = cvt_pk_bf16(p[rg][2 * kk][0], p[rg][2 * kk][1]); pw.y = cvt_pk_bf16(p[rg][2 * kk][2], p[rg][2 * kk][3]);
                    pw.z = cvt_pk_bf16(p[rg][2 * kk + 1][0], p[rg][2 * kk + 1][1]); pw.w = cvt_pk_bf16(p[rg][2 * kk + 1][2], p[rg][2 * kk + 1][3]);
                    pb[rg][kk] = __builtin_bit_cast(bf16x8, pw);
                }
            }
#pragma unroll
            for (int db = 0; db < 8; ++db)
#pragma unroll
                for (int kk = 0; kk < 2; ++kk) {
                    const LAS unsigned char* vp = (const LAS unsigned char*)(Vb + vtr_off + (32 * kk) * VROW + db * 32);
                    const s16x4 lo = __builtin_bit_cast(s16x4, __builtin_amdgcn_ds_read_tr16_b64_v4i16((LAS s16x4*)vp));
                    const s16x4 hi = __builtin_bit_cast(s16x4, __builtin_amdgcn_ds_read_tr16_b64_v4i16((LAS s16x4*)(vp + 16 * VROW)));
                    const bf16x8 vf = __builtin_shufflevector(lo, hi, 0, 1, 2, 3, 4, 5, 6, 7);
                    o[0][db] = __builtin_amdgcn_mfma_f32_16x16x32_bf16(vf, pb[0][kk], o[0][db], 0, 0, 0);
                    o[1][db] = __builtin_amdgcn_mfma_f32_16x16x32_bf16(vf, pb[1][kk], o[1][db], 0, 0, 0);
                }
        }
        if (more) ATT_STORE((t + 1) & 1);
        __syncthreads();
    }
#pragma unroll
    for (int rg = 0; rg < 2; ++rg) {
        float ls = l[rg]; ls += __shfl_xor(ls, 16); ls += __shfl_xor(ls, 32);
        const float inv = fast_rcp(ls);
        bf16_t* orow = O + (size_t)(qrow + 16 * rg) * QP + h * 128 + 4 * g;
#pragma unroll
        for (int db = 0; db < 8; ++db) {
            u32x2 wv; wv.x = cvt_pk_bf16(o[rg][db][0] * inv, o[rg][db][1] * inv); wv.y = cvt_pk_bf16(o[rg][db][2] * inv, o[rg][db][3] * inv);
            *(u32x2*)(orow + 16 * db) = wv;
        }
    }
#undef ATT_LOAD
#undef ATT_STORE
}
__device__ __forceinline__ void attn_phase(int tid, const Params& P, unsigned char* lds) {
    bf16_t* Q = (bf16_t*)(P.ws + OFF_FF + FF_Q); const bf16_t* KV = (const bf16_t*)(P.ws + OFF_FF + FF_KV); const bf16_t* KR = (const bf16_t*)(P.ws + OFF_FF + FF_LAT) + 640;
    for (int pr = blockIdx.x; pr < 512; pr += gridDim.x) {
        const int bh = pr >> 2, x = pr & 3, b = bh >> 3, h = bh & 7;
        attn_unit(tid, lds, Q, KV, KR, Q, b, h, 7 - x);
        attn_unit(tid, lds, Q, KV, KR, Q, b, h, x);
    }
}

constexpr int SROW = 576;
constexpr int SGU_STAT_OFF = 128 * SROW;
constexpr int SGU_W_OFF = SGU_STAT_OFF + 2048, SWROW = 272;
__device__ __forceinline__ void sgu_phase(int tid, const Params& P, unsigned char* lds, int j) {
    const int lane = tid & 63, w = __builtin_amdgcn_readfirstlane(tid >> 6), r = lane & 31, hh = lane >> 5;
    bf16_t* Z = (bf16_t*)(P.ws + OFF_FF);
    const float* lng = P.in[17] + j * 2048; const float* lnb = P.in[18] + j * 2048;
    const float* wsp = P.in[19] + (size_t)j * 8 * 128 * 128; const float* bsp = P.in[20] + j * 8 * 128;
    const int q4 = (lane & 15) >> 2, p4 = lane & 3, colblk = (lane >> 4) & 1;
    f32x2* stl = (f32x2*)(lds + SGU_STAT_OFF);
    for (int unit = blockIdx.x; unit < 256; unit += gridDim.x) {
        const int row0 = unit * 128;
        for (int rr0 = 0; rr0 < 16; rr0 += 4) {
            u32x4 raw[4][4];
#pragma unroll
            for (int a = 0; a < 4; ++a)
#pragma unroll
                for (int i = 0; i < 4; ++i) raw[a][i] = *(const u32x4*)(Z + (size_t)(row0 + 16 * w + rr0 + a) * ZP + 2048 + 8 * lane + 512 * i);
#pragma unroll
            for (int a = 0; a < 4; ++a) {
                float s1 = 0.f, s2 = 0.f;
#pragma unroll
                for (int i = 0; i < 4; ++i) { float v[8]; unpack8(raw[a][i], v);
#pragma unroll
                    for (int e = 0; e < 8; ++e) { s1 += v[e]; s2 += v[e] * v[e]; } }
                s1 = wave_sum(s1); s2 = wave_sum(s2);
                const float mu = s1 * (1.0f / 2048), var = s2 * (1.0f / 2048) - mu * mu;
                if (lane == 0) stl[16 * w + rr0 + a] = (f32x2){mu, rsqrtf(fmaxf(var, 0.f) + EPS)};
            }
        }
        __syncthreads();
        for (int g = 0; g < 8; ++g) {
#pragma unroll 2
            for (int i = 0; i < 8; ++i) {
                const int chunk = tid + 512 * i, row = chunk >> 5, ch = chunk & 31, col = g * 256 + ch * 8;
                float v[8]; unpack8(*(const u32x4*)(Z + (size_t)(row0 + row) * ZP + 2048 + col), v);
                const f32x2 st = stl[row]; const float mu = st.x, rstd = st.y;
                const f32x4 g0 = *(const f32x4*)(lng + col), g1 = *(const f32x4*)(lng + col + 4), b0 = *(const f32x4*)(lnb + col), b1 = *(const f32x4*)(lnb + col + 4);
#pragma unroll
                for (int e = 0; e < 4; ++e) { v[e] = (v[e] - mu) * rstd * g0[e] + b0[e]; v[4 + e] = (v[4 + e] - mu) * rstd * g1[e] + b1[e]; }
                *(u32x4*)(lds + row * SROW + ch * 16) = pack8(v);
            }
            {
                const float* wg = wsp + (size_t)g * 128 * 128;
                f32x4 w0[4], w1[4];
#pragma unroll
                for (int i = 0; i < 4; ++i) { const int c = tid + 512 * i, t = c >> 4, s0 = (c & 15) * 8; w0[i] = *(const f32x4*)(wg + t * 128 + s0); w1[i] = *(const f32x4*)(wg + t * 128 + s0 + 4); }
#pragma unroll
                for (int i = 0; i < 4; ++i) { const int c = tid + 512 * i, t = c >> 4, s0 = (c & 15) * 8;
                    float wv[8] = {w0[i][0], w0[i][1], w0[i][2], w0[i][3], w1[i][0], w1[i][1], w1[i][2], w1[i][3]};
#pragma unroll
                    for (int e = 0; e < 8; ++e) if (s0 + e > t) wv[e] = 0.f;
                    *(u32x4*)(lds + SGU_W_OFF + t * SWROW + s0 * 2) = pack8(wv); }
            }
            __syncthreads();
            bf16x8 af[8];
#pragma unroll
            for (int ks = 0; ks < 8; ++ks) {
                const LAS unsigned char* vp = (const LAS unsigned char*)(lds + (16 * ks + 8 * hh + q4) * SROW + (32 * w + 16 * colblk + 4 * p4) * 2);
                const s16x4 lo = __builtin_bit_cast(s16x4, __builtin_amdgcn_ds_read_tr16_b64_v4i16((LAS s16x4*)vp));
                const s16x4 hi = __builtin_bit_cast(s16x4, __builtin_amdgcn_ds_read_tr16_b64_v4i16((LAS s16x4*)(vp + 4 * SROW)));
                af[ks] = __builtin_shufflevector(lo, hi, 0, 1, 2, 3, 4, 5, 6, 7);
            }
#pragma unroll
            for (int tb = 0; tb < 4; ++tb) {
                f32x16 acc;
#pragma unroll
                for (int e = 0; e < 16; ++e) acc[e] = 0.f;
                const int t = 32 * tb + r;
#pragma unroll
                for (int ks = 0; ks < 8; ++ks) {
                    if (ks <= 2 * tb + 1) {
                        const bf16x8 bfr = *(const bf16x8*)(lds + SGU_W_OFF + t * SWROW + (16 * ks + 8 * hh) * 2);
                        acc = __builtin_amdgcn_mfma_f32_32x32x16_bf16(af[ks], bfr, acc, 0, 0, 0);
                    }
                }
                const float bias = bsp[g * 128 + t];
                bf16_t* up = Z + (size_t)(row0 + t) * ZP + g * 256 + 32 * w + 4 * hh;
#pragma unroll
                for (int i4 = 0; i4 < 4; ++i4) {
                    const u32x2 uu = *(const u32x2*)(up + 8 * i4);
                    u32x2 y; y.x = cvt_pk_bf16(bflo(uu.x) * (acc[4 * i4] + bias), bfhi(uu.x) * (acc[4 * i4 + 1] + bias));
                    y.y = cvt_pk_bf16(bflo(uu.y) * (acc[4 * i4 + 2] + bias), bfhi(uu.y) * (acc[4 * i4 + 3] + bias));
                    *(u32x2*)(up + 8 * i4) = y;
                }
            }
            __syncthreads();
        }
    }
}


#define XB_TMO      128
#define XB_XCNT(j)  (256  + 64 * (j))
#define XB_XSUB(j)  (1280 + 64 * (j))
#define XB_XGEN(j)  (2304 + 64 * (j))
#define XB_TOP      3328
#define XB_TOPGEN   3392
#define XB_SPIN_CAP (1u << 22)
__device__ __forceinline__ unsigned xb_ld(unsigned* p)              { return __hip_atomic_load(p, __ATOMIC_RELAXED, __HIP_MEMORY_SCOPE_AGENT); }
__device__ __forceinline__ unsigned xb_add(unsigned* p, unsigned v) { return __hip_atomic_fetch_add(p, v, __ATOMIC_RELAXED, __HIP_MEMORY_SCOPE_AGENT); }
__device__ __forceinline__ unsigned xb_xcc_id() { return (unsigned)__builtin_amdgcn_s_getreg((3 << 11) | 20) & 0xFu; }
#define XB_SPIN(cond, bar) do { unsigned _sp = 0; while (cond) { __builtin_amdgcn_s_sleep(1); \
    if ((++_sp & 255u) == 0u) { if (xb_ld(&(bar)[XB_TMO])) break; if (_sp > XB_SPIN_CAP) { atomicAdd(&(bar)[XB_TMO], 1u); break; } } } } while (0)
__device__ __forceinline__ void xcd_barrier_complete(unsigned* bar, unsigned x, unsigned& nloc, unsigned& nx) {
    const unsigned G = gridDim.x;
    unsigned sum, cnt, mine, sp = 0u;
    for (;;) {
        sum = 0u; cnt = 0u; mine = 0u;
#pragma unroll
        for (unsigned j = 0; j < 16; ++j) { const unsigned c = xb_ld(&bar[XB_XCNT(j)]); sum += c; cnt += (c > 0u) ? 1u : 0u; mine = (j == x) ? c : mine; }
        if (sum == G) break;
        __builtin_amdgcn_s_sleep(1);
        if ((++sp & 255u) == 0u) { if (xb_ld(&bar[XB_TMO])) break; if (sp > XB_SPIN_CAP) { atomicAdd(&bar[XB_TMO], 1u); break; } }
    }
    nloc = mine > 0u ? mine : 1u; nx = cnt > 0u ? cnt : 1u;
}
__device__ __forceinline__ void xcd_barrier(unsigned* bar, unsigned x, volatile LAS unsigned* st) {
    asm volatile("s_waitcnt vmcnt(0)" ::: "memory");
    __syncthreads();
    if (threadIdx.x == 0) {
        __builtin_amdgcn_s_waitcnt(0);
        unsigned nloc = st[0], nx = st[1];
        if (nloc == 0u) { xcd_barrier_complete(bar, x, nloc, nx); st[0] = nloc; st[1] = nx; }
        const unsigned old = xb_add(&bar[XB_XSUB(x)], 1u);
        const unsigned gen = old / nloc;
        if (old + 1u == (gen + 1u) * nloc) {
            __builtin_amdgcn_fence(__ATOMIC_RELEASE, "agent");
            asm volatile("s_waitcnt vmcnt(0)" ::: "memory");
            const unsigned og = xb_add(&bar[XB_TOP], 1u);
            const unsigned tg = og / nx;
            if (og + 1u == (tg + 1u) * nx) xb_add(&bar[XB_TOPGEN], 1u);
            else XB_SPIN(xb_ld(&bar[XB_TOPGEN]) == tg, bar);
            __builtin_amdgcn_fence(__ATOMIC_ACQUIRE, "agent");
            xb_add(&bar[XB_XGEN(x)], 1u);
            asm volatile("s_waitcnt vmcnt(0)" ::: "memory");
        } else {
            XB_SPIN(xb_ld(&bar[XB_XGEN(x)]) == gen, bar);
            __builtin_amdgcn_fence(__ATOMIC_ACQUIRE, "agent");
            asm volatile("s_waitcnt vmcnt(0)" ::: "memory");
        }
    }
    __syncthreads();
}

constexpr int NPHASE = 1 + 9 * DEPTH;
__device__ __forceinline__ int otid(int t) { asm volatile("" : "+v"(t)); return t; }
__device__ __forceinline__ Params load_params() {
    Params P{};
#if defined(__HIP_DEVICE_COMPILE__)
    typedef const __attribute__((address_space(4))) unsigned long long* kp_t;
    kp_t kp = (kp_t)__builtin_amdgcn_kernarg_segment_ptr(); asm volatile("" : "+s"(kp));
#pragma unroll
    for (int i = 0; i < 26; ++i) P.in[i] = (const float*)kp[i];
    P.out = (float*)kp[26]; P.ws = (unsigned char*)kp[27];
#endif
    return P;
}
__host__ __device__ __forceinline__ bool phase_nonempty(int ph) {
    if (ph == 0) return true;
    const int layer = (ph - 1) / 9, slot = (ph - 1) % 9;
    if ((layer & 1) && (slot == 3 || slot == 4)) return false;
    return true;
}

__global__ void __launch_bounds__(512) fwd_megakernel(Params Parg) {
    extern __shared__ __attribute__((aligned(16))) unsigned char lds[];
    LAS unsigned char* ldsl = (LAS unsigned char*)lds;
    const int wv0 = __builtin_amdgcn_readfirstlane((int)threadIdx.x >> 6);
    volatile LAS unsigned* bst = (volatile LAS unsigned*)(ldsl + 131072);
    if (threadIdx.x == 0) { bst[0] = 0u; bst[1] = 0u; }
    __syncthreads();
    unsigned* const bar = (unsigned*)(Parg.ws + OFF_BAR);
    const unsigned xcc = xb_xcc_id();
    int nseam = 0;
    bool first = true;
    for (int ph = Parg.ph_lo; ph < Parg.ph_hi; ++ph) {
        if (!phase_nonempty(ph)) continue;
        if (!first) {
            if (nseam == 0) { cg::this_grid().sync(); if (threadIdx.x == 0) (void)xb_add(&bar[XB_XCNT(xcc)], 1u); }
            else xcd_barrier(bar, xcc, bst);
            ++nseam;
        }
        first = false;
        const Params P = load_params();
        unsigned char* ws = P.ws;
        bf16_t* wb = (bf16_t*)(ws + OFF_W);
        bf16_t* hb = (bf16_t*)(ws + OFF_HB);
        float* SS = (float*)(ws + OFF_SS);
        const int G = gridDim.x, c = blockIdx.x;
        int tid; asm volatile("v_mbcnt_lo_u32_b32 %0, -1, 0\n\tv_mbcnt_hi_u32_b32 %0, -1, %0" : "=v"(tid)); tid = (tid + wv0 * 64) & 511;
#ifndef NO_P0
        if (ph == 0) { p0_prologue(otid(tid), P, lds); continue; }
#else
        if (ph == 0) continue;
#endif
        const int layer = (ph - 1) / 9, slot = (ph - 1) % 9, j = layer >> 1;
        const bool mla = (layer & 1) == 0;
        float* ss_mix = SS; float* ss_ffn = SS; float* ss_ple = SS;
        float* ss_next = (layer + 1 < DEPTH) ? SS : nullptr;
        const float* hin = (layer == 0) ? P.in[0] : P.out;
        pg8::StaticOrder S;
        if (slot == 0) {
            if (mla) {
                pg8::Gemm g{hb, wb + WE_DOWN + (size_t)j * LATP * DM, T, LATP, DM, DM}; S.init(T, LATP, G, c);
                pg8::EpiStore<0, 0> E{(bf16_t*)(ws + OFF_FF + FF_LAT), LATP, ss_mix, 1.0f / DM};
                pg8::gemm_phase(otid(tid), ldsl, g, S, E);
            } else {
                pg8::Gemm g{hb, wb + WE_GIN + (size_t)j * ZP * DM, T, ZP, DM, DM}; S.init(T, ZP, G, c);
                pg8::EpiStore<2, 0> E{(bf16_t*)(ws + OFF_FF), ZP, ss_mix, 1.0f / DM};
                pg8::gemm_phase(otid(tid), ldsl, g, S, E);
            }
        } else if (slot == 1) {
            if (mla) {
                { pg8::Gemm g{(const bf16_t*)(ws + OFF_FF + FF_LAT), wb + WE_UQ + (size_t)j * QP * QLR, T, QP, QLR, LATP}; S.init(T, QP, G, c);
                  pg8::EpiStore<0, 0> E{(bf16_t*)(ws + OFF_FF + FF_Q), QP, nullptr, 0.f};
                  pg8::gemm_phase(otid(tid), ldsl, g, S, E); }
                { pg8::Gemm g{(const bf16_t*)(ws + OFF_FF + FF_LAT) + QLR, wb + WE_UKV + (size_t)j * KVP * KVLR, T, KVP, KVLR, LATP}; S.init(T, KVP, G, c);
                  pg8::EpiStore<0, 0> E{(bf16_t*)(ws + OFF_FF + FF_KV), KVP, nullptr, 0.f};
                  pg8::gemm_phase(otid(tid), ldsl, g, S, E); }
            } else {
#ifndef NO_SGU
                sgu_phase(otid(tid), P, lds, j);
#endif
            }
        } else if (slot == 2) {
            if (mla) {
#ifndef NO_R2
                r2_phase(otid(tid), P, j);
#endif
            } else {
                pg8::Gemm g{(const bf16_t*)(ws + OFF_FF), wb + WE_GOUT + (size_t)j * DM * 2048, T, DM, 2048, ZP}; S.init(T, DM, G, c);
                pg8::EpiRes<0> E{hin, P.out, hb, ss_ffn, nullptr};
                pg8::gemm_phase(otid(tid), ldsl, g, S, E);
            }
        } else if (slot == 3) {
#ifndef NO_ATT
            attn_phase(otid(tid), P, lds);
#endif
        } else if (slot == 4) {
            pg8::Gemm g{(const bf16_t*)(ws + OFF_FF + FF_Q), wb + WE_MOUT + (size_t)j * DM * DM, T, DM, DM, QP}; S.init(T, DM, G, c);
            pg8::EpiRes<0> E{hin, P.out, hb, ss_ffn, nullptr};
            pg8::gemm_phase(otid(tid), ldsl, g, S, E);
        } else if (slot == 5) {
            pg8::Gemm g{hb, wb + WE_UP + (size_t)layer * DFF * DM, T, DFF, DM, DM}; S.init(T, DFF, G, c);
            pg8::EpiStore<1, 0> E{(bf16_t*)(ws + OFF_FF), DFF, ss_ffn, 1.0f / DM};
            pg8::gemm_phase(otid(tid), ldsl, g, S, E);
        } else if (slot == 6) {
            pg8::Gemm g{(const bf16_t*)(ws + OFF_FF), wb + WE_DN + (size_t)layer * DM * DFF, T, DM, DFF, DFF}; S.init(T, DM, G, c);
            pg8::EpiRes<0> E{P.out, P.out, hb, ss_ple, nullptr};
            pg8::gemm_phase(otid(tid), ldsl, g, S, E);
        } else if (slot == 7) {
            pg8::Gemm g{hb, wb + WE_GATE + (size_t)layer * DM * DM, T, DM, DM, DM}; S.init(T, DM, G, c);
            pg8::EpiStore<3, 0> E{(bf16_t*)(ws + OFF_FF), DM, ss_ple, 1.0f / DM};
            pg8::gemm_phase(otid(tid), ldsl, g, S, E);
        } else {
            pg8::Gemm g{(const bf16_t*)(ws + OFF_PB) + (size_t)layer * T * PLE, wb + WE_PROJ + (size_t)layer * DM * PLE, T, DM, PLE, PLE}; S.init(T, DM, G, c);
            pg8::EpiRes<1> E{P.out, P.out, hb, ss_next, (const bf16_t*)(ws + OFF_FF)};
            pg8::gemm_phase(otid(tid), ldsl, g, S, E);
        }
    }
    asm volatile("s_waitcnt vmcnt(0)" ::: "memory");
    __builtin_amdgcn_fence(__ATOMIC_RELEASE, "agent");
    asm volatile("s_waitcnt vmcnt(0)" ::: "memory");
}


#ifdef DBG_CHECK
__global__ void dbg_check(const bf16_t* A, int lda, const bf16_t* Bt, int K, const bf16_t* C, int ldc, int N, const float* ss, int act, float* out) {
    const unsigned s = blockIdx.x * blockDim.x + threadIdx.x;
    const unsigned hsh = s * 2654435761u; const int row = (hsh >> 8) % T; const int col = (s * 40503u + (hsh >> 3)) % N;
    float acc = 0.f;
    for (int k = 0; k < K; ++k) acc += bf2f(A[(size_t)row * lda + k]) * bf2f(Bt[(size_t)col * K + k]);
    if (ss) acc *= rsqrtf(ss[row] * (1.0f / DM) + EPS);
    if (act == 3) acc = 1.0f / (1.0f + expf(-acc));
    if (act == 1) { acc = fmaxf(acc, 0.f); acc *= acc; }
    const float got = bf2f(C[(size_t)row * ldc + col]);
    if (!(fabsf(got - acc) <= 0.03f + 0.03f * fabsf(acc))) atomicAdd(out + 4096, 1.0f);
}
#endif

#ifdef DBG_CHECK
__global__ void dbg_check_ss(const float* h, const float* ss, float* out) {
    const int row = blockIdx.x * blockDim.x + threadIdx.x; if (row >= T) return;
    float a = 0.f; for (int k = 0; k < DM; ++k) { const float v = h[(size_t)row * DM + k]; a += v * v; }
    const float got = ss[row];
    if (!(fabsf(got - a) <= 1e-3f * fabsf(a))) out[(size_t)row * DM] = 1e30f;
}
#endif

#ifdef DBG_CHECK
__global__ void dbg_zero(float* out) { out[4096 + threadIdx.x] = 0.f; out[8192 + threadIdx.x] = 0.f; }
__global__ void dbg_reduce(float* out) {
    float bc = 0.f, br = 0.f; int ic = 0, ir = 0;
    for (int i = 0; i < 256; ++i) { if (out[4096 + i] > bc) { bc = out[4096 + i]; ic = i; } if (out[8192 + i] > br) { br = out[8192 + i]; ir = i; } }
    float v = 1e6f * out[4096];
    for (int i = 0; i < 256; ++i) { out[4096 + i] = 0.f; out[8192 + i] = 0.f; }
    out[0] = v; out[1] = 1e-3f * bc; out[2] = 1e-3f * br;
}
#endif
constexpr int LDS_BYTES = 131072 + 256;
extern "C" void kernel_launch(void* const* d_in, const int* in_sizes, int n_in, void* d_out, int out_size, void* d_ws, size_t ws_size, hipStream_t stream) {
    static int grid = 0;
    if (grid == 0) {
        if (n_in != 26 || out_size != T * DM || ws_size < WS_NEED) { fprintf(stderr, "kernel_launch: unexpected problem (n_in %d out %d ws %zu)\n", n_in, out_size, ws_size); grid = -1; return; }
        int dev = 0, cus = 0, per_cu = 0;
        hipGetDevice(&dev); hipDeviceGetAttribute(&cus, hipDeviceAttributeMultiprocessorCount, dev);
        hipFuncSetAttribute((const void*)fwd_megakernel, hipFuncAttributeMaxDynamicSharedMemorySize, LDS_BYTES);
        hipOccupancyMaxActiveBlocksPerMultiprocessor(&per_cu, (const void*)fwd_megakernel, 512, LDS_BYTES);
        if (per_cu < 1) { fprintf(stderr, "kernel_launch: occupancy query says %d blocks/CU\n", per_cu); per_cu = 1; }
        (void)hipGetLastError();
        grid = cus;
    }
    if (grid < 0) return;
    Params p{};
    for (int i = 0; i < 26; ++i) p.in[i] = (const float*)d_in[i];
    p.out = (float*)d_out; p.ws = (unsigned char*)d_ws;
#if ONE_LAUNCH
    p.ph_lo = 0; p.ph_hi = NPHASE;
    for (int rep = 0; rep < DBG_REPS; ++rep)
    { void* args[] = {&p}; hipError_t e = hipLaunchCooperativeKernel((const void*)fwd_megakernel, dim3(grid), dim3(512), args, LDS_BYTES, stream);
      if (e != hipSuccess) fprintf(stderr, "cooperative launch failed: %s (grid %d)\n", hipGetErrorString(e), grid); }
#else
#ifndef DBG_STOP
#define DBG_STOP (NPHASE - 1)
#endif
    for (int ph = 0; ph <= DBG_STOP; ++ph) {
        if (!phase_nonempty(ph)) continue;
        p.ph_lo = ph; p.ph_hi = ph + 1;
#ifdef DBG_NANFILL
        if (ph == DBG_NANFILL) (void)hipMemsetAsync((char*)d_ws + OFF_FF, 0xFF, 64 * MiB, stream);
#endif
        void* args[] = {&p}; hipError_t e = hipLaunchCooperativeKernel((const void*)fwd_megakernel, dim3(grid), dim3(512), args, LDS_BYTES, stream);
        if (e != hipSuccess) { fprintf(stderr, "cooperative launch failed: %s (grid %d, phase %d)\n", hipGetErrorString(e), grid, ph); break; }
    }
#ifdef DBG_CHECK
    { unsigned char* ws = (unsigned char*)d_ws; bf16_t* wb = (bf16_t*)(ws + OFF_W);
      dbg_zero<<<1, 256, 0, stream>>>((float*)d_out); DBG_CHECK; dbg_reduce<<<1, 1, 0, stream>>>((float*)d_out); }
#endif
#endif
}
```

```cpp
#include <hip/hip_runtime.h>
#include <hip/hip_cooperative_groups.h>
#include <cstdio>
#include <cstdint>
namespace cg = cooperative_groups;

#ifndef DBG_NOGATE
#define DBG_NOGATE 0
#endif
#ifndef DBG_GATE_NOSS
#define DBG_GATE_NOSS 0
#endif
#ifndef DBG_REPS
#define DBG_REPS 1
#endif
#ifndef ONE_LAUNCH
#define ONE_LAUNCH 1
#endif

#define LAS __attribute__((address_space(3)))
typedef unsigned short bf16_t;
typedef short bf16x8 __attribute__((ext_vector_type(8)));
typedef short s16x4 __attribute__((ext_vector_type(4)));
typedef float f32x4 __attribute__((ext_vector_type(4)));
typedef float f32x2 __attribute__((ext_vector_type(2)));
typedef float f32x16 __attribute__((ext_vector_type(16)));
typedef unsigned u32x4 __attribute__((ext_vector_type(4)));
typedef unsigned u32x2 __attribute__((ext_vector_type(2)));

constexpr int T = 32768, DM = 1024, SEQ = 2048, NB = 16, DFF = 4096, PLE = 256, DEPTH = 4;
constexpr int NH = 8, QLR = 384, KVLR = 256, ROPE = 64, LATP = 768;
constexpr int QP = 1536, KVP = 2048, ZP = 4096;
constexpr float EPS = 1e-6f;
constexpr float QSCALE = 0.07216878364870322f * 1.4426950408889634f;

constexpr size_t MiB = 1u << 20;
constexpr size_t OFF_SS = 0;
constexpr size_t OFF_W = 2621440;
constexpr size_t OFF_HB = 112 * MiB;
constexpr size_t OFF_FF = 176 * MiB;
constexpr size_t OFF_PB = 448 * MiB;
constexpr size_t WS_NEED = 512 * MiB;
constexpr size_t OFF_BAR = 2 * MiB;
#define XCD_BAR_WORDS 3456
constexpr size_t WE_DOWN = 0, WE_UQ = WE_DOWN + 2ull * LATP * DM, WE_UKV = WE_UQ + 2ull * QP * QLR, WE_MOUT = WE_UKV + 2ull * KVP * KVLR,
                 WE_GIN = WE_MOUT + 2ull * DM * DM, WE_GOUT = WE_GIN + 2ull * ZP * DM, WE_UP = WE_GOUT + 2ull * DM * 2048,
                 WE_DN = WE_UP + 4ull * DFF * DM, WE_GATE = WE_DN + 4ull * DM * DFF, WE_PROJ = WE_GATE + 4ull * DM * DM, WE_END = WE_PROJ + 4ull * DM * PLE;
static_assert(OFF_W + WE_END * 2 <= OFF_HB, "weights fit");
constexpr size_t FF_Q = 0, FF_KV = 96 * MiB, FF_LAT = 224 * MiB;

struct Params { const float* in[26]; float* out; unsigned char* ws; int ph_lo, ph_hi; };

typedef __bf16 bf16x2_t __attribute__((ext_vector_type(2)));
__device__ __forceinline__ unsigned cvt_pk_bf16(float lo, float hi) { const f32x2 v = {lo, hi}; return __builtin_bit_cast(unsigned, __builtin_convertvector(v, bf16x2_t)); }
__device__ __forceinline__ float bf2f(unsigned short b) { return __uint_as_float((unsigned)b << 16); }
__device__ __forceinline__ float bflo(unsigned u) { return __uint_as_float(u << 16); }
__device__ __forceinline__ float bfhi(unsigned u) { return __uint_as_float(u & 0xffff0000u); }
__device__ __forceinline__ float fast_rcp(float x) { return __builtin_amdgcn_rcpf(x); }
__device__ __forceinline__ float fast_exp2(float x) { return __builtin_amdgcn_exp2f(x); }
__device__ __forceinline__ float gelu_tanh(float x) { const float y = x + 0.044715f * x * x * x; return x * fast_rcp(1.0f + fast_exp2(-2.3022082f * y)); }
__device__ __forceinline__ float sigmoidf_(float x) { return fast_rcp(1.0f + fast_exp2(-1.4426950409f * x)); }

namespace pg8 {
constexpr int BM = 256, BK = 64, HALF = 128, HTB = HALF * BK * 2, STAGE_BYTES = 8 * HTB, NXCD = 8, WGM = 8;
__host__ __device__ __forceinline__ int lds_byte(int r, int c) { const int st = (r >> 4) * 2 + (c >> 5), rr = r & 15, cc = c & 31, ob = rr * 64 + cc * 2; return st * 1024 + (ob ^ (((ob >> 9) & 1) << 5)); }
__host__ __device__ __forceinline__ void stage_rc(int b, int& R, int& C) { const int st = b / 1024, sb = b % 1024, swz = sb ^ (((sb >> 9) & 1) << 5); R = (st >> 1) * 16 + swz / 64; C = (st & 1) * 32 + (swz % 64) / 2; }
__host__ __device__ __forceinline__ int perm32(int rho) { const int n = rho >> 4, i = rho & 15; return 8 * (i >> 2) + 4 * n + (i & 3); }
struct Unit { int pm, pn; };
struct Gemm { const bf16_t* A; const bf16_t* Bt; int M, N, K, lda; };
struct StaticOrder {
    int nM, nN, nwg, G, c;
    __device__ void init(int M, int N, int G_, int c_) { nM = M / BM; nN = N / BM; nwg = nM * nN; G = G_; c = c_; }
    __device__ bool next(int i, Unit& u) const {
        const long L = (long)i * G + c; if (L >= nwg) return false;
        int wgid = (int)L; { const int q = nwg / NXCD, r = nwg % NXCD, xcd = wgid % NXCD, off = wgid / NXCD; wgid = (xcd < r ? xcd * (q + 1) : r * (q + 1) + (xcd - r) * q) + off; }
        const int nig = WGM * nN, gid = wgid / nig, fm = gid * WGM, gsz = (nM - fm) < WGM ? (nM - fm) : WGM;
        u.pm = fm + ((wgid % nig) % gsz); u.pn = (wgid % nig) / gsz; return true;
    }
};

template <int ACT, int STATS> struct EpiStore {
    static constexpr bool PERM = true;
    bf16_t* O; int ldc; const float* ss; float inv_n;
    __device__ __forceinline__ void operator()(const f32x4 (&acc)[2][2][4][2], const Unit& u, int wr, int wc, int fr, int fq) const {
        const int row0 = u.pm * BM + wr * 64 + fr, col0 = u.pn * BM + wc * 32 + 8 * fq;
#pragma unroll
        for (int ai = 0; ai < 2; ++ai)
#pragma unroll
            for (int m = 0; m < 4; ++m) {
                const int row = row0 + ai * HALF + m * 16;
                float rs = 1.0f;
                if (ss) { const f32x4* sp = (const f32x4*)(ss + (size_t)row * 16); const f32x4 a = sp[0], b = sp[1], c = sp[2], d = sp[3];
                    const float t = (((a[0] + a[1]) + (a[2] + a[3])) + ((b[0] + b[1]) + (b[2] + b[3]))) + (((c[0] + c[1]) + (c[2] + c[3])) + ((d[0] + d[1]) + (d[2] + d[3])));
                    rs = rsqrtf(t * inv_n + EPS); }
#pragma unroll
                for (int bj = 0; bj < 2; ++bj) {
                    f32x4 v0 = acc[ai][bj][m][0] * rs, v1 = acc[ai][bj][m][1] * rs;
                    if (ACT == 1) {
#pragma unroll
                        for (int e = 0; e < 4; ++e) { const float a = fmaxf(v0[e], 0.f), b = fmaxf(v1[e], 0.f); v0[e] = a * a; v1[e] = b * b; }
                    }
                    if (ACT == 2) {
#pragma unroll
                        for (int e = 0; e < 4; ++e) { v0[e] = gelu_tanh(v0[e]); v1[e] = gelu_tanh(v1[e]); }
                    }
                    if (ACT == 3) {
#pragma unroll
                        for (int e = 0; e < 4; ++e) { v0[e] = sigmoidf_(v0[e]); v1[e] = sigmoidf_(v1[e]); }
                    }
                    u32x4 w; w.x = cvt_pk_bf16(v0[0], v0[1]); w.y = cvt_pk_bf16(v0[2], v0[3]); w.z = cvt_pk_bf16(v1[0], v1[1]); w.w = cvt_pk_bf16(v1[2], v1[3]);
                    *(u32x4*)(O + (size_t)row * ldc + col0 + bj * HALF) = w;
                }
                asm volatile("" ::: "memory");
            }
    }
};
template <int MODE> struct EpiRes {
    static constexpr bool PERM = true;
    static constexpr int MB = (MODE == 1) ? 2 : 4;
    const float* hin32; float* hout32; bf16_t* hb; float* ssn; const bf16_t* pp;
    __device__ __forceinline__ void operator()(const f32x4 (&acc)[2][2][4][2], const Unit& u, int wr, int wc, int fr, int fq) const {
        const int row0 = u.pm * BM + wr * 64 + fr, col0 = u.pn * BM + wc * 32 + 8 * fq;
#pragma unroll
        for (int ai = 0; ai < 2; ++ai)
#pragma unroll
            for (int mg = 0; mg < 4; mg += MB) {
                f32x4 hv[MB][2][2]; u32x4 pw[MB][2];
#pragma unroll
                for (int mm = 0; mm < MB; ++mm)
#pragma unroll
                    for (int bj = 0; bj < 2; ++bj) {
                        const size_t off = (size_t)(row0 + ai * HALF + (mg + mm) * 16) * DM + col0 + bj * HALF;
                        if (hin32) { hv[mm][bj][0] = *(const f32x4*)(hin32 + off); hv[mm][bj][1] = *(const f32x4*)(hin32 + off + 4); }
                        else { const u32x4 b = *(const u32x4*)(hb + off); hv[mm][bj][0] = (f32x4){bflo(b.x), bfhi(b.x), bflo(b.y), bfhi(b.y)}; hv[mm][bj][1] = (f32x4){bflo(b.z), bfhi(b.z), bflo(b.w), bfhi(b.w)}; }
                        if (MODE == 1) pw[mm][bj] = *(const u32x4*)(pp + off);
                    }
#pragma unroll
                for (int mm = 0; mm < MB; ++mm) {
                    const int m = mg + mm, row = row0 + ai * HALF + m * 16;
                    float q = 0.f;
#pragma unroll
                    for (int bj = 0; bj < 2; ++bj) {
                        const size_t off = (size_t)row * DM + col0 + bj * HALF;
                        f32x4 v0 = acc[ai][bj][m][0], v1 = acc[ai][bj][m][1];
                        if (MODE == 1) {
                            const u32x4 g = pw[mm][bj];
                            v0[0] *= bflo(g.x); v0[1] *= bfhi(g.x); v0[2] *= bflo(g.y); v0[3] *= bfhi(g.y);
                            v1[0] *= bflo(g.z); v1[1] *= bfhi(g.z); v1[2] *= bflo(g.w); v1[3] *= bfhi(g.w);
                        }
                        v0 += hv[mm][bj][0]; v1 += hv[mm][bj][1];
                        if (hout32) { *(f32x4*)(hout32 + off) = v0; *(f32x4*)(hout32 + off + 4) = v1; }
                        else { u32x4 w; w.x = cvt_pk_bf16(v0[0], v0[1]); w.y = cvt_pk_bf16(v0[2], v0[3]); w.z = cvt_pk_bf16(v1[0], v1[1]); w.w = cvt_pk_bf16(v1[2], v1[3]);
                               *(u32x4*)(hb + off) = w; }
                        q += (v0[0] * v0[0] + v0[1] * v0[1]) + (v0[2] * v0[2] + v0[3] * v0[3]) + (v1[0] * v1[0] + v1[1] * v1[1]) + (v1[2] * v1[2] + v1[3] * v1[3]);
                    }
                    if (ssn) { q += __shfl_xor(q, 16); q += __shfl_xor(q, 32); if (fq == 0) ssn[(size_t)row * 16 + u.pn * 4 + wc] = q; }
                }
                asm volatile("" ::: "memory");
            }
    }
};

#ifndef PG8_SP2
#define PG8_SP2 true
#endif
#ifndef PG8_ALIGN
#define PG8_ALIGN true
#endif
template <class Epi, bool ALIGN_EPI = PG8_ALIGN, bool SP2 = PG8_SP2>
__device__ __forceinline__ void gemm_phase(int tid, LAS unsigned char* lds, const Gemm g, const StaticOrder& S, const Epi& E) {
    const int wid = __builtin_amdgcn_readfirstlane(tid >> 6), lane = tid & 63, wr = wid >> 2, wc = wid & 3, fr = lane & 15, fq = lane >> 4;
    const int K = g.K, nt = K / BK, lda = g.lda;
    unsigned voffA[2], voffB[2];
#pragma unroll
    for (int i = 0; i < 2; ++i) { int R, C; stage_rc(tid * 16 + i * 8192, R, C); const int Rb = Epi::PERM ? ((R & ~31) + perm32(R & 31)) : R;
        voffA[i] = (unsigned)(R * lda + C) * 2u; voffB[i] = (unsigned)(Rb * K + C) * 2u; }
    const size_t kstep = (size_t)(BK * 2);
    const size_t hstepA = (size_t)HALF * lda * 2, hstepB = (size_t)HALF * K * 2;
    const size_t tstepA = 2 * hstepA, tstepB = 2 * hstepB;
    const unsigned ldsw = (unsigned)wid * 1024u;
    const int aoff = lds_byte(wr * 64 + fr, fq * 8), boff = lds_byte(wc * 32 + fr, fq * 8);
#define PG8_SA(b, h) (((b) * 2 + (h)) * HTB)
#define PG8_SB(b, h) ((4 + (b) * 2 + (h)) * HTB)
#define PG8_STAGE(bufoff, gbase, voff) do { _Pragma("unroll") for (int _i = 0; _i < 2; ++_i) \
        __builtin_amdgcn_global_load_lds((const unsigned*)((const char*)(gbase) + (voff)[_i]), (LAS unsigned*)(lds + (bufoff) + ldsw + _i * 8192), 16, 0, 0); } while (0)
#define PG8_LDA(dst, b, h) do { _Pragma("unroll") for (int m = 0; m < 4; ++m) _Pragma("unroll") for (int k = 0; k < 2; ++k) dst[m][k] = *(const LAS bf16x8*)(lds + PG8_SA(b, h) + aoff + m * 2048 + k * 1024); } while (0)
#define PG8_LDB(dst, b, h) do { _Pragma("unroll") for (int n = 0; n < 2; ++n) _Pragma("unroll") for (int k = 0; k < 2; ++k) dst[n][k] = *(const LAS bf16x8*)(lds + PG8_SB(b, h) + boff + n * 2048 + k * 1024); } while (0)
#define PG8_MMA(ai, bj, At, Bt) do { __builtin_amdgcn_s_setprio(1); _Pragma("unroll") for (int m = 0; m < 4; ++m) _Pragma("unroll") for (int n = 0; n < 2; ++n) _Pragma("unroll") for (int k = 0; k < 2; ++k) \
        acc[ai][bj][m][n] = __builtin_amdgcn_mfma_f32_16x16x32_bf16(Bt[n][k], At[m][k], acc[ai][bj][m][n], 0, 0, 0); __builtin_amdgcn_s_setprio(0); } while (0)
#define PG8_WAIT_V(n) asm volatile("s_waitcnt vmcnt(" #n ")" ::: "memory")
#define PG8_WAIT_L(n) asm volatile("s_waitcnt lgkmcnt(" #n ")" ::: "memory")
#define PG8_BAR __builtin_amdgcn_s_barrier()
#define PG8_SCHED __builtin_amdgcn_sched_barrier(0)
    Unit cur, nxt; int ui = 0;
    if (!S.next(0, cur)) return;
    f32x4 acc[2][2][4][2];
#pragma unroll
    for (int a = 0; a < 2; ++a)
#pragma unroll
        for (int b = 0; b < 2; ++b)
#pragma unroll
            for (int m = 0; m < 4; ++m)
#pragma unroll
                for (int n = 0; n < 2; ++n) acc[a][b][m][n] = (f32x4){0.f, 0.f, 0.f, 0.f};
    bf16x8 At[4][2], B0[2][2], B1[2][2];
    const char* cA = (const char*)g.A + (size_t)cur.pm * tstepA; const char* cB = (const char*)g.Bt + (size_t)cur.pn * tstepB;
    if constexpr (SP2) {
    PG8_STAGE(PG8_SB(0, 0), cB, voffB); PG8_STAGE(PG8_SB(0, 1), cB + hstepB, voffB); PG8_STAGE(PG8_SA(0, 0), cA, voffA); PG8_STAGE(PG8_SA(0, 1), cA + hstepA, voffA);
    if (wr == 1) PG8_BAR;
    PG8_WAIT_V(2); PG8_BAR;
    PG8_STAGE(PG8_SB(1, 0), cB + kstep, voffB); PG8_STAGE(PG8_SA(1, 0), cA + kstep, voffA); PG8_STAGE(PG8_SB(1, 1), cB + hstepB + kstep, voffB);
    PG8_WAIT_V(6); PG8_BAR;
    } else {
    PG8_STAGE(PG8_SB(0, 0), cB, voffB); PG8_STAGE(PG8_SA(0, 0), cA, voffA); PG8_STAGE(PG8_SB(0, 1), cB + hstepB, voffB); PG8_STAGE(PG8_SA(0, 1), cA + hstepA, voffA);
    if (wr == 1) PG8_BAR;
    PG8_WAIT_V(4); PG8_BAR;
    PG8_STAGE(PG8_SB(1, 0), cB + kstep, voffB); PG8_STAGE(PG8_SA(1, 0), cA + kstep, voffA); PG8_STAGE(PG8_SB(1, 1), cB + hstepB + kstep, voffB);
    PG8_WAIT_V(6); PG8_BAR;
    }
    for (;;) {
        const bool has_next = S.next(ui + 1, nxt);
        const char* nA = has_next ? (const char*)g.A + (size_t)nxt.pm * tstepA : cA; const char* nB = has_next ? (const char*)g.Bt + (size_t)nxt.pn * tstepB : cB;
        for (int t = 0; t < nt; t += 2) {
            const bool last = (t == nt - 2);
            const char* a1 = cA + (size_t)(t + 1) * kstep;
            const char* a2 = last ? nA : cA + (size_t)(t + 2) * kstep; const char* b2 = last ? nB : cB + (size_t)(t + 2) * kstep;
            const char* a3 = a2 + kstep; const char* b3 = b2 + kstep;
            if constexpr (SP2) {
            PG8_LDB(B0, 0, 0); PG8_LDB(B1, 0, 1); PG8_SCHED; PG8_LDA(At, 0, 0); PG8_STAGE(PG8_SA(1, 1), a1 + hstepA, voffA);
            PG8_WAIT_V(8); PG8_WAIT_L(0); PG8_BAR; PG8_MMA(0, 0, At, B0); PG8_MMA(0, 1, At, B1); PG8_BAR; PG8_SCHED;
            PG8_LDA(At, 0, 1); PG8_STAGE(PG8_SB(0, 0), b2, voffB); PG8_STAGE(PG8_SB(0, 1), b2 + hstepB, voffB); PG8_STAGE(PG8_SA(0, 0), a2, voffA);
            PG8_WAIT_V(8); PG8_WAIT_L(0); PG8_BAR; PG8_MMA(1, 0, At, B0); PG8_MMA(1, 1, At, B1); PG8_BAR; PG8_SCHED;
            PG8_LDB(B0, 1, 0); PG8_LDB(B1, 1, 1); PG8_SCHED; PG8_LDA(At, 1, 0); PG8_STAGE(PG8_SA(0, 1), a2 + hstepA, voffA);
            PG8_WAIT_V(8); PG8_WAIT_L(0); PG8_BAR; PG8_MMA(0, 0, At, B0); PG8_MMA(0, 1, At, B1); PG8_BAR; PG8_SCHED;
            PG8_LDA(At, 1, 1); PG8_STAGE(PG8_SB(1, 0), b3, voffB); PG8_STAGE(PG8_SB(1, 1), b3 + hstepB, voffB); PG8_STAGE(PG8_SA(1, 0), a3, voffA);
            PG8_WAIT_V(8); PG8_WAIT_L(0); PG8_BAR; PG8_MMA(1, 0, At, B0); PG8_MMA(1, 1, At, B1); PG8_BAR; PG8_SCHED;
            } else {
            PG8_LDB(B0, 0, 0); PG8_SCHED; PG8_LDA(At, 0, 0); PG8_STAGE(PG8_SA(1, 1), a1 + hstepA, voffA);
            PG8_WAIT_L(8); PG8_BAR; PG8_WAIT_L(0); PG8_MMA(0, 0, At, B0); PG8_BAR; PG8_SCHED;
            PG8_LDB(B1, 0, 1); PG8_STAGE(PG8_SB(0, 0), b2, voffB);
            PG8_BAR; PG8_WAIT_L(0); PG8_MMA(0, 1, At, B1); PG8_BAR;
            PG8_LDA(At, 0, 1); PG8_STAGE(PG8_SA(0, 0), a2, voffA);
            PG8_BAR; PG8_WAIT_L(0); PG8_MMA(1, 0, At, B0); PG8_BAR; PG8_SCHED;
            PG8_STAGE(PG8_SB(0, 1), b2 + hstepB, voffB);
            PG8_WAIT_V(6); PG8_BAR; PG8_MMA(1, 1, At, B1); PG8_BAR;
            PG8_LDB(B0, 1, 0); PG8_SCHED; PG8_LDA(At, 1, 0); PG8_STAGE(PG8_SA(0, 1), a2 + hstepA, voffA);
            PG8_WAIT_L(8); PG8_BAR; PG8_WAIT_L(0); PG8_MMA(0, 0, At, B0); PG8_BAR; PG8_SCHED;
            PG8_LDB(B1, 1, 1); PG8_STAGE(PG8_SB(1, 0), b3, voffB);
            PG8_BAR; PG8_WAIT_L(0); PG8_MMA(0, 1, At, B1); PG8_BAR;
            PG8_LDA(At, 1, 1); PG8_STAGE(PG8_SA(1, 0), a3, voffA);
            PG8_BAR; PG8_WAIT_L(0); PG8_MMA(1, 0, At, B0); PG8_BAR; PG8_SCHED;
            PG8_STAGE(PG8_SB(1, 1), b3 + hstepB, voffB);
            PG8_WAIT_V(6); PG8_BAR; PG8_MMA(1, 1, At, B1); PG8_BAR;
            }
        }
        if constexpr (ALIGN_EPI) { if (wr == 0) PG8_BAR; }
        E(acc, cur, wr, wc, fr, fq);
        if (!has_next) break;
#pragma unroll
        for (int a = 0; a < 2; ++a)
#pragma unroll
            for (int b = 0; b < 2; ++b)
#pragma unroll
                for (int m = 0; m < 4; ++m)
#pragma unroll
                    for (int n = 0; n < 2; ++n) acc[a][b][m][n] = (f32x4){0.f, 0.f, 0.f, 0.f};
        cur = nxt; cA = nA; cB = nB; ++ui;
        if constexpr (ALIGN_EPI) { if (wr == 1) PG8_BAR; }
    }
    PG8_WAIT_V(0);
    if constexpr (!ALIGN_EPI) { if (wr == 0) PG8_BAR; }
    PG8_BAR;
#undef PG8_SA
#undef PG8_SB
#undef PG8_STAGE
#undef PG8_LDA
#undef PG8_LDB
#undef PG8_MMA
#undef PG8_WAIT_V
#undef PG8_WAIT_L
#undef PG8_BAR
#undef PG8_SCHED
}
}

__constant__ double kInvFreq[32] = {
    1.0, 0.7498942093324559, 0.5623413251903491, 0.4216965034285822, 0.31622776601683794, 0.23713737056616552, 0.1778279410038923, 0.1333521432163324,
    0.1, 0.07498942093324558, 0.05623413251903491, 0.04216965034285822, 0.03162277660168379, 0.023713737056616554, 0.01778279410038923, 0.01333521432163324,
    0.01, 0.007498942093324558, 0.005623413251903491, 0.004216965034285823, 0.0031622776601683794, 0.0023713737056616554, 0.001778279410038923, 0.001333521432163324,
    0.001, 0.0007498942093324559, 0.0005623413251903491, 0.0004216965034285823, 0.00031622776601683794, 0.00023713737056616554, 0.0001778279410038923, 0.0001333521432163324};

__device__ __forceinline__ float wave_sum(float v) {
#pragma unroll
    for (int o = 1; o < 64; o <<= 1) v += __shfl_xor(v, o);
    return v;
}
__device__ __forceinline__ void unpack8(const u32x4 w, float (&f)[8]) { f[0] = bflo(w.x); f[1] = bfhi(w.x); f[2] = bflo(w.y); f[3] = bfhi(w.y); f[4] = bflo(w.z); f[5] = bfhi(w.z); f[6] = bflo(w.w); f[7] = bfhi(w.w); }
__device__ __forceinline__ u32x4 pack8(const float (&f)[8]) { u32x4 w; w.x = cvt_pk_bf16(f[0], f[1]); w.y = cvt_pk_bf16(f[2], f[3]); w.z = cvt_pk_bf16(f[4], f[5]); w.w = cvt_pk_bf16(f[6], f[7]); return w; }

struct WDesc { const float* W; const float* gamma; bf16_t* dst; int K, N, Npad, mode, items; };
__device__ __forceinline__ WDesc wdesc(const Params& P, int id) {
    WDesc d; bf16_t* wb = (bf16_t*)(P.ws + OFF_W); d.gamma = nullptr; d.mode = 0;
    if (id < 12) {
        const int j = id & 1, f = id >> 1;
        switch (f) {
            case 0: d.W = P.in[6] + (size_t)j * DM * 704; d.K = DM; d.N = 704; d.Npad = LATP; d.dst = wb + WE_DOWN + (size_t)j * LATP * DM; d.gamma = P.in[3] + (2 * j) * DM; break;
            case 1: d.W = P.in[9] + (size_t)j * QLR * QP; d.K = QLR; d.N = QP; d.Npad = QP; d.dst = wb + WE_UQ + (size_t)j * QP * QLR; d.gamma = P.in[7] + j * QLR; d.mode = 1; break;
            case 2: d.W = P.in[10] + (size_t)j * KVLR * KVP; d.K = KVLR; d.N = KVP; d.Npad = KVP; d.dst = wb + WE_UKV + (size_t)j * KVP * KVLR; d.gamma = P.in[8] + j * KVLR; break;
            case 3: d.W = P.in[15] + (size_t)j * DM * DM; d.K = DM; d.N = DM; d.Npad = DM; d.dst = wb + WE_MOUT + (size_t)j * DM * DM; break;
            case 4: d.W = P.in[16] + (size_t)j * DM * ZP; d.K = DM; d.N = ZP; d.Npad = ZP; d.dst = wb + WE_GIN + (size_t)j * ZP * DM; d.gamma = P.in[3] + (2 * j + 1) * DM; break;
            default: d.W = P.in[21] + (size_t)j * 2048 * DM; d.K = 2048; d.N = DM; d.Npad = DM; d.dst = wb + WE_GOUT + (size_t)j * DM * 2048; break;
        }
    } else {
        const int i = (id - 12) & 3, f = (id - 12) >> 2;
        switch (f) {
            case 0: d.W = P.in[22] + (size_t)i * DM * DFF; d.K = DM; d.N = DFF; d.Npad = DFF; d.dst = wb + WE_UP + (size_t)i * DFF * DM; d.gamma = P.in[4] + i * DM; break;
            case 1: d.W = P.in[23] + (size_t)i * DFF * DM; d.K = DFF; d.N = DM; d.Npad = DM; d.dst = wb + WE_DN + (size_t)i * DM * DFF; break;
            case 2: d.W = P.in[24] + (size_t)i * DM * DM; d.K = DM; d.N = DM; d.Npad = DM; d.dst = wb + WE_GATE + (size_t)i * DM * DM; d.gamma = P.in[5] + i * DM; break;
            default: d.W = P.in[25] + (size_t)i * PLE * DM; d.K = PLE; d.N = DM; d.Npad = DM; d.dst = wb + WE_PROJ + (size_t)i * DM * PLE; break;
        }
    }
    d.items = (d.K / 64) * (d.Npad / 32);
    return d;
}
__device__ __forceinline__ void conv_item(const WDesc& d, int item, float* scr, int lane) {
    const int nblk = d.Npad / 32, kb = item / nblk, nb = item % nblk, k0 = 64 * kb, n0 = 32 * nb;
    int sn0 = n0;
    if (d.mode == 1) { if (n0 < 1024) sn0 = (n0 >> 7) * 192 + (n0 & 127); else { const int r = n0 - 1024; sn0 = (r >> 6) * 192 + 128 + (r & 63); } }
    const bool valid = sn0 < d.N;
#pragma unroll
    for (int i = 0; i < 32; ++i) { const int kk = 2 * i + (lane >> 5);
        float v = valid ? d.W[(size_t)(k0 + kk) * d.N + sn0 + (lane & 31)] : 0.f;
        if (d.gamma) v *= d.gamma[k0 + kk];
        scr[kk * 33 + (lane & 31)] = v; }
    asm volatile("s_waitcnt lgkmcnt(0)" ::: "memory");
    const int c = lane & 7;
#pragma unroll
    for (int j = 0; j < 4; ++j) { const int n = (lane >> 3) + 8 * j; const float* s = scr + (8 * c) * 33 + n;
        u32x4 o; o.x = cvt_pk_bf16(s[0 * 33], s[1 * 33]); o.y = cvt_pk_bf16(s[2 * 33], s[3 * 33]); o.z = cvt_pk_bf16(s[4 * 33], s[5 * 33]); o.w = cvt_pk_bf16(s[6 * 33], s[7 * 33]);
        *(u32x4*)(d.dst + (size_t)(n0 + n) * d.K + k0 + 8 * c) = o; }
    asm volatile("s_waitcnt lgkmcnt(0)" ::: "memory");
}
__device__ __forceinline__ void p0_prologue(int tid, const Params& P, unsigned char* lds) {
    const int lane = tid & 63, wave = __builtin_amdgcn_readfirstlane(tid >> 6);
    const int gw = blockIdx.x * 8 + wave, NGW = gridDim.x * 8;
    const size_t gt = (size_t)blockIdx.x * 512 + tid, NGT = (size_t)gridDim.x * 512;
    float* scr = (float*)(lds + wave * 8704);
    int total = 0;
    for (int id = 0; id < 28; ++id) total += wdesc(P, id).items;
    for (int it = gw; it < total; it += NGW) {
        int r = it, id = 0; WDesc d = wdesc(P, 0);
        while (r >= d.items) { r -= d.items; ++id; d = wdesc(P, id); }
        conv_item(d, r, scr, lane);
    }
    { unsigned* bw = (unsigned*)(P.ws + OFF_BAR); for (size_t i = gt; i < XCD_BAR_WORDS; i += NGT) bw[i] = 0u; }
    { const f32x4* src = (const f32x4*)P.in[1]; u32x4* dst = (u32x4*)(P.ws + OFF_PB); const size_t n8 = (size_t)DEPTH * T * PLE / 8;
      for (size_t i0 = gt; i0 < n8; i0 += 4 * NGT) {
          f32x4 a[4], b[4];
#pragma unroll
          for (int u = 0; u < 4; ++u) { const size_t i = i0 + u * NGT; if (i < n8) { a[u] = src[2 * i]; b[u] = src[2 * i + 1]; } }
#pragma unroll
          for (int u = 0; u < 4; ++u) { const size_t i = i0 + u * NGT; if (i < n8) { u32x4 w; w.x = cvt_pk_bf16(a[u][0], a[u][1]); w.y = cvt_pk_bf16(a[u][2], a[u][3]); w.z = cvt_pk_bf16(b[u][0], b[u][1]); w.w = cvt_pk_bf16(b[u][2], b[u][3]); dst[i] = w; } } } }
    { float* ssp = (float*)(P.ws + OFF_SS); bf16_t* hb = (bf16_t*)(P.ws + OFF_HB);
#pragma unroll 2
      for (int row = gw; row < T; row += NGW) {
          const f32x4* xr = (const f32x4*)(P.in[0] + (size_t)row * DM) + lane; float s = 0.f;
          unsigned long long* o8 = (unsigned long long*)(hb + (size_t)row * DM) + lane;
#pragma unroll
          for (int j = 0; j < 4; ++j) { const f32x4 v = xr[64 * j]; s += (v[0] * v[0] + v[1] * v[1]) + (v[2] * v[2] + v[3] * v[3]);
              o8[64 * j] = (unsigned long long)cvt_pk_bf16(v[0], v[1]) | ((unsigned long long)cvt_pk_bf16(v[2], v[3]) << 32); }
          s = wave_sum(s); if (lane < 16) ssp[(size_t)row * 16 + lane] = (lane == 0) ? s : 0.f; } }
}

__device__ __forceinline__ void r2_phase(int tid, const Params& P, int j) {
    const int lane = tid & 63, wave = __builtin_amdgcn_readfirstlane(tid >> 6);
    const int gw = blockIdx.x * 8 + wave, NGW = gridDim.x * 8;
    bf16_t* Q = (bf16_t*)(P.ws + OFF_FF + FF_Q); bf16_t* KV = (bf16_t*)(P.ws + OFF_FF + FF_KV); bf16_t* LAT = (bf16_t*)(P.ws + OFF_FF + FF_LAT);
    const float* gqn = P.in[11] + j * 128; const float* gqr = P.in[12] + j * 64; const float* gkn = P.in[13] + j * 128; const float* gkr = P.in[14] + j * 64;
    const int* pos = (const int*)P.in[2];
    float g_qn[2][8], g_kn[2][8], g_qr[8], g_kr[8];
#pragma unroll
    for (int i = 0; i < 2; ++i)
#pragma unroll
        for (int e = 0; e < 8; ++e) { const int d = (8 * lane + 512 * i + e) & 127; g_qn[i][e] = gqn[d] * QSCALE; g_kn[i][e] = gkn[d]; }
#pragma unroll
    for (int e = 0; e < 8; ++e) { const int r = 8 * (lane & 7) + e; g_qr[e] = gqr[r] * QSCALE; g_kr[e] = gkr[r]; }
    const double invf = kInvFreq[lane & 31];
    for (int row = gw; row < T; row += NGW) {
        float rq, rkv;
        { u32x4 z4 = {0u, 0u, 0u, 0u};
          const u32x4 lq = (lane < 48) ? *(const u32x4*)(LAT + (size_t)row * LATP + 8 * lane) : z4;
          const u32x4 lk = (lane < 32) ? *(const u32x4*)(LAT + (size_t)row * LATP + QLR + 8 * lane) : z4;
          float a[8], b[8]; unpack8(lq, a); unpack8(lk, b); float sa = 0.f, sb = 0.f;
#pragma unroll
          for (int e = 0; e < 8; ++e) { sa += a[e] * a[e]; sb += b[e] * b[e]; }
          rq = rsqrtf(wave_sum(sa) * (1.0f / QLR) + EPS); rkv = rsqrtf(wave_sum(sb) * (1.0f / KVLR) + EPS); }
        const double ang = (double)pos[row] * invf; double rev = ang * 0.15915494309189535; rev -= floor(rev);
        const float cs = __builtin_amdgcn_cosf((float)rev), sn = __builtin_amdgcn_sinf((float)rev);
        float cj[8], sj[8];
#pragma unroll
        for (int e = 0; e < 8; ++e) { cj[e] = __shfl(cs, 8 * (lane & 3) + e); sj[e] = __shfl(sn, 8 * (lane & 3) + e); }
#pragma unroll
        for (int i = 0; i < 2; ++i) {
            const int idx = 8 * lane + 512 * i, head = idx >> 7, d = idx & 127;
            u32x4* qp = (u32x4*)(Q + (size_t)row * QP + idx); u32x4* kp = (u32x4*)(KV + (size_t)row * KVP + head * 256 + d);
            float a[8], b[8]; unpack8(*qp, a); unpack8(*kp, b);
            { u32x4* vp = (u32x4*)(KV + (size_t)row * KVP + head * 256 + 128 + d); float vv[8]; unpack8(*vp, vv);
#pragma unroll
              for (int e = 0; e < 8; ++e) vv[e] *= rkv;
              *vp = pack8(vv); }
            float sa = 0.f, sb = 0.f;
#pragma unroll
            for (int e = 0; e < 8; ++e) { a[e] *= rq; b[e] *= rkv; sa += a[e] * a[e]; sb += b[e] * b[e]; }
#pragma unroll
            for (int o = 1; o < 16; o <<= 1) { sa += __shfl_xor(sa, o); sb += __shfl_xor(sb, o); }
            const float ra = rsqrtf(sa * (1.0f / 128) + EPS), rb = rsqrtf(sb * (1.0f / 128) + EPS);
#pragma unroll
            for (int e = 0; e < 8; ++e) { a[e] = a[e] * ra * g_qn[i][e]; b[e] = b[e] * rb * g_kn[i][e]; }
            *qp = pack8(a); *kp = pack8(b);
        }
        {
            u32x4* qp = (u32x4*)(Q + (size_t)row * QP + 1024 + 8 * lane); u32x4* kp = (u32x4*)(LAT + (size_t)row * LATP + 640 + 8 * (lane & 7));
            float a[8], b[8]; unpack8(*qp, a); unpack8(*kp, b);
            float sa = 0.f, sb = 0.f;
#pragma unroll
            for (int e = 0; e < 8; ++e) { a[e] *= rq; sa += a[e] * a[e]; sb += b[e] * b[e]; }
#pragma unroll
            for (int o = 1; o < 8; o <<= 1) { sa += __shfl_xor(sa, o); sb += __shfl_xor(sb, o); }
            const float ra = rsqrtf(sa * (1.0f / 64) + EPS), rb = rsqrtf(sb * (1.0f / 64) + EPS);
            const bool hi = (lane & 4) != 0;
#pragma unroll
            for (int e = 0; e < 8; ++e) {
                const float ya = a[e] * ra * g_qr[e], yb = b[e] * rb * g_kr[e];
                const float pa = __shfl_xor(ya, 4), pb = __shfl_xor(yb, 4);
                a[e] = hi ? (ya * cj[e] + pa * sj[e]) : (ya * cj[e] - pa * sj[e]);
                b[e] = hi ? (yb * cj[e] + pb * sj[e]) : (yb * cj[e] - pb * sj[e]);
            }
            *qp = pack8(a); if (lane < 8) *kp = pack8(b);
        }
    }
}

constexpr int KROW = 400, VROW = 288, KTILE = 64 * KROW, VTILE = 64 * VROW;
__device__ __forceinline__ void attn_unit(int tid, unsigned char* lds, const bf16_t* Q, const bf16_t* KV, const bf16_t* KR, bf16_t* O, int b, int h, int qb) {
    const int lane = tid & 63, w = __builtin_amdgcn_readfirstlane(tid >> 6), r = lane & 15, g = lane >> 4;
    const int row0 = b * SEQ + qb * 256, qrow = row0 + 32 * w + r;
    bf16x8 qf[2][6];
#pragma unroll
    for (int rg = 0; rg < 2; ++rg) {
#pragma unroll
        for (int ks = 0; ks < 4; ++ks) qf[rg][ks] = *(const bf16x8*)(Q + (size_t)(qrow + 16 * rg) * QP + h * 128 + 32 * ks + 8 * g);
#pragma unroll
        for (int ks = 0; ks < 2; ++ks) qf[rg][4 + ks] = *(const bf16x8*)(Q + (size_t)(qrow + 16 * rg) * QP + 1024 + h * 64 + 32 * ks + 8 * g);
    }
    const int ntiles = 4 * qb + 4, last_tile = 4 * qb + (w >> 1);
    const int kn_row0 = tid >> 4, kn_ch = tid & 15;
    const int kr_row = tid >> 3, kr_ch = tid & 7;
    const bf16_t* gk = KV + (size_t)(b * SEQ) * KVP + h * 256;
    const bf16_t* gr = KR + (size_t)(b * SEQ) * LATP;
    u32x4 sk0, sk1, sr, sv0, sv1;
#define ATT_LOAD(t) do { const size_t kb = (size_t)(t) * 64; \
        sk0 = *(const u32x4*)(gk + (kb + kn_row0) * KVP + kn_ch * 8); sk1 = *(const u32x4*)(gk + (kb + kn_row0 + 32) * KVP + kn_ch * 8); \
        sv0 = *(const u32x4*)(gk + (kb + kn_row0) * KVP + 128 + kn_ch * 8); sv1 = *(const u32x4*)(gk + (kb + kn_row0 + 32) * KVP + 128 + kn_ch * 8); \
        sr = *(const u32x4*)(gr + (kb + kr_row) * LATP + kr_ch * 8); } while (0)
#define ATT_STORE(buf) do { unsigned char* kb_ = lds + (buf) * KTILE; unsigned char* vb_ = lds + 2 * KTILE + (buf) * VTILE; \
        *(u32x4*)(kb_ + kn_row0 * KROW + kn_ch * 16) = sk0; *(u32x4*)(kb_ + (kn_row0 + 32) * KROW + kn_ch * 16) = sk1; \
        *(u32x4*)(kb_ + kr_row * KROW + 256 + kr_ch * 16) = sr; \
        *(u32x4*)(vb_ + kn_row0 * VROW + kn_ch * 16) = sv0; *(u32x4*)(vb_ + (kn_row0 + 32) * VROW + kn_ch * 16) = sv1; } while (0)
    f32x4 o[2][8];
#pragma unroll
    for (int rg = 0; rg < 2; ++rg)
#pragma unroll
        for (int i = 0; i < 8; ++i) o[rg][i] = (f32x4){0.f, 0.f, 0.f, 0.f};
    float m[2] = {-1e30f, -1e30f}, l[2] = {0.f, 0.f};
    ATT_LOAD(0); ATT_STORE(0);
    __syncthreads();
    const int q4 = r >> 2, p4 = lane & 3;
    const int vtr_off = (4 * g + q4) * VROW + (4 * p4) * 2;
    const int qidx = qb * 256 + 32 * w + r;
    for (int t = 0; t < ntiles; ++t) {
        const bool more = (t + 1 < ntiles);
        if (more) ATT_LOAD(t + 1);
        if (t <= last_tile) {
            const unsigned char* Kb = lds + (t & 1) * KTILE; const unsigned char* Vb = lds + 2 * KTILE + (t & 1) * VTILE;
            f32x4 p[2][4];
#pragma unroll
            for (int kb = 0; kb < 4; ++kb) {
                p[0][kb] = (f32x4){0.f, 0.f, 0.f, 0.f}; p[1][kb] = (f32x4){0.f, 0.f, 0.f, 0.f};
#pragma unroll
                for (int ks = 0; ks < 6; ++ks) {
                    const bf16x8 a = *(const bf16x8*)(Kb + (16 * kb + r) * KROW + ks * 64 + g * 16);
                    p[0][kb] = __builtin_amdgcn_mfma_f32_16x16x32_bf16(a, qf[0][ks], p[0][kb], 0, 0, 0);
                    p[1][kb] = __builtin_amdgcn_mfma_f32_16x16x32_bf16(a, qf[1][ks], p[1][kb], 0, 0, 0);
                }
            }
            const bool diag = (t * 64 + 63 > qb * 256 + 32 * w);
            bf16x8 pb[2][2];
#pragma unroll
            for (int rg = 0; rg < 2; ++rg) {
                if (diag) {
#pragma unroll
                    for (int kb = 0; kb < 4; ++kb)
#pragma unroll
                        for (int i = 0; i < 4; ++i) { const int kk = t * 64 + 16 * kb + 4 * g + i; if (kk > qidx + 16 * rg) p[rg][kb][i] = -1e30f; }
                }
                float mx = fmaxf(fmaxf(p[rg][0][0], p[rg][0][1]), fmaxf(p[rg][0][2], p[rg][0][3]));
#pragma unroll
                for (int kb = 1; kb < 4; ++kb) mx = fmaxf(mx, fmaxf(fmaxf(p[rg][kb][0], p[rg][kb][1]), fmaxf(p[rg][kb][2], p[rg][kb][3])));
                mx = fmaxf(mx, __shfl_xor(mx, 16)); mx = fmaxf(mx, __shfl_xor(mx, 32));
                const float mn = fmaxf(m[rg], mx), alpha = fast_exp2(m[rg] - mn); m[rg] = mn;
                float rsum = 0.f;
#pragma unroll
                for (int kb = 0; kb < 4; ++kb)
#pragma unroll
                    for (int i = 0; i < 4; ++i) { p[rg][kb][i] = fast_exp2(p[rg][kb][i] - mn); rsum += p[rg][kb][i]; }
                l[rg] = l[rg] * alpha + rsum;
#pragma unroll
                for (int i = 0; i < 8; ++i) o[rg][i] *= alpha;
#pragma unroll
                for (int kk = 0; kk < 2; ++kk) {
                    u32x4 pw; pw.x = cvt_pk_bf16(p[rg][2 * kk][0], p[rg][2 * kk][1]); pw.y = cvt_pk_bf16(p[rg][2 * kk][2], p[rg][2 * kk][3]);
                    pw.z = cvt_pk_bf16(p[rg][2 * kk + 1][0], p[rg][2 * kk + 1][1]); pw.w = cvt_pk_bf16(p[rg][2 * kk + 1][2], p[rg][2 * kk + 1][3]);
                    pb[rg][kk] = __builtin_bit_cast(bf16x8, pw);
                }
            }
#pragma unroll
            for (int db = 0; db < 8; ++db)
#pragma unroll
                for (int kk = 0; kk < 2; ++kk) {
                    const LAS unsigned char* vp = (const LAS unsigned char*)(Vb + vtr_off + (32 * kk) * VROW + db * 32);
                    const s16x4 lo = __builtin_bit_cast(s16x4, __builtin_amdgcn_ds_read_tr16_b64_v4i16((LAS s16x4*)vp));
                    const s16x4 hi = __builtin_bit_cast(s16x4, __builtin_amdgcn_ds_read_tr16_b64_v4i16((LAS s16x4*)(vp + 16 * VROW)));
                    const bf16x8 vf = __builtin_shufflevector(lo, hi, 0, 1, 2, 3, 4, 5, 6, 7);
                    o[0][db] = __builtin_amdgcn_mfma_f32_16x16x32_bf16(vf, pb[0][kk], o[0][db], 0, 0, 0);
                    o[1][db] = __builtin_amdgcn_mfma_f32_16x16x32_bf16(vf, pb[1][kk], o[1][db], 0, 0, 0);
                }
        }
        if (more) ATT_STORE((t + 1) & 1);
        __syncthreads();
    }
#pragma unroll
    for (int rg = 0; rg < 2; ++rg) {
        float ls = l[rg]; ls += __shfl_xor(ls, 16); ls += __shfl_xor(ls, 32);
        const float inv = fast_rcp(ls);
        bf16_t* orow = O + (size_t)(qrow + 16 * rg) * QP + h * 128 + 4 * g;
#pragma unroll
        for (int db = 0; db < 8; ++db) {
            u32x2 wv; wv.x = cvt_pk_bf16(o[rg][db][0] * inv, o[rg][db][1] * inv); wv.y = cvt_pk_bf16(o[rg][db][2] * inv, o[rg][db][3] * inv);
            *(u32x2*)(orow + 16 * db) = wv;
        }
    }
#undef ATT_LOAD
#undef ATT_STORE
}
__device__ __forceinline__ void attn_phase(int tid, const Params& P, unsigned char* lds) {
    bf16_t* Q = (bf16_t*)(P.ws + OFF_FF + FF_Q); const bf16_t* KV = (const bf16_t*)(P.ws + OFF_FF + FF_KV); const bf16_t* KR = (const bf16_t*)(P.ws + OFF_FF + FF_LAT) + 640;
    for (int pr = blockIdx.x; pr < 512; pr += gridDim.x) {
        const int bh = pr >> 2, x = pr & 3, b = bh >> 3, h = bh & 7;
        attn_unit(tid, lds, Q, KV, KR, Q, b, h, 7 - x);
        attn_unit(tid, lds, Q, KV, KR, Q, b, h, x);
    }
}

constexpr int SROW = 576;
constexpr int SGU_STAT_OFF = 128 * SROW;
constexpr int SGU_W_OFF = SGU_STAT_OFF + 2048, SWROW = 272;
__device__ __forceinline__ void sgu_phase(int tid, const Params& P, unsigned char* lds, int j) {
    const int lane = tid & 63, w = __builtin_amdgcn_readfirstlane(tid >> 6), r = lane & 31, hh = lane >> 5;
    bf16_t* Z = (bf16_t*)(P.ws + OFF_FF);
    const float* lng = P.in[17] + j * 2048; const float* lnb = P.in[18] + j * 2048;
    const float* wsp = P.in[19] + (size_t)j * 8 * 128 * 128; const float* bsp = P.in[20] + j * 8 * 128;
    const int q4 = (lane & 15) >> 2, p4 = lane & 3, colblk = (lane >> 4) & 1;
    f32x2* stl = (f32x2*)(lds + SGU_STAT_OFF);
    for (int unit = blockIdx.x; unit < 256; unit += gridDim.x) {
        const int row0 = unit * 128;
        for (int rr0 = 0; rr0 < 16; rr0 += 4) {
            u32x4 raw[4][4];
#pragma unroll
            for (int a = 0; a < 4; ++a)
#pragma unroll
                for (int i = 0; i < 4; ++i) raw[a][i] = *(const u32x4*)(Z + (size_t)(row0 + 16 * w + rr0 + a) * ZP + 2048 + 8 * lane + 512 * i);
#pragma unroll
            for (int a = 0; a < 4; ++a) {
                float s1 = 0.f, s2 = 0.f;
#pragma unroll
                for (int i = 0; i < 4; ++i) { float v[8]; unpack8(raw[a][i], v);
#pragma unroll
                    for (int e = 0; e < 8; ++e) { s1 += v[e]; s2 += v[e] * v[e]; } }
                s1 = wave_sum(s1); s2 = wave_sum(s2);
                const float mu = s1 * (1.0f / 2048), var = s2 * (1.0f / 2048) - mu * mu;
                if (lane == 0) stl[16 * w + rr0 + a] = (f32x2){mu, rsqrtf(fmaxf(var, 0.f) + EPS)};
            }
        }
        __syncthreads();
        for (int g = 0; g < 8; ++g) {
#pragma unroll 2
            for (int i = 0; i < 8; ++i) {
                const int chunk = tid + 512 * i, row = chunk >> 5, ch = chunk & 31, col = g * 256 + ch * 8;
                float v[8]; unpack8(*(const u32x4*)(Z + (size_t)(row0 + row) * ZP + 2048 + col), v);
                const f32x2 st = stl[row]; const float mu = st.x, rstd = st.y;
                const f32x4 g0 = *(const f32x4*)(lng + col), g1 = *(const f32x4*)(lng + col + 4), b0 = *(const f32x4*)(lnb + col), b1 = *(const f32x4*)(lnb + col + 4);
#pragma unroll
                for (int e = 0; e < 4; ++e) { v[e] = (v[e] - mu) * rstd * g0[e] + b0[e]; v[4 + e] = (v[4 + e] - mu) * rstd * g1[e] + b1[e]; }
                *(u32x4*)(lds + row * SROW + ch * 16) = pack8(v);
            }
            {
                const float* wg = wsp + (size_t)g * 128 * 128;
                f32x4 w0[4], w1[4];
#pragma unroll
                for (int i = 0; i < 4; ++i) { const int c = tid + 512 * i, t = c >> 4, s0 = (c & 15) * 8; w0[i] = *(const f32x4*)(wg + t * 128 + s0); w1[i] = *(const f32x4*)(wg + t * 128 + s0 + 4); }
#pragma unroll
                for (int i = 0; i < 4; ++i) { const int c = tid + 512 * i, t = c >> 4, s0 = (c & 15) * 8;
                    float wv[8] = {w0[i][0], w0[i][1], w0[i][2], w0[i][3], w1[i][0], w1[i][1], w1[i][2], w1[i][3]};
#pragma unroll
                    for (int e = 0; e < 8; ++e) if (s0 + e > t) wv[e] = 0.f;
                    *(u32x4*)(lds + SGU_W_OFF + t * SWROW + s0 * 2) = pack8(wv); }
            }
            __syncthreads();
            bf16x8 af[8];
#pragma unroll
            for (int ks = 0; ks < 8; ++ks) {
                const LAS unsigned char* vp = (const LAS unsigned char*)(lds + (16 * ks + 8 * hh + q4) * SROW + (32 * w + 16 * colblk + 4 * p4) * 2);
                const s16x4 lo = __builtin_bit_cast(s16x4, __builtin_amdgcn_ds_read_tr16_b64_v4i16((LAS s16x4*)vp));
                const s16x4 hi = __builtin_bit_cast(s16x4, __builtin_amdgcn_ds_read_tr16_b64_v4i16((LAS s16x4*)(vp + 4 * SROW)));
                af[ks] = __builtin_shufflevector(lo, hi, 0, 1, 2, 3, 4, 5, 6, 7);
            }
#pragma unroll
            for (int tb = 0; tb < 4; ++tb) {
                f32x16 acc;
#pragma unroll
                for (int e = 0; e < 16; ++e) acc[e] = 0.f;
                const int t = 32 * tb + r;
#pragma unroll
                for (int ks = 0; ks < 8; ++ks) {
                    if (ks <= 2 * tb + 1) {
                        const bf16x8 bfr = *(const bf16x8*)(lds + SGU_W_OFF + t * SWROW + (16 * ks + 8 * hh) * 2);
                        acc = __builtin_amdgcn_mfma_f32_32x32x16_bf16(af[ks], bfr, acc, 0, 0, 0);
                    }
                }
                const float bias = bsp[g * 128 + t];
                bf16_t* up = Z + (size_t)(row0 + t) * ZP + g * 256 + 32 * w + 4 * hh;
#pragma unroll
                for (int i4 = 0; i4 < 4; ++i4) {
                    const u32x2 uu = *(const u32x2*)(up + 8 * i4);
                    u32x2 y; y.x = cvt_pk_bf16(bflo(uu.x) * (acc[4 * i4] + bias), bfhi(uu.x) * (acc[4 * i4 + 1] + bias));
                    y.y = cvt_pk_bf16(bflo(uu.y) * (acc[4 * i4 + 2] + bias), bfhi(uu.y) * (acc[4 * i4 + 3] + bias));
                    *(u32x2*)(up + 8 * i4) = y;
                }
            }
            __syncthreads();
        }
    }
}


#define XB_TMO      128
#define XB_XCNT(j)  (256  + 64 * (j))
#define XB_XSUB(j)  (1280 + 64 * (j))
#define XB_XGEN(j)  (2304 + 64 * (j))
#define XB_TOP      3328
#define XB_TOPGEN   3392
#define XB_SPIN_CAP (1u << 22)
__device__ __forceinline__ unsigned xb_ld(unsigned* p)              { return __hip_atomic_load(p, __ATOMIC_RELAXED, __HIP_MEMORY_SCOPE_AGENT); }
__device__ __forceinline__ unsigned xb_add(unsigned* p, unsigned v) { return __hip_atomic_fetch_add(p, v, __ATOMIC_RELAXED, __HIP_MEMORY_SCOPE_AGENT); }
__device__ __forceinline__ unsigned xb_xcc_id() { return (unsigned)__builtin_amdgcn_s_getreg((3 << 11) | 20) & 0xFu; }
#define XB_SPIN(cond, bar) do { unsigned _sp = 0; while (cond) { __builtin_amdgcn_s_sleep(1); \
    if ((++_sp & 255u) == 0u) { if (xb_ld(&(bar)[XB_TMO])) break; if (_sp > XB_SPIN_CAP) { atomicAdd(&(bar)[XB_TMO], 1u); break; } } } } while (0)
__device__ __forceinline__ void xcd_barrier_complete(unsigned* bar, unsigned x, unsigned& nloc, unsigned& nx) {
    const unsigned G = gridDim.x;
    unsigned sum, cnt, mine, sp = 0u;
    for (;;) {
        sum = 0u; cnt = 0u; mine = 0u;
#pragma unroll
        for (unsigned j = 0; j < 16; ++j) { const unsigned c = xb_ld(&bar[XB_XCNT(j)]); sum += c; cnt += (c > 0u) ? 1u : 0u; mine = (j == x) ? c : mine; }
        if (sum == G) break;
        __builtin_amdgcn_s_sleep(1);
        if ((++sp & 255u) == 0u) { if (xb_ld(&bar[XB_TMO])) break; if (sp > XB_SPIN_CAP) { atomicAdd(&bar[XB_TMO], 1u); break; } }
    }
    nloc = mine > 0u ? mine : 1u; nx = cnt > 0u ? cnt : 1u;
}
__device__ __forceinline__ void xcd_barrier(unsigned* bar, unsigned x, volatile LAS unsigned* st) {
    asm volatile("s_waitcnt vmcnt(0)" ::: "memory");
    __syncthreads();
    if (threadIdx.x == 0) {
        __builtin_amdgcn_s_waitcnt(0);
        unsigned nloc = st[0], nx = st[1];
        if (nloc == 0u) { xcd_barrier_complete(bar, x, nloc, nx); st[0] = nloc; st[1] = nx; }
        const unsigned old = xb_add(&bar[XB_XSUB(x)], 1u);
        const unsigned gen = old / nloc;
        if (old + 1u == (gen + 1u) * nloc) {
            __builtin_amdgcn_fence(__ATOMIC_RELEASE, "agent");
            asm volatile("s_waitcnt vmcnt(0)" ::: "memory");
            const unsigned og = xb_add(&bar[XB_TOP], 1u);
            const unsigned tg = og / nx;
            if (og + 1u == (tg + 1u) * nx) xb_add(&bar[XB_TOPGEN], 1u);
            else XB_SPIN(xb_ld(&bar[XB_TOPGEN]) == tg, bar);
            __builtin_amdgcn_fence(__ATOMIC_ACQUIRE, "agent");
            xb_add(&bar[XB_XGEN(x)], 1u);
            asm volatile("s_waitcnt vmcnt(0)" ::: "memory");
        } else {
            XB_SPIN(xb_ld(&bar[XB_XGEN(x)]) == gen, bar);
            __builtin_amdgcn_fence(__ATOMIC_ACQUIRE, "agent");
            asm volatile("s_waitcnt vmcnt(0)" ::: "memory");
        }
    }
    __syncthreads();
}

constexpr int NPHASE = 1 + 9 * DEPTH;
__device__ __forceinline__ int mktid(int wv0) { int t; asm volatile("v_mbcnt_lo_u32_b32 %0, -1, 0\n\tv_mbcnt_hi_u32_b32 %0, -1, %0" : "=v"(t)); return (t + wv0 * 64) & 511; }
__device__ __forceinline__ Params load_params() {
    Params P{};
#if defined(__HIP_DEVICE_COMPILE__)
    typedef const __attribute__((address_space(4))) unsigned long long* kp_t;
    kp_t kp = (kp_t)__builtin_amdgcn_kernarg_segment_ptr(); asm volatile("" : "+s"(kp));
#pragma unroll
    for (int i = 0; i < 26; ++i) P.in[i] = (const float*)kp[i];
    P.out = (float*)kp[26]; P.ws = (unsigned char*)kp[27];
#endif
    return P;
}
__host__ __device__ __forceinline__ bool phase_nonempty(int ph) {
    if (ph == 0) return true;
    const int layer = (ph - 1) / 9, slot = (ph - 1) % 9;
    if ((layer & 1) && (slot == 3 || slot == 4)) return false;
    return true;
}

__global__ void __launch_bounds__(512) fwd_megakernel(Params Parg) {
    extern __shared__ __attribute__((aligned(16))) unsigned char lds[];
    LAS unsigned char* ldsl = (LAS unsigned char*)lds;
    const int wv0 = __builtin_amdgcn_readfirstlane((int)threadIdx.x >> 6);
    volatile LAS unsigned* bst = (volatile LAS unsigned*)(ldsl + 131072);
    if (threadIdx.x == 0) { bst[0] = 0u; bst[1] = 0u; }
    __syncthreads();
    unsigned* const bar = (unsigned*)(Parg.ws + OFF_BAR);
    const unsigned xcc = xb_xcc_id();
    int nseam = 0;
    bool first = true;
    for (int ph = Parg.ph_lo; ph < Parg.ph_hi; ++ph) {
        if (!phase_nonempty(ph)) continue;
        if (!first) {
            if (nseam == 0) { cg::this_grid().sync(); if (threadIdx.x == 0) (void)xb_add(&bar[XB_XCNT(xcc)], 1u); }
            else xcd_barrier(bar, xcc, bst);
            ++nseam;
        }
        first = false;
        const Params P = load_params();
        unsigned char* ws = P.ws;
        bf16_t* wb = (bf16_t*)(ws + OFF_W);
        bf16_t* hb = (bf16_t*)(ws + OFF_HB);
        float* SS = (float*)(ws + OFF_SS);
        const int G = gridDim.x, c = blockIdx.x;
#ifndef NO_P0
        if (ph == 0) { p0_prologue(mktid(wv0), P, lds); continue; }
#else
        if (ph == 0) continue;
#endif
        const int layer = (ph - 1) / 9, slot = (ph - 1) % 9, j = layer >> 1;
        const bool mla = (layer & 1) == 0;
        float* ss_mix = SS; float* ss_ffn = SS; float* ss_ple = SS;
        float* ss_next = (layer + 1 < DEPTH) ? SS : nullptr;
        const float* hin = (layer == 0) ? P.in[0] : nullptr;
        pg8::StaticOrder S;
        if (slot == 0) {
            if (mla) {
                pg8::Gemm g{hb, wb + WE_DOWN + (size_t)j * LATP * DM, T, LATP, DM, DM}; S.init(T, LATP, G, c);
                pg8::EpiStore<0, 0> E{(bf16_t*)(ws + OFF_FF + FF_LAT), LATP, ss_mix, 1.0f / DM};
                pg8::gemm_phase(mktid(wv0), ldsl, g, S, E);
            } else {
                pg8::Gemm g{hb, wb + WE_GIN + (size_t)j * ZP * DM, T, ZP, DM, DM}; S.init(T, ZP, G, c);
                pg8::EpiStore<2, 0> E{(bf16_t*)(ws + OFF_FF), ZP, ss_mix, 1.0f / DM};
                pg8::gemm_phase(mktid(wv0), ldsl, g, S, E);
            }
        } else if (slot == 1) {
            if (mla) {
                { pg8::Gemm g{(const bf16_t*)(ws + OFF_FF + FF_LAT), wb + WE_UQ + (size_t)j * QP * QLR, T, QP, QLR, LATP}; S.init(T, QP, G, c);
                  pg8::EpiStore<0, 0> E{(bf16_t*)(ws + OFF_FF + FF_Q), QP, nullptr, 0.f};
                  pg8::gemm_phase(mktid(wv0), ldsl, g, S, E); }
                { pg8::Gemm g{(const bf16_t*)(ws + OFF_FF + FF_LAT) + QLR, wb + WE_UKV + (size_t)j * KVP * KVLR, T, KVP, KVLR, LATP}; S.init(T, KVP, G, c);
                  pg8::EpiStore<0, 0> E{(bf16_t*)(ws + OFF_FF + FF_KV), KVP, nullptr, 0.f};
                  pg8::gemm_phase(mktid(wv0), ldsl, g, S, E); }
            } else {
#ifndef NO_SGU
                sgu_phase(mktid(wv0), P, lds, j);
#endif
            }
        } else if (slot == 2) {
            if (mla) {
#ifndef NO_R2
                r2_phase(mktid(wv0), P, j);
#endif
            } else {
                pg8::Gemm g{(const bf16_t*)(ws + OFF_FF), wb + WE_GOUT + (size_t)j * DM * 2048, T, DM, 2048, ZP}; S.init(T, DM, G, c);
                pg8::EpiRes<0> E{hin, nullptr, hb, ss_ffn, nullptr};
                pg8::gemm_phase(mktid(wv0), ldsl, g, S, E);
            }
        } else if (slot == 3) {
#ifndef NO_ATT
            attn_phase(mktid(wv0), P, lds);
#endif
        } else if (slot == 4) {
            pg8::Gemm g{(const bf16_t*)(ws + OFF_FF + FF_Q), wb + WE_MOUT + (size_t)j * DM * DM, T, DM, DM, QP}; S.init(T, DM, G, c);
            pg8::EpiRes<0> E{hin, nullptr, hb, ss_ffn, nullptr};
            pg8::gemm_phase(mktid(wv0), ldsl, g, S, E);
        } else if (slot == 5) {
            pg8::Gemm g{hb, wb + WE_UP + (size_t)layer * DFF * DM, T, DFF, DM, DM}; S.init(T, DFF, G, c);
            pg8::EpiStore<1, 0> E{(bf16_t*)(ws + OFF_FF), DFF, ss_ffn, 1.0f / DM};
            pg8::gemm_phase(mktid(wv0), ldsl, g, S, E);
        } else if (slot == 6) {
            pg8::Gemm g{(const bf16_t*)(ws + OFF_FF), wb + WE_DN + (size_t)layer * DM * DFF, T, DM, DFF, DFF}; S.init(T, DM, G, c);
            pg8::EpiRes<0> E{nullptr, nullptr, hb, ss_ple, nullptr};
            pg8::gemm_phase(mktid(wv0), ldsl, g, S, E);
        } else if (slot == 7) {
            pg8::Gemm g{hb, wb + WE_GATE + (size_t)layer * DM * DM, T, DM, DM, DM}; S.init(T, DM, G, c);
            pg8::EpiStore<3, 0> E{(bf16_t*)(ws + OFF_FF), DM, ss_ple, 1.0f / DM};
            pg8::gemm_phase(mktid(wv0), ldsl, g, S, E);
        } else {
            pg8::Gemm g{(const bf16_t*)(ws + OFF_PB) + (size_t)layer * T * PLE, wb + WE_PROJ + (size_t)layer * DM * PLE, T, DM, PLE, PLE}; S.init(T, DM, G, c);
            pg8::EpiRes<1> E{nullptr, (layer == DEPTH - 1) ? P.out : nullptr, hb, ss_next, (const bf16_t*)(ws + OFF_FF)};
            pg8::gemm_phase(mktid(wv0), ldsl, g, S, E);
        }
    }
    asm volatile("s_waitcnt vmcnt(0)" ::: "memory");
    __builtin_amdgcn_fence(__ATOMIC_RELEASE, "agent");
    asm volatile("s_waitcnt vmcnt(0)" ::: "memory");
}


#ifdef DBG_CHECK
__global__ void dbg_check(const bf16_t* A, int lda, const bf16_t* Bt, int K, const bf16_t* C, int ldc, int N, const float* ss, int act, float* out) {
    const unsigned s = blockIdx.x * blockDim.x + threadIdx.x;
    const unsigned hsh = s * 2654435761u; const int row = (hsh >> 8) % T; const int col = (s * 40503u + (hsh >> 3)) % N;
    float acc = 0.f;
    for (int k = 0; k < K; ++k) acc += bf2f(A[(size_t)row * lda + k]) * bf2f(Bt[(size_t)col * K + k]);
    if (ss) acc *= rsqrtf(ss[row] * (1.0f / DM) + EPS);
    if (act == 3) acc = 1.0f / (1.0f + expf(-acc));
    if (act == 1) { acc = fmaxf(acc, 0.f); acc *= acc; }
    const float got = bf2f(C[(size_t)row * ldc + col]);
    if (!(fabsf(got - acc) <= 0.03f + 0.03f * fabsf(acc))) atomicAdd(out + 4096, 1.0f);
}
#endif

#ifdef DBG_CHECK
__global__ void dbg_check_ss(const float* h, const float* ss, float* out) {
    const int row = blockIdx.x * blockDim.x + threadIdx.x; if (row >= T) return;
    float a = 0.f; for (int k = 0; k < DM; ++k) { const float v = h[(size_t)row * DM + k]; a += v * v; }
    const float got = ss[row];
    if (!(fabsf(got - a) <= 1e-3f * fabsf(a))) out[(size_t)row * DM] = 1e30f;
}
#endif

#ifdef DBG_CHECK
__global__ void dbg_zero(float* out) { out[4096 + threadIdx.x] = 0.f; out[8192 + threadIdx.x] = 0.f; }
__global__ void dbg_reduce(float* out) {
    float bc = 0.f, br = 0.f; int ic = 0, ir = 0;
    for (int i = 0; i < 256; ++i) { if (out[4096 + i] > bc) { bc = out[4096 + i]; ic = i; } if (out[8192 + i] > br) { br = out[8192 + i]; ir = i; } }
    float v = 1e6f * out[4096];
    for (int i = 0; i < 256; ++i) { out[4096 + i] = 0.f; out[8192 + i] = 0.f; }
    out[0] = v; out[1] = 1e-3f * bc; out[2] = 1e-3f * br;
}
#endif
constexpr int LDS_BYTES = 131072 + 256;
extern "C" void kernel_launch(void* const* d_in, const int* in_sizes, int n_in, void* d_out, int out_size, void* d_ws, size_t ws_size, hipStream_t stream) {
    static int grid = 0;
    if (grid == 0) {
        if (n_in != 26 || out_size != T * DM || ws_size < WS_NEED) { fprintf(stderr, "kernel_launch: unexpected problem (n_in %d out %d ws %zu)\n", n_in, out_size, ws_size); grid = -1; return; }
        int dev = 0, cus = 0, per_cu = 0;
        hipGetDevice(&dev); hipDeviceGetAttribute(&cus, hipDeviceAttributeMultiprocessorCount, dev);
        hipFuncSetAttribute((const void*)fwd_megakernel, hipFuncAttributeMaxDynamicSharedMemorySize, LDS_BYTES);
        hipOccupancyMaxActiveBlocksPerMultiprocessor(&per_cu, (const void*)fwd_megakernel, 512, LDS_BYTES);
        if (per_cu < 1) { fprintf(stderr, "kernel_launch: occupancy query says %d blocks/CU\n", per_cu); per_cu = 1; }
        (void)hipGetLastError();
        grid = cus;
    }
    if (grid < 0) return;
    Params p{};
    for (int i = 0; i < 26; ++i) p.in[i] = (const float*)d_in[i];
    p.out = (float*)d_out; p.ws = (unsigned char*)d_ws;
#if ONE_LAUNCH
    p.ph_lo = 0; p.ph_hi = NPHASE;
    for (int rep = 0; rep < DBG_REPS; ++rep)
    { void* args[] = {&p}; hipError_t e = hipLaunchCooperativeKernel((const void*)fwd_megakernel, dim3(grid), dim3(512), args, LDS_BYTES, stream);
      if (e != hipSuccess) fprintf(stderr, "cooperative launch failed: %s (grid %d)\n", hipGetErrorString(e), grid); }
#else
#ifndef DBG_STOP
#define DBG_STOP (NPHASE - 1)
#endif
    for (int ph = 0; ph <= DBG_STOP; ++ph) {
        if (!phase_nonempty(ph)) continue;
        p.ph_lo = ph; p.ph_hi = ph + 1;
#ifdef DBG_NANFILL
        if (ph == DBG_NANFILL) (void)hipMemsetAsync((char*)d_ws + OFF_FF, 0xFF, 64 * MiB, stream);
#endif
        void* args[] = {&p}; hipError_t e = hipLaunchCooperativeKernel((const void*)fwd_megakernel, dim3(grid), dim3(512), args, LDS_BYTES, stream);
        if (e != hipSuccess) { fprintf(stderr, "cooperative launch failed: %s (grid %d, phase %d)\n", hipGetErrorString(e), grid, ph); break; }
    }
#ifdef DBG_CHECK
    { unsigned char* ws = (unsigned char*)d_ws; bf16_t* wb = (bf16_t*)(ws + OFF_W);
      dbg_zero<<<1, 256, 0, stream>>>((float*)d_out); DBG_CHECK; dbg_reduce<<<1, 1, 0, stream>>>((float*)d_out); }
#endif
#endif
}
```

```cpp
#include <hip/hip_runtime.h>
#include <hip/hip_cooperative_groups.h>
#include <cstdio>
#include <cstdint>
namespace cg = cooperative_groups;

#ifndef DBG_NOGATE
#define DBG_NOGATE 0
#endif
#ifndef DBG_GATE_NOSS
#define DBG_GATE_NOSS 0
#endif
#ifndef DBG_REPS
#define DBG_REPS 1
#endif
#ifndef ONE_LAUNCH
#define ONE_LAUNCH 1
#endif

#define LAS __attribute__((address_space(3)))
typedef unsigned short bf16_t;
typedef short bf16x8 __attribute__((ext_vector_type(8)));
typedef short s16x4 __attribute__((ext_vector_type(4)));
typedef float f32x4 __attribute__((ext_vector_type(4)));
typedef float f32x2 __attribute__((ext_vector_type(2)));
typedef float f32x16 __attribute__((ext_vector_type(16)));
typedef unsigned u32x4 __attribute__((ext_vector_type(4)));
typedef unsigned u32x2 __attribute__((ext_vector_type(2)));

constexpr int T = 32768, DM = 1024, SEQ = 2048, NB = 16, DFF = 4096, PLE = 256, DEPTH = 4;
constexpr int NH = 8, QLR = 384, KVLR = 256, ROPE = 64, LATP = 768;
constexpr int QP = 1536, KVP = 2048, ZP = 4096;
constexpr float EPS = 1e-6f;
constexpr float QSCALE = 0.07216878364870322f * 1.4426950408889634f;

constexpr size_t MiB = 1u << 20;
constexpr size_t OFF_SS = 0;
constexpr size_t OFF_W = 2621440;
constexpr size_t OFF_HB = 112 * MiB;
constexpr size_t OFF_FF = 176 * MiB;
constexpr size_t OFF_PB = 448 * MiB;
constexpr size_t WS_NEED = 512 * MiB;
constexpr size_t OFF_BAR = 2 * MiB;
#define XCD_BAR_WORDS 3456
constexpr size_t WE_DOWN = 0, WE_UQ = WE_DOWN + 2ull * LATP * DM, WE_UKV = WE_UQ + 2ull * QP * QLR, WE_MOUT = WE_UKV + 2ull * KVP * KVLR,
                 WE_GIN = WE_MOUT + 2ull * DM * DM, WE_GOUT = WE_GIN + 2ull * ZP * DM, WE_UP = WE_GOUT + 2ull * DM * 2048,
                 WE_DN = WE_UP + 4ull * DFF * DM, WE_GATE = WE_DN + 4ull * DM * DFF, WE_PROJ = WE_GATE + 4ull * DM * DM, WE_END = WE_PROJ + 4ull * DM * PLE;
static_assert(OFF_W + WE_END * 2 <= OFF_HB, "weights fit");
constexpr size_t FF_Q = 0, FF_KV = 96 * MiB, FF_LAT = 224 * MiB;

struct Params { const float* in[26]; float* out; unsigned char* ws; int ph_lo, ph_hi; };

typedef __bf16 bf16x2_t __attribute__((ext_vector_type(2)));
__device__ __forceinline__ unsigned cvt_pk_bf16(float lo, float hi) { const f32x2 v = {lo, hi}; return __builtin_bit_cast(unsigned, __builtin_convertvector(v, bf16x2_t)); }
__device__ __forceinline__ float bf2f(unsigned short b) { return __uint_as_float((unsigned)b << 16); }
__device__ __forceinline__ float bflo(unsigned u) { return __uint_as_float(u << 16); }
__device__ __forceinline__ float bfhi(unsigned u) { return __uint_as_float(u & 0xffff0000u); }
__device__ __forceinline__ float fast_rcp(float x) { return __builtin_amdgcn_rcpf(x); }
__device__ __forceinline__ float fast_exp2(float x) { return __builtin_amdgcn_exp2f(x); }
__device__ __forceinline__ float gelu_tanh(float x) { const float y = x + 0.044715f * x * x * x; return x * fast_rcp(1.0f + fast_exp2(-2.3022082f * y)); }
__device__ __forceinline__ float sigmoidf_(float x) { return fast_rcp(1.0f + fast_exp2(-1.4426950409f * x)); }

namespace pg8 {
constexpr int BM = 256, BK = 64, HALF = 128, HTB = HALF * BK * 2, STAGE_BYTES = 8 * HTB, NXCD = 8, WGM = 8;
__host__ __device__ __forceinline__ int lds_byte(int r, int c) { const int st = (r >> 4) * 2 + (c >> 5), rr = r & 15, cc = c & 31, ob = rr * 64 + cc * 2; return st * 1024 + (ob ^ (((ob >> 9) & 1) << 5)); }
__host__ __device__ __forceinline__ void stage_rc(int b, int& R, int& C) { const int st = b / 1024, sb = b % 1024, swz = sb ^ (((sb >> 9) & 1) << 5); R = (st >> 1) * 16 + swz / 64; C = (st & 1) * 32 + (swz % 64) / 2; }
__host__ __device__ __forceinline__ int perm32(int rho) { const int n = rho >> 4, i = rho & 15; return 8 * (i >> 2) + 4 * n + (i & 3); }
struct Unit { int pm, pn; };
struct Gemm { const bf16_t* A; const bf16_t* Bt; int M, N, K, lda; };
struct StaticOrder {
    int nM, nN, nwg, G, c;
    __device__ void init(int M, int N, int G_, int c_) { nM = M / BM; nN = N / BM; nwg = nM * nN; G = G_; c = c_; }
    __device__ bool next(int i, Unit& u) const {
        const long L = (long)i * G + c; if (L >= nwg) return false;
        int wgid = (int)L; { const int q = nwg / NXCD, r = nwg % NXCD, xcd = wgid % NXCD, off = wgid / NXCD; wgid = (xcd < r ? xcd * (q + 1) : r * (q + 1) + (xcd - r) * q) + off; }
        const int nig = WGM * nN, gid = wgid / nig, fm = gid * WGM, gsz = (nM - fm) < WGM ? (nM - fm) : WGM;
        u.pm = fm + ((wgid % nig) % gsz); u.pn = (wgid % nig) / gsz; return true;
    }
};

template <int ACT, int STATS> struct EpiStore {
    static constexpr bool PERM = true;
    bf16_t* O; int ldc; const float* ss; float inv_n;
    __device__ __forceinline__ void operator()(const f32x4 (&acc)[2][2][4][2], const Unit& u, int wr, int wc, int fr, int fq) const {
        const int row0 = u.pm * BM + wr * 64 + fr, col0 = u.pn * BM + wc * 32 + 8 * fq;
#pragma unroll
        for (int ai = 0; ai < 2; ++ai)
#pragma unroll
            for (int m = 0; m < 4; ++m) {
                const int row = row0 + ai * HALF + m * 16;
                float rs = 1.0f;
                if (ss) { const f32x4* sp = (const f32x4*)(ss + (size_t)row * 16); const f32x4 a = sp[0], b = sp[1], c = sp[2], d = sp[3];
                    const float t = (((a[0] + a[1]) + (a[2] + a[3])) + ((b[0] + b[1]) + (b[2] + b[3]))) + (((c[0] + c[1]) + (c[2] + c[3])) + ((d[0] + d[1]) + (d[2] + d[3])));
                    rs = rsqrtf(t * inv_n + EPS); }
#pragma unroll
                for (int bj = 0; bj < 2; ++bj) {
                    f32x4 v0 = acc[ai][bj][m][0] * rs, v1 = acc[ai][bj][m][1] * rs;
                    if (ACT == 1) {
#pragma unroll
                        for (int e = 0; e < 4; ++e) { const float a = fmaxf(v0[e], 0.f), b = fmaxf(v1[e], 0.f); v0[e] = a * a; v1[e] = b * b; }
                    }
                    if (ACT == 2) {
#pragma unroll
                        for (int e = 0; e < 4; ++e) { v0[e] = gelu_tanh(v0[e]); v1[e] = gelu_tanh(v1[e]); }
                    }
                    if (ACT == 3) {
#pragma unroll
                        for (int e = 0; e < 4; ++e) { v0[e] = sigmoidf_(v0[e]); v1[e] = sigmoidf_(v1[e]); }
                    }
                    u32x4 w; w.x = cvt_pk_bf16(v0[0], v0[1]); w.y = cvt_pk_bf16(v0[2], v0[3]); w.z = cvt_pk_bf16(v1[0], v1[1]); w.w = cvt_pk_bf16(v1[2], v1[3]);
                    *(u32x4*)(O + (size_t)row * ldc + col0 + bj * HALF) = w;
                }
                asm volatile("" ::: "memory");
            }
    }
};
template <int MODE> struct EpiRes {
    static constexpr bool PERM = true;
    static constexpr int MB = (MODE == 1) ? 2 : 4;
    const float* hin32; float* hout32; bf16_t* hb; float* ssn; const bf16_t* pp;
    __device__ __forceinline__ void operator()(const f32x4 (&acc)[2][2][4][2], const Unit& u, int wr, int wc, int fr, int fq) const {
        const int row0 = u.pm * BM + wr * 64 + fr, col0 = u.pn * BM + wc * 32 + 8 * fq;
#pragma unroll
        for (int ai = 0; ai < 2; ++ai)
#pragma unroll
            for (int mg = 0; mg < 4; mg += MB) {
                f32x4 hv[MB][2][2]; u32x4 pw[MB][2];
#pragma unroll
                for (int mm = 0; mm < MB; ++mm)
#pragma unroll
                    for (int bj = 0; bj < 2; ++bj) {
                        const size_t off = (size_t)(row0 + ai * HALF + (mg + mm) * 16) * DM + col0 + bj * HALF;
                        if (hin32) { hv[mm][bj][0] = *(const f32x4*)(hin32 + off); hv[mm][bj][1] = *(const f32x4*)(hin32 + off + 4); }
                        else { const u32x4 b = *(const u32x4*)(hb + off); hv[mm][bj][0] = (f32x4){bflo(b.x), bfhi(b.x), bflo(b.y), bfhi(b.y)}; hv[mm][bj][1] = (f32x4){bflo(b.z), bfhi(b.z), bflo(b.w), bfhi(b.w)}; }
                        if (MODE == 1) pw[mm][bj] = *(const u32x4*)(pp + off);
                    }
#pragma unroll
                for (int mm = 0; mm < MB; ++mm) {
                    const int m = mg + mm, row = row0 + ai * HALF + m * 16;
                    float q = 0.f;
#pragma unroll
                    for (int bj = 0; bj < 2; ++bj) {
                        const size_t off = (size_t)row * DM + col0 + bj * HALF;
                        f32x4 v0 = acc[ai][bj][m][0], v1 = acc[ai][bj][m][1];
                        if (MODE == 1) {
                            const u32x4 g = pw[mm][bj];
                            v0[0] *= bflo(g.x); v0[1] *= bfhi(g.x); v0[2] *= bflo(g.y); v0[3] *= bfhi(g.y);
                            v1[0] *= bflo(g.z); v1[1] *= bfhi(g.z); v1[2] *= bflo(g.w); v1[3] *= bfhi(g.w);
                        }
                        v0 += hv[mm][bj][0]; v1 += hv[mm][bj][1];
                        if (hout32) { *(f32x4*)(hout32 + off) = v0; *(f32x4*)(hout32 + off + 4) = v1; }
                        else { u32x4 w; w.x = cvt_pk_bf16(v0[0], v0[1]); w.y = cvt_pk_bf16(v0[2], v0[3]); w.z = cvt_pk_bf16(v1[0], v1[1]); w.w = cvt_pk_bf16(v1[2], v1[3]);
                               *(u32x4*)(hb + off) = w; }
                        q += (v0[0] * v0[0] + v0[1] * v0[1]) + (v0[2] * v0[2] + v0[3] * v0[3]) + (v1[0] * v1[0] + v1[1] * v1[1]) + (v1[2] * v1[2] + v1[3] * v1[3]);
                    }
                    if (ssn) { q += __shfl_xor(q, 16); q += __shfl_xor(q, 32); if (fq == 0) ssn[(size_t)row * 16 + u.pn * 4 + wc] = q; }
                }
                asm volatile("" ::: "memory");
            }
    }
};

#ifndef PG8_SP2
#define PG8_SP2 true
#endif
#ifndef PG8_ALIGN
#define PG8_ALIGN true
#endif
template <class Epi, bool ALIGN_EPI = PG8_ALIGN, bool SP2 = PG8_SP2>
__device__ __forceinline__ void gemm_phase(int tid, LAS unsigned char* lds, const Gemm g, const StaticOrder& S, const Epi& E) {
    const int wid = __builtin_amdgcn_readfirstlane(tid >> 6), lane = tid & 63, wr = wid >> 2, wc = wid & 3, fr = lane & 15, fq = lane >> 4;
    const int K = g.K, nt = K / BK, lda = g.lda;
    unsigned voffA[2], voffB[2];
#pragma unroll
    for (int i = 0; i < 2; ++i) { int R, C; stage_rc(tid * 16 + i * 8192, R, C); const int Rb = Epi::PERM ? ((R & ~31) + perm32(R & 31)) : R;
        voffA[i] = (unsigned)(R * lda + C) * 2u; voffB[i] = (unsigned)(Rb * K + C) * 2u; }
    const size_t kstep = (size_t)(BK * 2);
    const size_t hstepA = (size_t)HALF * lda * 2, hstepB = (size_t)HALF * K * 2;
    const size_t tstepA = 2 * hstepA, tstepB = 2 * hstepB;
    const unsigned ldsw = (unsigned)wid * 1024u;
    const int aoff = lds_byte(wr * 64 + fr, fq * 8), boff = lds_byte(wc * 32 + fr, fq * 8);
#define PG8_SA(b, h) (((b) * 2 + (h)) * HTB)
#define PG8_SB(b, h) ((4 + (b) * 2 + (h)) * HTB)
#define PG8_STAGE(bufoff, gbase, voff) do { _Pragma("unroll") for (int _i = 0; _i < 2; ++_i) \
        __builtin_amdgcn_global_load_lds((const unsigned*)((const char*)(gbase) + (voff)[_i]), (LAS unsigned*)(lds + (bufoff) + ldsw + _i * 8192), 16, 0, 0); } while (0)
#define PG8_LDA(dst, b, h) do { _Pragma("unroll") for (int m = 0; m < 4; ++m) _Pragma("unroll") for (int k = 0; k < 2; ++k) dst[m][k] = *(const LAS bf16x8*)(lds + PG8_SA(b, h) + aoff + m * 2048 + k * 1024); } while (0)
#define PG8_LDB(dst, b, h) do { _Pragma("unroll") for (int n = 0; n < 2; ++n) _Pragma("unroll") for (int k = 0; k < 2; ++k) dst[n][k] = *(const LAS bf16x8*)(lds + PG8_SB(b, h) + boff + n * 2048 + k * 1024); } while (0)
#define PG8_MMA(ai, bj, At, Bt) do { __builtin_amdgcn_s_setprio(1); _Pragma("unroll") for (int m = 0; m < 4; ++m) _Pragma("unroll") for (int n = 0; n < 2; ++n) _Pragma("unroll") for (int k = 0; k < 2; ++k) \
        acc[ai][bj][m][n] = __builtin_amdgcn_mfma_f32_16x16x32_bf16(Bt[n][k], At[m][k], acc[ai][bj][m][n], 0, 0, 0); __builtin_amdgcn_s_setprio(0); } while (0)
#define PG8_WAIT_V(n) asm volatile("s_waitcnt vmcnt(" #n ")" ::: "memory")
#define PG8_WAIT_L(n) asm volatile("s_waitcnt lgkmcnt(" #n ")" ::: "memory")
#define PG8_BAR __builtin_amdgcn_s_barrier()
#define PG8_SCHED __builtin_amdgcn_sched_barrier(0)
    Unit cur, nxt; int ui = 0;
    if (!S.next(0, cur)) return;
    f32x4 acc[2][2][4][2];
#pragma unroll
    for (int a = 0; a < 2; ++a)
#pragma unroll
        for (int b = 0; b < 2; ++b)
#pragma unroll
            for (int m = 0; m < 4; ++m)
#pragma unroll
                for (int n = 0; n < 2; ++n) acc[a][b][m][n] = (f32x4){0.f, 0.f, 0.f, 0.f};
    bf16x8 At[4][2], B0[2][2], B1[2][2];
    const char* cA = (const char*)g.A + (size_t)cur.pm * tstepA; const char* cB = (const char*)g.Bt + (size_t)cur.pn * tstepB;
    if constexpr (SP2) {
    PG8_STAGE(PG8_SB(0, 0), cB, voffB); PG8_STAGE(PG8_SB(0, 1), cB + hstepB, voffB); PG8_STAGE(PG8_SA(0, 0), cA, voffA); PG8_STAGE(PG8_SA(0, 1), cA + hstepA, voffA);
    if (wr == 1) PG8_BAR;
    PG8_WAIT_V(2); PG8_BAR;
    PG8_STAGE(PG8_SB(1, 0), cB + kstep, voffB); PG8_STAGE(PG8_SA(1, 0), cA + kstep, voffA); PG8_STAGE(PG8_SB(1, 1), cB + hstepB + kstep, voffB);
    PG8_WAIT_V(6); PG8_BAR;
    } else {
    PG8_STAGE(PG8_SB(0, 0), cB, voffB); PG8_STAGE(PG8_SA(0, 0), cA, voffA); PG8_STAGE(PG8_SB(0, 1), cB + hstepB, voffB); PG8_STAGE(PG8_SA(0, 1), cA + hstepA, voffA);
    if (wr == 1) PG8_BAR;
    PG8_WAIT_V(4); PG8_BAR;
    PG8_STAGE(PG8_SB(1, 0), cB + kstep, voffB); PG8_STAGE(PG8_SA(1, 0), cA + kstep, voffA); PG8_STAGE(PG8_SB(1, 1), cB + hstepB + kstep, voffB);
    PG8_WAIT_V(6); PG8_BAR;
    }
    for (;;) {
        const bool has_next = S.next(ui + 1, nxt);
        const char* nA = has_next ? (const char*)g.A + (size_t)nxt.pm * tstepA : cA; const char* nB = has_next ? (const char*)g.Bt + (size_t)nxt.pn * tstepB : cB;
        for (int t = 0; t < nt; t += 2) {
            const bool last = (t == nt - 2);
            const char* a1 = cA + (size_t)(t + 1) * kstep;
            const char* a2 = last ? nA : cA + (size_t)(t + 2) * kstep; const char* b2 = last ? nB : cB + (size_t)(t + 2) * kstep;
            const char* a3 = a2 + kstep; const char* b3 = b2 + kstep;
            if constexpr (SP2) {
            PG8_LDB(B0, 0, 0); PG8_LDB(B1, 0, 1); PG8_SCHED; PG8_LDA(At, 0, 0); PG8_STAGE(PG8_SA(1, 1), a1 + hstepA, voffA);
            PG8_WAIT_V(8); PG8_WAIT_L(0); PG8_BAR; PG8_MMA(0, 0, At, B0); PG8_MMA(0, 1, At, B1); PG8_BAR; PG8_SCHED;
            PG8_LDA(At, 0, 1); PG8_STAGE(PG8_SB(0, 0), b2, voffB); PG8_STAGE(PG8_SB(0, 1), b2 + hstepB, voffB); PG8_STAGE(PG8_SA(0, 0), a2, voffA);
            PG8_WAIT_V(8); PG8_WAIT_L(0); PG8_BAR; PG8_MMA(1, 0, At, B0); PG8_MMA(1, 1, At, B1); PG8_BAR; PG8_SCHED;
            PG8_LDB(B0, 1, 0); PG8_LDB(B1, 1, 1); PG8_SCHED; PG8_LDA(At, 1, 0); PG8_STAGE(PG8_SA(0, 1), a2 + hstepA, voffA);
            PG8_WAIT_V(8); PG8_WAIT_L(0); PG8_BAR; PG8_MMA(0, 0, At, B0); PG8_MMA(0, 1, At, B1); PG8_BAR; PG8_SCHED;
            PG8_LDA(At, 1, 1); PG8_STAGE(PG8_SB(1, 0), b3, voffB); PG8_STAGE(PG8_SB(1, 1), b3 + hstepB, voffB); PG8_STAGE(PG8_SA(1, 0), a3, voffA);
            PG8_WAIT_V(8); PG8_WAIT_L(0); PG8_BAR; PG8_MMA(1, 0, At, B0); PG8_MMA(1, 1, At, B1); PG8_BAR; PG8_SCHED;
            } else {
            PG8_LDB(B0, 0, 0); PG8_SCHED; PG8_LDA(At, 0, 0); PG8_STAGE(PG8_SA(1, 1), a1 + hstepA, voffA);
            PG8_WAIT_L(8); PG8_BAR; PG8_WAIT_L(0); PG8_MMA(0, 0, At, B0); PG8_BAR; PG8_SCHED;
            PG8_LDB(B1, 0, 1); PG8_STAGE(PG8_SB(0, 0), b2, voffB);
            PG8_BAR; PG8_WAIT_L(0); PG8_MMA(0, 1, At, B1); PG8_BAR;
            PG8_LDA(At, 0, 1); PG8_STAGE(PG8_SA(0, 0), a2, voffA);
            PG8_BAR; PG8_WAIT_L(0); PG8_MMA(1, 0, At, B0); PG8_BAR; PG8_SCHED;
            PG8_STAGE(PG8_SB(0, 1), b2 + hstepB, voffB);
            PG8_WAIT_V(6); PG8_BAR; PG8_MMA(1, 1, At, B1); PG8_BAR;
            PG8_LDB(B0, 1, 0); PG8_SCHED; PG8_LDA(At, 1, 0); PG8_STAGE(PG8_SA(0, 1), a2 + hstepA, voffA);
            PG8_WAIT_L(8); PG8_BAR; PG8_WAIT_L(0); PG8_MMA(0, 0, At, B0); PG8_BAR; PG8_SCHED;
            PG8_LDB(B1, 1, 1); PG8_STAGE(PG8_SB(1, 0), b3, voffB);
            PG8_BAR; PG8_WAIT_L(0); PG8_MMA(0, 1, At, B1); PG8_BAR;
            PG8_LDA(At, 1, 1); PG8_STAGE(PG8_SA(1, 0), a3, voffA);
            PG8_BAR; PG8_WAIT_L(0); PG8_MMA(1, 0, At, B0); PG8_BAR; PG8_SCHED;
            PG8_STAGE(PG8_SB(1, 1), b3 + hstepB, voffB);
            PG8_WAIT_V(6); PG8_BAR; PG8_MMA(1, 1, At, B1); PG8_BAR;
            }
        }
        if constexpr (ALIGN_EPI) { if (wr == 0) PG8_BAR; }
        E(acc, cur, wr, wc, fr, fq);
        if (!has_next) break;
#pragma unroll
        for (int a = 0; a < 2; ++a)
#pragma unroll
            for (int b = 0; b < 2; ++b)
#pragma unroll
                for (int m = 0; m < 4; ++m)
#pragma unroll
                    for (int n = 0; n < 2; ++n) acc[a][b][m][n] = (f32x4){0.f, 0.f, 0.f, 0.f};
        cur = nxt; cA = nA; cB = nB; ++ui;
        if constexpr (ALIGN_EPI) { if (wr == 1) PG8_BAR; }
    }
    PG8_WAIT_V(0);
    if constexpr (!ALIGN_EPI) { if (wr == 0) PG8_BAR; }
    PG8_BAR;
#undef PG8_SA
#undef PG8_SB
#undef PG8_STAGE
#undef PG8_LDA
#undef PG8_LDB
#undef PG8_MMA
#undef PG8_WAIT_V
#undef PG8_WAIT_L
#undef PG8_BAR
#undef PG8_SCHED
}
}

__constant__ double kInvFreq[32] = {
    1.0, 0.7498942093324559, 0.5623413251903491, 0.4216965034285822, 0.31622776601683794, 0.23713737056616552, 0.1778279410038923, 0.1333521432163324,
    0.1, 0.07498942093324558, 0.05623413251903491, 0.04216965034285822, 0.03162277660168379, 0.023713737056616554, 0.01778279410038923, 0.01333521432163324,
    0.01, 0.007498942093324558, 0.005623413251903491, 0.004216965034285823, 0.0031622776601683794, 0.0023713737056616554, 0.001778279410038923, 0.001333521432163324,
    0.001, 0.0007498942093324559, 0.0005623413251903491, 0.0004216965034285823, 0.00031622776601683794, 0.00023713737056616554, 0.0001778279410038923, 0.0001333521432163324};

__device__ __forceinline__ float wave_sum(float v) {
#pragma unroll
    for (int o = 1; o < 64; o <<= 1) v += __shfl_xor(v, o);
    return v;
}
__device__ __forceinline__ void unpack8(const u32x4 w, float (&f)[8]) { f[0] = bflo(w.x); f[1] = bfhi(w.x); f[2] = bflo(w.y); f[3] = bfhi(w.y); f[4] = bflo(w.z); f[5] = bfhi(w.z); f[6] = bflo(w.w); f[7] = bfhi(w.w); }
__device__ __forceinline__ u32x4 pack8(const float (&f)[8]) { u32x4 w; w.x = cvt_pk_bf16(f[0], f[1]); w.y = cvt_pk_bf16(f[2], f[3]); w.z = cvt_pk_bf16(f[4], f[5]); w.w = cvt_pk_bf16(f[6], f[7]); return w; }

struct WDesc { const float* W; const float* gamma; bf16_t* dst; int K, N, Npad, mode, items; };
__device__ __forceinline__ WDesc wdesc(const Params& P, int id) {
    WDesc d; bf16_t* wb = (bf16_t*)(P.ws + OFF_W); d.gamma = nullptr; d.mode = 0;
    if (id < 12) {
        const int j = id & 1, f = id >> 1;
        switch (f) {
            case 0: d.W = P.in[6] + (size_t)j * DM * 704; d.K = DM; d.N = 704; d.Npad = LATP; d.dst = wb + WE_DOWN + (size_t)j * LATP * DM; d.gamma = P.in[3] + (2 * j) * DM; break;
            case 1: d.W = P.in[9] + (size_t)j * QLR * QP; d.K = QLR; d.N = QP; d.Npad = QP; d.dst = wb + WE_UQ + (size_t)j * QP * QLR; d.gamma = P.in[7] + j * QLR; d.mode = 1; break;
            case 2: d.W = P.in[10] + (size_t)j * KVLR * KVP; d.K = KVLR; d.N = KVP; d.Npad = KVP; d.dst = wb + WE_UKV + (size_t)j * KVP * KVLR; d.gamma = P.in[8] + j * KVLR; break;
            case 3: d.W = P.in[15] + (size_t)j * DM * DM; d.K = DM; d.N = DM; d.Npad = DM; d.dst = wb + WE_MOUT + (size_t)j * DM * DM; break;
            case 4: d.W = P.in[16] + (size_t)j * DM * ZP; d.K = DM; d.N = ZP; d.Npad = ZP; d.dst = wb + WE_GIN + (size_t)j * ZP * DM; d.gamma = P.in[3] + (2 * j + 1) * DM; break;
            default: d.W = P.in[21] + (size_t)j * 2048 * DM; d.K = 2048; d.N = DM; d.Npad = DM; d.dst = wb + WE_GOUT + (size_t)j * DM * 2048; break;
        }
    } else {
        const int i = (id - 12) & 3, f = (id - 12) >> 2;
        switch (f) {
            case 0: d.W = P.in[22] + (size_t)i * DM * DFF; d.K = DM; d.N = DFF; d.Npad = DFF; d.dst = wb + WE_UP + (size_t)i * DFF * DM; d.gamma = P.in[4] + i * DM; break;
            case 1: d.W = P.in[23] + (size_t)i * DFF * DM; d.K = DFF; d.N = DM; d.Npad = DM; d.dst = wb + WE_DN + (size_t)i * DM * DFF; break;
            case 2: d.W = P.in[24] + (size_t)i * DM * DM; d.K = DM; d.N = DM; d.Npad = DM; d.dst = wb + WE_GATE + (size_t)i * DM * DM; d.gamma = P.in[5] + i * DM; break;
            default: d.W = P.in[25] + (size_t)i * PLE * DM; d.K = PLE; d.N = DM; d.Npad = DM; d.dst = wb + WE_PROJ + (size_t)i * DM * PLE; break;
        }
    }
    d.items = (d.K / 64) * (d.Npad / 32);
    return d;
}
__device__ __forceinline__ void conv_item(const WDesc& d, int item, float* scr, int lane) {
    const int nblk = d.Npad / 32, kb = item / nblk, nb = item % nblk, k0 = 64 * kb, n0 = 32 * nb;
    int sn0 = n0;
    if (d.mode == 1) { if (n0 < 1024) sn0 = (n0 >> 7) * 192 + (n0 & 127); else { const int r = n0 - 1024; sn0 = (r >> 6) * 192 + 128 + (r & 63); } }
    const bool valid = sn0 < d.N;
#pragma unroll
    for (int i = 0; i < 32; ++i) { const int kk = 2 * i + (lane >> 5);
        float v = valid ? d.W[(size_t)(k0 + kk) * d.N + sn0 + (lane & 31)] : 0.f;
        if (d.gamma) v *= d.gamma[k0 + kk];
        scr[kk * 33 + (lane & 31)] = v; }
    asm volatile("s_waitcnt lgkmcnt(0)" ::: "memory");
    const int c = lane & 7;
#pragma unroll
    for (int j = 0; j < 4; ++j) { const int n = (lane >> 3) + 8 * j; const float* s = scr + (8 * c) * 33 + n;
        u32x4 o; o.x = cvt_pk_bf16(s[0 * 33], s[1 * 33]); o.y = cvt_pk_bf16(s[2 * 33], s[3 * 33]); o.z = cvt_pk_bf16(s[4 * 33], s[5 * 33]); o.w = cvt_pk_bf16(s[6 * 33], s[7 * 33]);
        *(u32x4*)(d.dst + (size_t)(n0 + n) * d.K + k0 + 8 * c) = o; }
    asm volatile("s_waitcnt lgkmcnt(0)" ::: "memory");
}
__device__ __forceinline__ void p0_prologue(int tid, const Params& P, unsigned char* lds) {
    const int lane = tid & 63, wave = __builtin_amdgcn_readfirstlane(tid >> 6);
    const int gw = blockIdx.x * 8 + wave, NGW = gridDim.x * 8;
    const size_t gt = (size_t)blockIdx.x * 512 + tid, NGT = (size_t)gridDim.x * 512;
    float* scr = (float*)(lds + wave * 8704);
    int total = 0;
    for (int id = 0; id < 28; ++id) total += wdesc(P, id).items;
    for (int it = gw; it < total; it += NGW) {
        int r = it, id = 0; WDesc d = wdesc(P, 0);
        while (r >= d.items) { r -= d.items; ++id; d = wdesc(P, id); }
        conv_item(d, r, scr, lane);
    }
    { unsigned* bw = (unsigned*)(P.ws + OFF_BAR); for (size_t i = gt; i < XCD_BAR_WORDS; i += NGT) bw[i] = 0u; }
    { const f32x4* src = (const f32x4*)P.in[1]; u32x4* dst = (u32x4*)(P.ws + OFF_PB); const size_t n8 = (size_t)DEPTH * T * PLE / 8;
      for (size_t i0 = gt; i0 < n8; i0 += 4 * NGT) {
          f32x4 a[4], b[4];
#pragma unroll
          for (int u = 0; u < 4; ++u) { const size_t i = i0 + u * NGT; if (i < n8) { a[u] = src[2 * i]; b[u] = src[2 * i + 1]; } }
#pragma unroll
          for (int u = 0; u < 4; ++u) { const size_t i = i0 + u * NGT; if (i < n8) { u32x4 w; w.x = cvt_pk_bf16(a[u][0], a[u][1]); w.y = cvt_pk_bf16(a[u][2], a[u][3]); w.z = cvt_pk_bf16(b[u][0], b[u][1]); w.w = cvt_pk_bf16(b[u][2], b[u][3]); dst[i] = w; } } } }
    { float* ssp = (float*)(P.ws + OFF_SS); bf16_t* hb = (bf16_t*)(P.ws + OFF_HB);
#pragma unroll 2
      for (int row = gw; row < T; row += NGW) {
          const f32x4* xr = (const f32x4*)(P.in[0] + (size_t)row * DM) + lane; float s = 0.f;
          unsigned long long* o8 = (unsigned long long*)(hb + (size_t)row * DM) + lane;
#pragma unroll
          for (int j = 0; j < 4; ++j) { const f32x4 v = xr[64 * j]; s += (v[0] * v[0] + v[1] * v[1]) + (v[2] * v[2] + v[3] * v[3]);
              o8[64 * j] = (unsigned long long)cvt_pk_bf16(v[0], v[1]) | ((unsigned long long)cvt_pk_bf16(v[2], v[3]) << 32); }
          s = wave_sum(s); if (lane < 16) ssp[(size_t)row * 16 + lane] = (lane == 0) ? s : 0.f; } }
}

__device__ __forceinline__ void r2_phase(int tid, const Params& P, int j) {
    const int lane = tid & 63, wave = __builtin_amdgcn_readfirstlane(tid >> 6);
    const int gw = blockIdx.x * 8 + wave, NGW = gridDim.x * 8;
    bf16_t* Q = (bf16_t*)(P.ws + OFF_FF + FF_Q); bf16_t* KV = (bf16_t*)(P.ws + OFF_FF + FF_KV); bf16_t* LAT = (bf16_t*)(P.ws + OFF_FF + FF_LAT);
    const float* gqn = P.in[11] + j * 128; const float* gqr = P.in[12] + j * 64; const float* gkn = P.in[13] + j * 128; const float* gkr = P.in[14] + j * 64;
    const int* pos = (const int*)P.in[2];
    float g_qn[2][8], g_kn[2][8], g_qr[8], g_kr[8];
#pragma unroll
    for (int i = 0; i < 2; ++i)
#pragma unroll
        for (int e = 0; e < 8; ++e) { const int d = (8 * lane + 512 * i + e) & 127; g_qn[i][e] = gqn[d] * QSCALE; g_kn[i][e] = gkn[d]; }
#pragma unroll
    for (int e = 0; e < 8; ++e) { const int r = 8 * (lane & 7) + e; g_qr[e] = gqr[r] * QSCALE; g_kr[e] = gkr[r]; }
    const double invf = kInvFreq[lane & 31];
#pragma unroll 2
    for (int row = gw; row < T; row += NGW) {
        float rq, rkv;
        { u32x4 z4 = {0u, 0u, 0u, 0u};
          const u32x4 lq = (lane < 48) ? *(const u32x4*)(LAT + (size_t)row * LATP + 8 * lane) : z4;
          const u32x4 lk = (lane < 32) ? *(const u32x4*)(LAT + (size_t)row * LATP + QLR + 8 * lane) : z4;
          float a[8], b[8]; unpack8(lq, a); unpack8(lk, b); float sa = 0.f, sb = 0.f;
#pragma unroll
          for (int e = 0; e < 8; ++e) { sa += a[e] * a[e]; sb += b[e] * b[e]; }
          rq = rsqrtf(wave_sum(sa) * (1.0f / QLR) + EPS); rkv = rsqrtf(wave_sum(sb) * (1.0f / KVLR) + EPS); }
        const double ang = (double)pos[row] * invf; double rev = ang * 0.15915494309189535; rev -= floor(rev);
        const float cs = __builtin_amdgcn_cosf((float)rev), sn = __builtin_amdgcn_sinf((float)rev);
        float cj[8], sj[8];
#pragma unroll
        for (int e = 0; e < 8; ++e) { cj[e] = __shfl(cs, 8 * (lane & 3) + e); sj[e] = __shfl(sn, 8 * (lane & 3) + e); }
#pragma unroll
        for (int i = 0; i < 2; ++i) {
            const int idx = 8 * lane + 512 * i, head = idx >> 7, d = idx & 127;
            u32x4* qp = (u32x4*)(Q + (size_t)row * QP + idx); u32x4* kp = (u32x4*)(KV + (size_t)row * KVP + head * 256 + d);
            float a[8], b[8]; unpack8(*qp, a); unpack8(*kp, b);
            { u32x4* vp = (u32x4*)(KV + (size_t)row * KVP + head * 256 + 128 + d); float vv[8]; unpack8(*vp, vv);
#pragma unroll
              for (int e = 0; e < 8; ++e) vv[e] *= rkv;
              *vp = pack8(vv); }
            float sa = 0.f, sb = 0.f;
#pragma unroll
            for (int e = 0; e < 8; ++e) { a[e] *= rq; b[e] *= rkv; sa += a[e] * a[e]; sb += b[e] * b[e]; }
#pragma unroll
            for (int o = 1; o < 16; o <<= 1) { sa += __shfl_xor(sa, o); sb += __shfl_xor(sb, o); }
            const float ra = rsqrtf(sa * (1.0f / 128) + EPS), rb = rsqrtf(sb * (1.0f / 128) + EPS);
#pragma unroll
            for (int e = 0; e < 8; ++e) { a[e] = a[e] * ra * g_qn[i][e]; b[e] = b[e] * rb * g_kn[i][e]; }
            *qp = pack8(a); *kp = pack8(b);
        }
        {
            u32x4* qp = (u32x4*)(Q + (size_t)row * QP + 1024 + 8 * lane); u32x4* kp = (u32x4*)(LAT + (size_t)row * LATP + 640 + 8 * (lane & 7));
            float a[8], b[8]; unpack8(*qp, a); unpack8(*kp, b);
            float sa = 0.f, sb = 0.f;
#pragma unroll
            for (int e = 0; e < 8; ++e) { a[e] *= rq; sa += a[e] * a[e]; sb += b[e] * b[e]; }
#pragma unroll
            for (int o = 1; o < 8; o <<= 1) { sa += __shfl_xor(sa, o); sb += __shfl_xor(sb, o); }
            const float ra = rsqrtf(sa * (1.0f / 64) + EPS), rb = rsqrtf(sb * (1.0f / 64) + EPS);
            const bool hi = (lane & 4) != 0;
#pragma unroll
            for (int e = 0; e < 8; ++e) {
                const float ya = a[e] * ra * g_qr[e], yb = b[e] * rb * g_kr[e];
                const float pa = __shfl_xor(ya, 4), pb = __shfl_xor(yb, 4);
                a[e] = hi ? (ya * cj[e] + pa * sj[e]) : (ya * cj[e] - pa * sj[e]);
                b[e] = hi ? (yb * cj[e] + pb * sj[e]) : (yb * cj[e] - pb * sj[e]);
            }
            *qp = pack8(a); if (lane < 8) *kp = pack8(b);
        }
    }
}

constexpr int KROW = 400, VROW = 288, KTILE = 64 * KROW, VTILE = 64 * VROW;
__device__ __forceinline__ void attn_unit(int tid, unsigned char* lds, const bf16_t* Q, const bf16_t* KV, const bf16_t* KR, bf16_t* O, int b, int h, int qb) {
    const int lane = tid & 63, w = __builtin_amdgcn_readfirstlane(tid >> 6), r = lane & 15, g = lane >> 4;
    const int row0 = b * SEQ + qb * 256, qrow = row0 + 32 * w + r;
    bf16x8 qf[2][6];
#pragma unroll
    for (int rg = 0; rg < 2; ++rg) {
#pragma unroll
        for (int ks = 0; ks < 4; ++ks) qf[rg][ks] = *(const bf16x8*)(Q + (size_t)(qrow + 16 * rg) * QP + h * 128 + 32 * ks + 8 * g);
#pragma unroll
        for (int ks = 0; ks < 2; ++ks) qf[rg][4 + ks] = *(const bf16x8*)(Q + (size_t)(qrow + 16 * rg) * QP + 1024 + h * 64 + 32 * ks + 8 * g);
    }
    const int ntiles = 4 * qb + 4, last_tile = 4 * qb + (w >> 1);
    const int kn_row0 = tid >> 4, kn_ch = tid & 15;
    const int kr_row = tid >> 3, kr_ch = tid & 7;
    const bf16_t* gk = KV + (size_t)(b * SEQ) * KVP + h * 256;
    const bf16_t* gr = KR + (size_t)(b * SEQ) * LATP;
    u32x4 sk0, sk1, sr, sv0, sv1;
#define ATT_LOAD(t) do { const size_t kb = (size_t)(t) * 64; \
        sk0 = *(const u32x4*)(gk + (kb + kn_row0) * KVP + kn_ch * 8); sk1 = *(const u32x4*)(gk + (kb + kn_row0 + 32) * KVP + kn_ch * 8); \
        sv0 = *(const u32x4*)(gk + (kb + kn_row0) * KVP + 128 + kn_ch * 8); sv1 = *(const u32x4*)(gk + (kb + kn_row0 + 32) * KVP + 128 + kn_ch * 8); \
        sr = *(const u32x4*)(gr + (kb + kr_row) * LATP + kr_ch * 8); } while (0)
#define ATT_STORE(buf) do { unsigned char* kb_ = lds + (buf) * KTILE; unsigned char* vb_ = lds + 2 * KTILE + (buf) * VTILE; \
        *(u32x4*)(kb_ + kn_row0 * KROW + kn_ch * 16) = sk0; *(u32x4*)(kb_ + (kn_row0 + 32) * KROW + kn_ch * 16) = sk1; \
        *(u32x4*)(kb_ + kr_row * KROW + 256 + kr_ch * 16) = sr; \
        *(u32x4*)(vb_ + kn_row0 * VROW + kn_ch * 16) = sv0; *(u32x4*)(vb_ + (kn_row0 + 32) * VROW + kn_ch * 16) = sv1; } while (0)
    f32x4 o[2][8];
#pragma unroll
    for (int rg = 0; rg < 2; ++rg)
#pragma unroll
        for (int i = 0; i < 8; ++i) o[rg][i] = (f32x4){0.f, 0.f, 0.f, 0.f};
    float m[2] = {-1e30f, -1e30f}, l[2] = {0.f, 0.f};
    ATT_LOAD(0); ATT_STORE(0);
    __syncthreads();
    const int q4 = r >> 2, p4 = lane & 3;
    const int vtr_off = (4 * g + q4) * VROW + (4 * p4) * 2;
    const int qidx = qb * 256 + 32 * w + r;
    for (int t = 0; t < ntiles; ++t) {
        const bool more = (t + 1 < ntiles);
        if (more) ATT_LOAD(t + 1);
        if (t <= last_tile) {
            const unsigned char* Kb = lds + (t & 1) * KTILE; const unsigned char* Vb = lds + 2 * KTILE + (t & 1) * VTILE;
            f32x4 p[2][4];
#pragma unroll
            for (int kb = 0; kb < 4; ++kb) {
                p[0][kb] = (f32x4){0.f, 0.f, 0.f, 0.f}; p[1][kb] = (f32x4){0.f, 0.f, 0.f, 0.f};
#pragma unroll
                for (int ks = 0; ks < 6; ++ks) {
                    const bf16x8 a = *(const bf16x8*)(Kb + (16 * kb + r) * KROW + ks * 64 + g * 16);
                    p[0][kb] = __builtin_amdgcn_mfma_f32_16x16x32_bf16(a, qf[0][ks], p[0][kb], 0, 0, 0);
                    p[1][kb] = __builtin_amdgcn_mfma_f32_16x16x32_bf16(a, qf[1][ks], p[1][kb], 0, 0, 0);
                }
            }
            const bool diag = (t * 64 + 63 > qb * 256 + 32 * w);
            bf16x8 pb[2][2];
#pragma unroll
            for (int rg = 0; rg < 2; ++rg) {
                if (diag) {
#pragma unroll
                    for (int kb = 0; kb < 4; ++kb)
#pragma unroll
                        for (int i = 0; i < 4; ++i) { const int kk = t * 64 + 16 * kb + 4 * g + i; if (kk > qidx + 16 * rg) p[rg][kb][i] = -1e30f; }
                }
                float mx = fmaxf(fmaxf(p[rg][0][0], p[rg][0][1]), fmaxf(p[rg][0][2], p[rg][0][3]));
#pragma unroll
                for (int kb = 1; kb < 4; ++kb) mx = fmaxf(mx, fmaxf(fmaxf(p[rg][kb][0], p[rg][kb][1]), fmaxf(p[rg][kb][2], p[rg][kb][3])));
                mx = fmaxf(mx, __shfl_xor(mx, 16)); mx = fmaxf(mx, __shfl_xor(mx, 32));
                if (!__all(mx <= m[rg] + 8.0f)) {
                    const float mn = fmaxf(m[rg], mx), alpha = fast_exp2(m[rg] - mn); m[rg] = mn;
                    l[rg] *= alpha;
#pragma unroll
                    for (int i = 0; i < 8; ++i) o[rg][i] *= alpha;
                }
                const float mref = m[rg];
                float rsum = 0.f;
#pragma unroll
                for (int kb = 0; kb < 4; ++kb)
#pragma unroll
                    for (int i = 0; i < 4; ++i) { p[rg][kb][i] = fast_exp2(p[rg][kb][i] - mref); rsum += p[rg][kb][i]; }
                l[rg] += rsum;
#pragma unroll
                for (int kk = 0; kk < 2; ++kk) {
                    u32x4 pw; pw.x = cvt_pk_bf16(p[rg][2 * kk][0], p[rg][2 * kk][1]); pw.y = cvt_pk_bf16(p[rg][2 * kk][2], p[rg][2 * kk][3]);
                    pw.z = cvt_pk_bf16(p[rg][2 * kk + 1][0], p[rg][2 * kk + 1][1]); pw.w = cvt_pk_bf16(p[rg][2 * kk + 1][2], p[rg][2 * kk + 1][3]);
                    pb[rg][kk] = __builtin_bit_cast(bf16x8, pw);
                }
            }
#pragma unroll
            for (int db = 0; db < 8; ++db)
#pragma unroll
                for (int kk = 0; kk < 2; ++kk) {
                    const LAS unsigned char* vp = (const LAS unsigned char*)(Vb + vtr_off + (32 * kk) * VROW + db * 32);
                    const s16x4 lo = __builtin_bit_cast(s16x4, __builtin_amdgcn_ds_read_tr16_b64_v4i16((LAS s16x4*)vp));
                    const s16x4 hi = __builtin_bit_cast(s16x4, __builtin_amdgcn_ds_read_tr16_b64_v4i16((LAS s16x4*)(vp + 16 * VROW)));
                    const bf16x8 vf = __builtin_shufflevector(lo, hi, 0, 1, 2, 3, 4, 5, 6, 7);
                    o[0][db] = __builtin_amdgcn_mfma_f32_16x16x32_bf16(vf, pb[0][kk], o[0][db], 0, 0, 0);
                    o[1][db] = __builtin_amdgcn_mfma_f32_16x16x32_bf16(vf, pb[1][kk], o[1][db], 0, 0, 0);
                }
        }
        if (more) ATT_STORE((t + 1) & 1);
        __syncthreads();
    }
#pragma unroll
    for (int rg = 0; rg < 2; ++rg) {
        float ls = l[rg]; ls += __shfl_xor(ls, 16); ls += __shfl_xor(ls, 32);
        const float inv = fast_rcp(ls);
        bf16_t* orow = O + (size_t)(qrow + 16 * rg) * QP + h * 128 + 4 * g;
#pragma unroll
        for (int db = 0; db < 8; ++db) {
            u32x2 wv; wv.x = cvt_pk_bf16(o[rg][db][0] * inv, o[rg][db][1] * inv); wv.y = cvt_pk_bf16(o[rg][db][2] * inv, o[rg][db][3] * inv);
            *(u32x2*)(orow + 16 * db) = wv;
        }
    }
#undef ATT_LOAD
#undef ATT_STORE
}
__device__ __forceinline__ void attn_phase(int tid, const Params& P, unsigned char* lds) {
    bf16_t* Q = (bf16_t*)(P.ws + OFF_FF + FF_Q); const bf16_t* KV = (const bf16_t*)(P.ws + OFF_FF + FF_KV); const bf16_t* KR = (const bf16_t*)(P.ws + OFF_FF + FF_LAT) + 640;
    for (int pr = blockIdx.x; pr < 512; pr += gridDim.x) {
        const int bh = pr >> 2, x = pr & 3, b = bh >> 3, h = bh & 7;
        attn_unit(tid, lds, Q, KV, KR, Q, b, h, 7 - x);
        attn_unit(tid, lds, Q, KV, KR, Q, b, h, x);
    }
}

constexpr int SROW = 576;
constexpr int SGU_STAT_OFF = 128 * SROW;
constexpr int SGU_W_OFF = SGU_STAT_OFF + 2048, SWROW = 272;
__device__ __forceinline__ void sgu_phase(int tid, const Params& P, unsigned char* lds, int j) {
    const int lane = tid & 63, w = __builtin_amdgcn_readfirstlane(tid >> 6), r = lane & 31, hh = lane >> 5;
    bf16_t* Z = (bf16_t*)(P.ws + OFF_FF);
    const float* lng = P.in[17] + j * 2048; const float* lnb = P.in[18] + j * 2048;
    const float* wsp = P.in[19] + (size_t)j * 8 * 128 * 128; const float* bsp = P.in[20] + j * 8 * 128;
    const int q4 = (lane & 15) >> 2, p4 = lane & 3, colblk = (lane >> 4) & 1;
    f32x2* stl = (f32x2*)(lds + SGU_STAT_OFF);
    for (int unit = blockIdx.x; unit < 256; unit += gridDim.x) {
        const int row0 = unit * 128;
        for (int rr0 = 0; rr0 < 16; rr0 += 4) {
            u32x4 raw[4][4];
#pragma unroll
            for (int a = 0; a < 4; ++a)
#pragma unroll
                for (int i = 0; i < 4; ++i) raw[a][i] = *(const u32x4*)(Z + (size_t)(row0 + 16 * w + rr0 + a) * ZP + 2048 + 8 * lane + 512 * i);
#pragma unroll
            for (int a = 0; a < 4; ++a) {
                float s1 = 0.f, s2 = 0.f;
#pragma unroll
                for (int i = 0; i < 4; ++i) { float v[8]; unpack8(raw[a][i], v);
#pragma unroll
                    for (int e = 0; e < 8; ++e) { s1 += v[e]; s2 += v[e] * v[e]; } }
                s1 = wave_sum(s1); s2 = wave_sum(s2);
                const float mu = s1 * (1.0f / 2048), var = s2 * (1.0f / 2048) - mu * mu;
                if (lane == 0) stl[16 * w + rr0 + a] = (f32x2){mu, rsqrtf(fmaxf(var, 0.f) + EPS)};
            }
        }
        __syncthreads();
        for (int g = 0; g < 8; ++g) {
#pragma unroll 2
            for (int i = 0; i < 8; ++i) {
                const int chunk = tid + 512 * i, row = chunk >> 5, ch = chunk & 31, col = g * 256 + ch * 8;
                float v[8]; unpack8(*(const u32x4*)(Z + (size_t)(row0 + row) * ZP + 2048 + col), v);
                const f32x2 st = stl[row]; const float mu = st.x, rstd = st.y;
                const f32x4 g0 = *(const f32x4*)(lng + col), g1 = *(const f32x4*)(lng + col + 4), b0 = *(const f32x4*)(lnb + col), b1 = *(const f32x4*)(lnb + col + 4);
#pragma unroll
                for (int e = 0; e < 4; ++e) { v[e] = (v[e] - mu) * rstd * g0[e] + b0[e]; v[4 + e] = (v[4 + e] - mu) * rstd * g1[e] + b1[e]; }
                *(u32x4*)(lds + row * SROW + ch * 16) = pack8(v);
            }
            {
                const float* wg = wsp + (size_t)g * 128 * 128;
                f32x4 w0[4], w1[4];
#pragma unroll
                for (int i = 0; i < 4; ++i) { const int c = tid + 512 * i, t = c >> 4, s0 = (c & 15) * 8; w0[i] = *(const f32x4*)(wg + t * 128 + s0); w1[i] = *(const f32x4*)(wg + t * 128 + s0 + 4); }
#pragma unroll
                for (int i = 0; i < 4; ++i) { const int c = tid + 512 * i, t = c >> 4, s0 = (c & 15) * 8;
                    float wv[8] = {w0[i][0], w0[i][1], w0[i][2], w0[i][3], w1[i][0], w1[i][1], w1[i][2], w1[i][3]};
#pragma unroll
                    for (int e = 0; e < 8; ++e) if (s0 + e > t) wv[e] = 0.f;
                    *(u32x4*)(lds + SGU_W_OFF + t * SWROW + s0 * 2) = pack8(wv); }
            }
            __syncthreads();
            bf16x8 af[8];
#pragma unroll
            for (int ks = 0; ks < 8; ++ks) {
                const LAS unsigned char* vp = (const LAS unsigned char*)(lds + (16 * ks + 8 * hh + q4) * SROW + (32 * w + 16 * colblk + 4 * p4) * 2);
                const s16x4 lo = __builtin_bit_cast(s16x4, __builtin_amdgcn_ds_read_tr16_b64_v4i16((LAS s16x4*)vp));
                const s16x4 hi = __builtin_bit_cast(s16x4, __builtin_amdgcn_ds_read_tr16_b64_v4i16((LAS s16x4*)(vp + 4 * SROW)));
                af[ks] = __builtin_shufflevector(lo, hi, 0, 1, 2, 3, 4, 5, 6, 7);
            }
#pragma unroll
            for (int tb = 0; tb < 4; ++tb) {
                f32x16 acc;
#pragma unroll
                for (int e = 0; e < 16; ++e) acc[e] = 0.f;
                const int t = 32 * tb + r;
#pragma unroll
                for (int ks = 0; ks < 8; ++ks) {
                    if (ks <= 2 * tb + 1) {
                        const bf16x8 bfr = *(const bf16x8*)(lds + SGU_W_OFF + t * SWROW + (16 * ks + 8 * hh) * 2);
                        acc = __builtin_amdgcn_mfma_f32_32x32x16_bf16(af[ks], bfr, acc, 0, 0, 0);
                    }
                }
                const float bias = bsp[g * 128 + t];
                bf16_t* up = Z + (size_t)(row0 + t) * ZP + g * 256 + 32 * w + 4 * hh;
#pragma unroll
                for (int i4 = 0; i4 < 4; ++i4) {
                    const u32x2 uu = *(const u32x2*)(up + 8 * i4);
                    u32x2 y; y.x = cvt_pk_bf16(bflo(uu.x) * (acc[4 * i4] + bias), bfhi(uu.x) * (acc[4 * i4 + 1] + bias));
                    y.y = cvt_pk_bf16(bflo(uu.y) * (acc[4 * i4 + 2] + bias), bfhi(uu.y) * (acc[4 * i4 + 3] + bias));
                    *(u32x2*)(up + 8 * i4) = y;
                }
            }
            __syncthreads();
        }
    }
}


#define XB_TMO      128
#define XB_XCNT(j)  (256  + 64 * (j))
#define XB_XSUB(j)  (1280 + 64 * (j))
#define XB_XGEN(j)  (2304 + 64 * (j))
#define XB_TOP      3328
#define XB_TOPGEN   3392
#define XB_SPIN_CAP (1u << 22)
__device__ __forceinline__ unsigned xb_ld(unsigned* p)              { return __hip_atomic_load(p, __ATOMIC_RELAXED, __HIP_MEMORY_SCOPE_AGENT); }
__device__ __forceinline__ unsigned xb_add(unsigned* p, unsigned v) { return __hip_atomic_fetch_add(p, v, __ATOMIC_RELAXED, __HIP_MEMORY_SCOPE_AGENT); }
__device__ __forceinline__ unsigned xb_xcc_id() { return (unsigned)__builtin_amdgcn_s_getreg((3 << 11) | 20) & 0xFu; }
#define XB_SPIN(cond, bar) do { unsigned _sp = 0; while (cond) { __builtin_amdgcn_s_sleep(1); \
    if ((++_sp & 255u) == 0u) { if (xb_ld(&(bar)[XB_TMO])) break; if (_sp > XB_SPIN_CAP) { atomicAdd(&(bar)[XB_TMO], 1u); break; } } } } while (0)
__device__ __forceinline__ void xcd_barrier_complete(unsigned* bar, unsigned x, unsigned& nloc, unsigned& nx) {
    const unsigned G = gridDim.x;
    unsigned sum, cnt, mine, sp = 0u;
    for (;;) {
        sum = 0u; cnt = 0u; mine = 0u;
#pragma unroll
        for (unsigned j = 0; j < 16; ++j) { const unsigned c = xb_ld(&bar[XB_XCNT(j)]); sum += c; cnt += (c > 0u) ? 1u : 0u; mine = (j == x) ? c : mine; }
        if (sum == G) break;
        __builtin_amdgcn_s_sleep(1);
        if ((++sp & 255u) == 0u) { if (xb_ld(&bar[XB_TMO])) break; if (sp > XB_SPIN_CAP) { atomicAdd(&bar[XB_TMO], 1u); break; } }
    }
    nloc = mine > 0u ? mine : 1u; nx = cnt > 0u ? cnt : 1u;
}
__device__ __forceinline__ void xcd_barrier(unsigned* bar, unsigned x, volatile LAS unsigned* st) {
    asm volatile("s_waitcnt vmcnt(0)" ::: "memory");
    __syncthreads();
    if (threadIdx.x == 0) {
        __builtin_amdgcn_s_waitcnt(0);
        unsigned nloc = st[0], nx = st[1];
        if (nloc == 0u) { xcd_barrier_complete(bar, x, nloc, nx); st[0] = nloc; st[1] = nx; }
        const unsigned old = xb_add(&bar[XB_XSUB(x)], 1u);
        const unsigned gen = old / nloc;
        if (old + 1u == (gen + 1u) * nloc) {
            __builtin_amdgcn_fence(__ATOMIC_RELEASE, "agent");
            asm volatile("s_waitcnt vmcnt(0)" ::: "memory");
            const unsigned og = xb_add(&bar[XB_TOP], 1u);
            const unsigned tg = og / nx;
            if (og + 1u == (tg + 1u) * nx) xb_add(&bar[XB_TOPGEN], 1u);
            else XB_SPIN(xb_ld(&bar[XB_TOPGEN]) == tg, bar);
            __builtin_amdgcn_fence(__ATOMIC_ACQUIRE, "agent");
            xb_add(&bar[XB_XGEN(x)], 1u);
            asm volatile("s_waitcnt vmcnt(0)" ::: "memory");
        } else {
            XB_SPIN(xb_ld(&bar[XB_XGEN(x)]) == gen, bar);
            __builtin_amdgcn_fence(__ATOMIC_ACQUIRE, "agent");
            asm volatile("s_waitcnt vmcnt(0)" ::: "memory");
        }
    }
    __syncthreads();
}

constexpr int NPHASE = 1 + 9 * DEPTH;
__device__ __forceinline__ int mktid(int wv0) { int t; asm volatile("v_mbcnt_lo_u32_b32 %0, -1, 0\n\tv_mbcnt_hi_u32_b32 %0, -1, %0" : "=v"(t)); return (t + wv0 * 64) & 511; }
__device__ __forceinline__ Params load_params() {
    Params P{};
#if defined(__HIP_DEVICE_COMPILE__)
    typedef const __attribute__((address_space(4))) unsigned long long* kp_t;
    kp_t kp = (kp_t)__builtin_amdgcn_kernarg_segment_ptr(); asm volatile("" : "+s"(kp));
#pragma unroll
    for (int i = 0; i < 26; ++i) P.in[i] = (const float*)kp[i];
    P.out = (float*)kp[26]; P.ws = (unsigned char*)kp[27];
#endif
    return P;
}
__host__ __device__ __forceinline__ bool phase_nonempty(int ph) {
    if (ph == 0) return true;
    const int layer = (ph - 1) / 9, slot = (ph - 1) % 9;
    if ((layer & 1) && (slot == 3 || slot == 4)) return false;
    return true;
}

__global__ void __launch_bounds__(512) fwd_megakernel(Params Parg) {
    extern __shared__ __attribute__((aligned(16))) unsigned char lds[];
    LAS unsigned char* ldsl = (LAS unsigned char*)lds;
    const int wv0 = __builtin_amdgcn_readfirstlane((int)threadIdx.x >> 6);
    volatile LAS unsigned* bst = (volatile LAS unsigned*)(ldsl + 131072);
    if (threadIdx.x == 0) { bst[0] = 0u; bst[1] = 0u; }
    __syncthreads();
    unsigned* const bar = (unsigned*)(Parg.ws + OFF_BAR);
    const unsigned xcc = xb_xcc_id();
    int nseam = 0;
    bool first = true;
    for (int ph = Parg.ph_lo; ph < Parg.ph_hi; ++ph) {
        if (!phase_nonempty(ph)) continue;
        if (!first) {
            if (nseam == 0) { cg::this_grid().sync(); if (threadIdx.x == 0) (void)xb_add(&bar[XB_XCNT(xcc)], 1u); }
            else xcd_barrier(bar, xcc, bst);
            ++nseam;
        }
        first = false;
        const Params P = load_params();
        unsigned char* ws = P.ws;
        bf16_t* wb = (bf16_t*)(ws + OFF_W);
        bf16_t* hb = (bf16_t*)(ws + OFF_HB);
        float* SS = (float*)(ws + OFF_SS);
        const int G = gridDim.x, c = blockIdx.x;
#ifndef NO_P0
        if (ph == 0) { p0_prologue(mktid(wv0), P, lds); continue; }
#else
        if (ph == 0) continue;
#endif
        const int layer = (ph - 1) / 9, slot = (ph - 1) % 9, j = layer >> 1;
        const bool mla = (layer & 1) == 0;
        float* ss_mix = SS; float* ss_ffn = SS; float* ss_ple = SS;
        float* ss_next = (layer + 1 < DEPTH) ? SS : nullptr;
        const float* hin = (layer == 0) ? P.in[0] : nullptr;
        pg8::StaticOrder S;
        if (slot == 0) {
            if (mla) {
                pg8::Gemm g{hb, wb + WE_DOWN + (size_t)j * LATP * DM, T, LATP, DM, DM}; S.init(T, LATP, G, c);
                pg8::EpiStore<0, 0> E{(bf16_t*)(ws + OFF_FF + FF_LAT), LATP, ss_mix, 1.0f / DM};
                pg8::gemm_phase(mktid(wv0), ldsl, g, S, E);
            } else {
                pg8::Gemm g{hb, wb + WE_GIN + (size_t)j * ZP * DM, T, ZP, DM, DM}; S.init(T, ZP, G, c);
                pg8::EpiStore<2, 0> E{(bf16_t*)(ws + OFF_FF), ZP, ss_mix, 1.0f / DM};
                pg8::gemm_phase(mktid(wv0), ldsl, g, S, E);
            }
        } else if (slot == 1) {
            if (mla) {
                { pg8::Gemm g{(const bf16_t*)(ws + OFF_FF + FF_LAT), wb + WE_UQ + (size_t)j * QP * QLR, T, QP, QLR, LATP}; S.init(T, QP, G, c);
                  pg8::EpiStore<0, 0> E{(bf16_t*)(ws + OFF_FF + FF_Q), QP, nullptr, 0.f};
                  pg8::gemm_phase(mktid(wv0), ldsl, g, S, E); }
                { pg8::Gemm g{(const bf16_t*)(ws + OFF_FF + FF_LAT) + QLR, wb + WE_UKV + (size_t)j * KVP * KVLR, T, KVP, KVLR, LATP}; S.init(T, KVP, G, c);
                  pg8::EpiStore<0, 0> E{(bf16_t*)(ws + OFF_FF + FF_KV), KVP, nullptr, 0.f};
                  pg8::gemm_phase(mktid(wv0), ldsl, g, S, E); }
            } else {
#ifndef NO_SGU
                sgu_phase(mktid(wv0), P, lds, j);
#endif
            }
        } else if (slot == 2) {
            if (mla) {
#ifndef NO_R2
                r2_phase(mktid(wv0), P, j);
#endif
            } else {
                pg8::Gemm g{(const bf16_t*)(ws + OFF_FF), wb + WE_GOUT + (size_t)j * DM * 2048, T, DM, 2048, ZP}; S.init(T, DM, G, c);
                pg8::EpiRes<0> E{hin, nullptr, hb, ss_ffn, nullptr};
                pg8::gemm_phase(mktid(wv0), ldsl, g, S, E);
            }
        } else if (slot == 3) {
#ifndef NO_ATT
            attn_phase(mktid(wv0), P, lds);
#endif
        } else if (slot == 4) {
            pg8::Gemm g{(const bf16_t*)(ws + OFF_FF + FF_Q), wb + WE_MOUT + (size_t)j * DM * DM, T, DM, DM, QP}; S.init(T, DM, G, c);
            pg8::EpiRes<0> E{hin, nullptr, hb, ss_ffn, nullptr};
            pg8::gemm_phase(mktid(wv0), ldsl, g, S, E);
        } else if (slot == 5) {
            pg8::Gemm g{hb, wb + WE_UP + (size_t)layer * DFF * DM, T, DFF, DM, DM}; S.init(T, DFF, G, c);
            pg8::EpiStore<1, 0> E{(bf16_t*)(ws + OFF_FF), DFF, ss_ffn, 1.0f / DM};
            pg8::gemm_phase(mktid(wv0), ldsl, g, S, E);
        } else if (slot == 6) {
            pg8::Gemm g{(const bf16_t*)(ws + OFF_FF), wb + WE_DN + (size_t)layer * DM * DFF, T, DM, DFF, DFF}; S.init(T, DM, G, c);
            pg8::EpiRes<0> E{nullptr, nullptr, hb, ss_ple, nullptr};
            pg8::gemm_phase(mktid(wv0), ldsl, g, S, E);
        } else if (slot == 7) {
            pg8::Gemm g{hb, wb + WE_GATE + (size_t)layer * DM * DM, T, DM, DM, DM}; S.init(T, DM, G, c);
            pg8::EpiStore<3, 0> E{(bf16_t*)(ws + OFF_FF), DM, ss_ple, 1.0f / DM};
            pg8::gemm_phase(mktid(wv0), ldsl, g, S, E);
        } else {
            pg8::Gemm g{(const bf16_t*)(ws + OFF_PB) + (size_t)layer * T * PLE, wb + WE_PROJ + (size_t)layer * DM * PLE, T, DM, PLE, PLE}; S.init(T, DM, G, c);
            pg8::EpiRes<1> E{nullptr, (layer == DEPTH - 1) ? P.out : nullptr, hb, ss_next, (const bf16_t*)(ws + OFF_FF)};
            pg8::gemm_phase(mktid(wv0), ldsl, g, S, E);
        }
    }
    asm volatile("s_waitcnt vmcnt(0)" ::: "memory");
    __builtin_amdgcn_fence(__ATOMIC_RELEASE, "agent");
    asm volatile("s_waitcnt vmcnt(0)" ::: "memory");
}


#ifdef DBG_CHECK
__global__ void dbg_check(const bf16_t* A, int lda, const bf16_t* Bt, int K, const bf16_t* C, int ldc, int N, const float* ss, int act, float* out) {
    const unsigned s = blockIdx.x * blockDim.x + threadIdx.x;
    const unsigned hsh = s * 2654435761u; const int row = (hsh >> 8) % T; const int col = (s * 40503u + (hsh >> 3)) % N;
    float acc = 0.f;
    for (int k = 0; k < K; ++k) acc += bf2f(A[(size_t)row * lda + k]) * bf2f(Bt[(size_t)col * K + k]);
    if (ss) acc *= rsqrtf(ss[row] * (1.0f / DM) + EPS);
    if (act == 3) acc = 1.0f / (1.0f + expf(-acc));
    if (act == 1) { acc = fmaxf(acc, 0.f); acc *= acc; }
    const float got = bf2f(C[(size_t)row * ldc + col]);
    if (!(fabsf(got - acc) <= 0.03f + 0.03f * fabsf(acc))) atomicAdd(out + 4096, 1.0f);
}
#endif

#ifdef DBG_CHECK
__global__ void dbg_check_ss(const float* h, const float* ss, float* out) {
    const int row = blockIdx.x * blockDim.x + threadIdx.x; if (row >= T) return;
    float a = 0.f; for (int k = 0; k < DM; ++k) { const float v = h[(size_t)row * DM + k]; a += v * v; }
    const float got = ss[row];
    if (!(fabsf(got - a) <= 1e-3f * fabsf(a))) out[(size_t)row * DM] = 1e30f;
}
#endif

#ifdef DBG_CHECK
__global__ void dbg_zero(float* out) { out[4096 + threadIdx.x] = 0.f; out[8192 + threadIdx.x] = 0.f; }
__global__ void dbg_reduce(float* out) {
    float bc = 0.f, br = 0.f; int ic = 0, ir = 0;
    for (int i = 0; i < 256; ++i) { if (out[4096 + i] > bc) { bc = out[4096 + i]; ic = i; } if (out[8192 + i] > br) { br = out[8192 + i]; ir = i; } }
    float v = 1e6f * out[4096];
    for (int i = 0; i < 256; ++i) { out[4096 + i] = 0.f; out[8192 + i] = 0.f; }
    out[0] = v; out[1] = 1e-3f * bc; out[2] = 1e-3f * br;
}
#endif
constexpr int LDS_BYTES = 131072 + 256;
extern "C" void kernel_launch(void* const* d_in, const int* in_sizes, int n_in, void* d_out, int out_size, void* d_ws, size_t ws_size, hipStream_t stream) {
    static int grid = 0;
    if (grid == 0) {
        if (n_in != 26 || out_size != T * DM || ws_size < WS_NEED) { fprintf(stderr, "kernel_launch: unexpected problem (n_in %d out %d ws %zu)\n", n_in, out_size, ws_size); grid = -1; return; }
        int dev = 0, cus = 0, per_cu = 0;
        hipGetDevice(&dev); hipDeviceGetAttribute(&cus, hipDeviceAttributeMultiprocessorCount, dev);
        hipFuncSetAttribute((const void*)fwd_megakernel, hipFuncAttributeMaxDynamicSharedMemorySize, LDS_BYTES);
        hipOccupancyMaxActiveBlocksPerMultiprocessor(&per_cu, (const void*)fwd_megakernel, 512, LDS_BYTES);
        if (per_cu < 1) { fprintf(stderr, "kernel_launch: occupancy query says %d blocks/CU\n", per_cu); per_cu = 1; }
        (void)hipGetLastError();
        grid = cus;
    }
    if (grid < 0) return;
    Params p{};
    for (int i = 0; i < 26; ++i) p.in[i] = (const float*)d_in[i];
    p.out = (float*)d_out; p.ws = (unsigned char*)d_ws;
#if ONE_LAUNCH
    p.ph_lo = 0; p.ph_hi = NPHASE;
    for (int rep = 0; rep < DBG_REPS; ++rep)
    { void* args[] = {&p}; hipError_t e = hipLaunchCooperativeKernel((const void*)fwd_megakernel, dim3(grid), dim3(512), args, LDS_BYTES, stream);
      if (e != hipSuccess) fprintf(stderr, "cooperative launch failed: %s (grid %d)\n", hipGetErrorString(e), grid); }
#else
#ifndef DBG_STOP
#define DBG_STOP (NPHASE - 1)
#endif
    for (int ph = 0; ph <= DBG_STOP; ++ph) {
        if (!phase_nonempty(ph)) continue;
        p.ph_lo = ph; p.ph_hi = ph + 1;
#ifdef DBG_NANFILL
        if (ph == DBG_NANFILL) (void)hipMemsetAsync((char*)d_ws + OFF_FF, 0xFF, 64 * MiB, stream);
#endif
        void* args[] = {&p}; hipError_t e = hipLaunchCooperativeKernel((const void*)fwd_megakernel, dim3(grid), dim3(512), args, LDS_BYTES, stream);
        if (e != hipSuccess) { fprintf(stderr, "cooperative launch failed: %s (grid %d, phase %d)\n", hipGetErrorString(e), grid, ph); break; }
    }
#ifdef DBG_CHECK
    { unsigned char* ws = (unsigned char*)d_ws; bf16_t* wb = (bf16_t*)(ws + OFF_W);
      dbg_zero<<<1, 256, 0, stream>>>((float*)d_out); DBG_CHECK; dbg_reduce<<<1, 1, 0, stream>>>((float*)d_out); }
#endif
#endif
}
```

```cpp
#include <hip/hip_runtime.h>
#include <hip/hip_cooperative_groups.h>
#include <cstdio>
#include <cstdint>
namespace cg = cooperative_groups;

#ifndef DBG_NOGATE
#define DBG_NOGATE 0
#endif
#ifndef DBG_GATE_NOSS
#define DBG_GATE_NOSS 0
#endif
#ifndef DBG_REPS
#define DBG_REPS 1
#endif
#ifndef ONE_LAUNCH
#define ONE_LAUNCH 1
#endif

#define LAS __attribute__((address_space(3)))
typedef unsigned short bf16_t;
typedef short bf16x8 __attribute__((ext_vector_type(8)));
typedef short s16x4 __attribute__((ext_vector_type(4)));
typedef float f32x4 __attribute__((ext_vector_type(4)));
typedef float f32x2 __attribute__((ext_vector_type(2)));
typedef float f32x16 __attribute__((ext_vector_type(16)));
typedef unsigned u32x4 __attribute__((ext_vector_type(4)));
typedef unsigned u32x2 __attribute__((ext_vector_type(2)));

constexpr int T = 32768, DM = 1024, SEQ = 2048, NB = 16, DFF = 4096, PLE = 256, DEPTH = 4;
constexpr int NH = 8, QLR = 384, KVLR = 256, ROPE = 64, LATP = 768;
constexpr int QP = 1536, KVP = 2048, ZP = 4096;
constexpr float EPS = 1e-6f;
constexpr float QSCALE = 0.07216878364870322f * 1.4426950408889634f;

constexpr size_t MiB = 1u << 20;
constexpr size_t OFF_SS = 0;
constexpr size_t OFF_W = 2621440;
constexpr size_t OFF_HB = 112 * MiB;
constexpr size_t OFF_FF = 176 * MiB;
constexpr size_t OFF_PB = 448 * MiB;
constexpr size_t WS_NEED = 512 * MiB;
constexpr size_t OFF_BAR = 2 * MiB;
#define XCD_BAR_WORDS 3456
constexpr size_t WE_DOWN = 0, WE_UQ = WE_DOWN + 2ull * LATP * DM, WE_UKV = WE_UQ + 2ull * QP * QLR, WE_MOUT = WE_UKV + 2ull * KVP * KVLR,
                 WE_GIN = WE_MOUT + 2ull * DM * DM, WE_GOUT = WE_GIN + 2ull * ZP * DM, WE_UP = WE_GOUT + 2ull * DM * 2048,
                 WE_DN = WE_UP + 4ull * DFF * DM, WE_GATE = WE_DN + 4ull * DM * DFF, WE_PROJ = WE_GATE + 4ull * DM * DM, WE_END = WE_PROJ + 4ull * DM * PLE;
static_assert(OFF_W + WE_END * 2 <= OFF_HB, "weights fit");
constexpr size_t FF_Q = 0, FF_KV = 96 * MiB, FF_LAT = 224 * MiB;

struct Params { const float* in[26]; float* out; unsigned char* ws; int ph_lo, ph_hi; };

typedef __bf16 bf16x2_t __attribute__((ext_vector_type(2)));
__device__ __forceinline__ unsigned cvt_pk_bf16(float lo, float hi) { const f32x2 v = {lo, hi}; return __builtin_bit_cast(unsigned, __builtin_convertvector(v, bf16x2_t)); }
__device__ __forceinline__ float bf2f(unsigned short b) { return __uint_as_float((unsigned)b << 16); }
__device__ __forceinline__ float bflo(unsigned u) { return __uint_as_float(u << 16); }
__device__ __forceinline__ float bfhi(unsigned u) { return __uint_as_float(u & 0xffff0000u); }
__device__ __forceinline__ float fast_rcp(float x) { return __builtin_amdgcn_rcpf(x); }
__device__ __forceinline__ float fast_exp2(float x) { return __builtin_amdgcn_exp2f(x); }
__device__ __forceinline__ float gelu_tanh(float x) { const float y = x + 0.044715f * x * x * x; return x * fast_rcp(1.0f + fast_exp2(-2.3022082f * y)); }
__device__ __forceinline__ float sigmoidf_(float x) { return fast_rcp(1.0f + fast_exp2(-1.4426950409f * x)); }

namespace pg8 {
constexpr int BM = 256, BK = 64, HALF = 128, HTB = HALF * BK * 2, STAGE_BYTES = 8 * HTB, NXCD = 8, WGM = 8;
__host__ __device__ __forceinline__ int lds_byte(int r, int c) { const int st = (r >> 4) * 2 + (c >> 5), rr = r & 15, cc = c & 31, ob = rr * 64 + cc * 2; return st * 1024 + (ob ^ (((ob >> 9) & 1) << 5)); }
__host__ __device__ __forceinline__ void stage_rc(int b, int& R, int& C) { const int st = b / 1024, sb = b % 1024, swz = sb ^ (((sb >> 9) & 1) << 5); R = (st >> 1) * 16 + swz / 64; C = (st & 1) * 32 + (swz % 64) / 2; }
__host__ __device__ __forceinline__ int perm32(int rho) { const int n = rho >> 4, i = rho & 15; return 8 * (i >> 2) + 4 * n + (i & 3); }
struct Unit { int pm, pn; };
struct RsCtx { const LAS float* tab; int pmA, pmB; };
struct Gemm { const bf16_t* A; const bf16_t* Bt; int M, N, K, lda; };
struct StaticOrder {
    int nM, nN, nwg, G, c;
    __device__ void init(int M, int N, int G_, int c_) { nM = M / BM; nN = N / BM; nwg = nM * nN; G = G_; c = c_; }
    __device__ bool next(int i, Unit& u) const {
        const long L = (long)i * G + c; if (L >= nwg) return false;
        int wgid = (int)L; { const int q = nwg / NXCD, r = nwg % NXCD, xcd = wgid % NXCD, off = wgid / NXCD; wgid = (xcd < r ? xcd * (q + 1) : r * (q + 1) + (xcd - r) * q) + off; }
        const int nig = WGM * nN, gid = wgid / nig, fm = gid * WGM, gsz = (nM - fm) < WGM ? (nM - fm) : WGM;
        u.pm = fm + ((wgid % nig) % gsz); u.pn = (wgid % nig) / gsz; return true;
    }
};

template <int ACT, int STATS> struct EpiStore {
    static constexpr bool PERM = true; static constexpr bool HAS_RS = true;
    bf16_t* O; int ldc; const float* ss; float inv_n;
    __device__ __forceinline__ void operator()(const f32x4 (&acc)[2][2][4][2], const Unit& u, int wr, int wc, int fr, int fq, const RsCtx& rc) const {
        const int row0 = u.pm * BM + wr * 64 + fr, col0 = u.pn * BM + wc * 32 + 8 * fq;
        const int rslot = (u.pm == rc.pmA) ? 0 : ((u.pm == rc.pmB) ? 1 : -1);
#pragma unroll
        for (int ai = 0; ai < 2; ++ai)
#pragma unroll
            for (int m = 0; m < 4; ++m) {
                const int row = row0 + ai * HALF + m * 16;
                float rs = 1.0f;
                if (ss && rslot >= 0) rs = rc.tab[rslot * 256 + wr * 64 + fr + ai * HALF + m * 16];
                else if (ss) { const f32x4* sp = (const f32x4*)(ss + (size_t)row * 16); const f32x4 a = sp[0], b = sp[1], c = sp[2], d = sp[3];
                    const float t = (((a[0] + a[1]) + (a[2] + a[3])) + ((b[0] + b[1]) + (b[2] + b[3]))) + (((c[0] + c[1]) + (c[2] + c[3])) + ((d[0] + d[1]) + (d[2] + d[3])));
                    rs = rsqrtf(t * inv_n + EPS); }
#pragma unroll
                for (int bj = 0; bj < 2; ++bj) {
                    f32x4 v0 = acc[ai][bj][m][0] * rs, v1 = acc[ai][bj][m][1] * rs;
                    if (ACT == 1) {
#pragma unroll
                        for (int e = 0; e < 4; ++e) { const float a = fmaxf(v0[e], 0.f), b = fmaxf(v1[e], 0.f); v0[e] = a * a; v1[e] = b * b; }
                    }
                    if (ACT == 2) {
#pragma unroll
                        for (int e = 0; e < 4; ++e) { v0[e] = gelu_tanh(v0[e]); v1[e] = gelu_tanh(v1[e]); }
                    }
                    if (ACT == 3) {
#pragma unroll
                        for (int e = 0; e < 4; ++e) { v0[e] = sigmoidf_(v0[e]); v1[e] = sigmoidf_(v1[e]); }
                    }
                    u32x4 w; w.x = cvt_pk_bf16(v0[0], v0[1]); w.y = cvt_pk_bf16(v0[2], v0[3]); w.z = cvt_pk_bf16(v1[0], v1[1]); w.w = cvt_pk_bf16(v1[2], v1[3]);
                    *(u32x4*)(O + (size_t)row * ldc + col0 + bj * HALF) = w;
                }
                asm volatile("" ::: "memory");
            }
    }
};
template <int MODE> struct EpiRes {
    static constexpr bool PERM = true; static constexpr bool HAS_RS = false;
    static constexpr int MB = (MODE == 1) ? 2 : 4;
    const float* hin32; float* hout32; bf16_t* hb; float* ssn; const bf16_t* pp;
    __device__ __forceinline__ void operator()(const f32x4 (&acc)[2][2][4][2], const Unit& u, int wr, int wc, int fr, int fq, const RsCtx&) const {
        const int row0 = u.pm * BM + wr * 64 + fr, col0 = u.pn * BM + wc * 32 + 8 * fq;
#pragma unroll
        for (int ai = 0; ai < 2; ++ai)
#pragma unroll
            for (int mg = 0; mg < 4; mg += MB) {
                f32x4 hv[MB][2][2]; u32x4 pw[MB][2];
#pragma unroll
                for (int mm = 0; mm < MB; ++mm)
#pragma unroll
                    for (int bj = 0; bj < 2; ++bj) {
                        const size_t off = (size_t)(row0 + ai * HALF + (mg + mm) * 16) * DM + col0 + bj * HALF;
                        if (hin32) { hv[mm][bj][0] = *(const f32x4*)(hin32 + off); hv[mm][bj][1] = *(const f32x4*)(hin32 + off + 4); }
                        else { const u32x4 b = *(const u32x4*)(hb + off); hv[mm][bj][0] = (f32x4){bflo(b.x), bfhi(b.x), bflo(b.y), bfhi(b.y)}; hv[mm][bj][1] = (f32x4){bflo(b.z), bfhi(b.z), bflo(b.w), bfhi(b.w)}; }
                        if (MODE == 1) pw[mm][bj] = *(const u32x4*)(pp + off);
                    }
#pragma unroll
                for (int mm = 0; mm < MB; ++mm) {
                    const int m = mg + mm, row = row0 + ai * HALF + m * 16;
                    float q = 0.f;
#pragma unroll
                    for (int bj = 0; bj < 2; ++bj) {
                        const size_t off = (size_t)row * DM + col0 + bj * HALF;
                        f32x4 v0 = acc[ai][bj][m][0], v1 = acc[ai][bj][m][1];
                        if (MODE == 1) {
                            const u32x4 g = pw[mm][bj];
                            v0[0] *= bflo(g.x); v0[1] *= bfhi(g.x); v0[2] *= bflo(g.y); v0[3] *= bfhi(g.y);
                            v1[0] *= bflo(g.z); v1[1] *= bfhi(g.z); v1[2] *= bflo(g.w); v1[3] *= bfhi(g.w);
                        }
                        v0 += hv[mm][bj][0]; v1 += hv[mm][bj][1];
                        if (hout32) { *(f32x4*)(hout32 + off) = v0; *(f32x4*)(hout32 + off + 4) = v1; }
                        else { u32x4 w; w.x = cvt_pk_bf16(v0[0], v0[1]); w.y = cvt_pk_bf16(v0[2], v0[3]); w.z = cvt_pk_bf16(v1[0], v1[1]); w.w = cvt_pk_bf16(v1[2], v1[3]);
                               *(u32x4*)(hb + off) = w; }
                        q += (v0[0] * v0[0] + v0[1] * v0[1]) + (v0[2] * v0[2] + v0[3] * v0[3]) + (v1[0] * v1[0] + v1[1] * v1[1]) + (v1[2] * v1[2] + v1[3] * v1[3]);
                    }
                    if (ssn) { q += __shfl_xor(q, 16); q += __shfl_xor(q, 32); if (fq == 0) ssn[(size_t)row * 16 + u.pn * 4 + wc] = q; }
                }
                asm volatile("" ::: "memory");
            }
    }
};

#ifndef PG8_SP2
#define PG8_SP2 true
#endif
#ifndef PG8_ALIGN
#define PG8_ALIGN true
#endif
template <class Epi, bool ALIGN_EPI = PG8_ALIGN, bool SP2 = PG8_SP2>
__device__ __forceinline__ void gemm_phase(int tid, LAS unsigned char* lds, const Gemm g, const StaticOrder& S, const Epi& E) {
    const int wid = __builtin_amdgcn_readfirstlane(tid >> 6), lane = tid & 63, wr = wid >> 2, wc = wid & 3, fr = lane & 15, fq = lane >> 4;
    const int K = g.K, nt = K / BK, lda = g.lda;
    unsigned voffA[2], voffB[2];
#pragma unroll
    for (int i = 0; i < 2; ++i) { int R, C; stage_rc(tid * 16 + i * 8192, R, C); const int Rb = Epi::PERM ? ((R & ~31) + perm32(R & 31)) : R;
        voffA[i] = (unsigned)(R * lda + C) * 2u; voffB[i] = (unsigned)(Rb * K + C) * 2u; }
    const size_t kstep = (size_t)(BK * 2);
    const size_t hstepA = (size_t)HALF * lda * 2, hstepB = (size_t)HALF * K * 2;
    const size_t tstepA = 2 * hstepA, tstepB = 2 * hstepB;
    const unsigned ldsw = (unsigned)wid * 1024u;
    const int aoff = lds_byte(wr * 64 + fr, fq * 8), boff = lds_byte(wc * 32 + fr, fq * 8);
#define PG8_SA(b, h) (((b) * 2 + (h)) * HTB)
#define PG8_SB(b, h) ((4 + (b) * 2 + (h)) * HTB)
#define PG8_STAGE(bufoff, gbase, voff) do { _Pragma("unroll") for (int _i = 0; _i < 2; ++_i) \
        __builtin_amdgcn_global_load_lds((const unsigned*)((const char*)(gbase) + (voff)[_i]), (LAS unsigned*)(lds + (bufoff) + ldsw + _i * 8192), 16, 0, 0); } while (0)
#define PG8_LDA(dst, b, h) do { _Pragma("unroll") for (int m = 0; m < 4; ++m) _Pragma("unroll") for (int k = 0; k < 2; ++k) dst[m][k] = *(const LAS bf16x8*)(lds + PG8_SA(b, h) + aoff + m * 2048 + k * 1024); } while (0)
#define PG8_LDB(dst, b, h) do { _Pragma("unroll") for (int n = 0; n < 2; ++n) _Pragma("unroll") for (int k = 0; k < 2; ++k) dst[n][k] = *(const LAS bf16x8*)(lds + PG8_SB(b, h) + boff + n * 2048 + k * 1024); } while (0)
#define PG8_MMA(ai, bj, At, Bt) do { __builtin_amdgcn_s_setprio(1); _Pragma("unroll") for (int m = 0; m < 4; ++m) _Pragma("unroll") for (int n = 0; n < 2; ++n) _Pragma("unroll") for (int k = 0; k < 2; ++k) \
        acc[ai][bj][m][n] = __builtin_amdgcn_mfma_f32_16x16x32_bf16(Bt[n][k], At[m][k], acc[ai][bj][m][n], 0, 0, 0); __builtin_amdgcn_s_setprio(0); } while (0)
#define PG8_WAIT_V(n) asm volatile("s_waitcnt vmcnt(" #n ")" ::: "memory")
#define PG8_WAIT_L(n) asm volatile("s_waitcnt lgkmcnt(" #n ")" ::: "memory")
#define PG8_BAR __builtin_amdgcn_s_barrier()
#define PG8_SCHED __builtin_amdgcn_sched_barrier(0)
    Unit cur, nxt; int ui = 0;
    if (!S.next(0, cur)) return;
    RsCtx rc; rc.tab = (const LAS float*)(lds + STAGE_BYTES + 256); rc.pmA = cur.pm; rc.pmB = cur.pm;
    if constexpr (Epi::HAS_RS) {
        if (E.ss) {
            Unit lu = cur; for (int i = 1; S.next(i, nxt); ++i) lu = nxt;
            rc.pmB = lu.pm;
            const int rowl = tid & 255, pmx = (tid >> 8) ? rc.pmB : rc.pmA;
            const f32x4* sp = (const f32x4*)(E.ss + (size_t)(pmx * BM + rowl) * 16); const f32x4 a = sp[0], b = sp[1], c = sp[2], d = sp[3];
            const float t = (((a[0] + a[1]) + (a[2] + a[3])) + ((b[0] + b[1]) + (b[2] + b[3]))) + (((c[0] + c[1]) + (c[2] + c[3])) + ((d[0] + d[1]) + (d[2] + d[3])));
            ((LAS float*)(lds + STAGE_BYTES + 256))[tid] = rsqrtf(t * E.inv_n + EPS);
            __syncthreads();
        }
    }
    f32x4 acc[2][2][4][2];
#pragma unroll
    for (int a = 0; a < 2; ++a)
#pragma unroll
        for (int b = 0; b < 2; ++b)
#pragma unroll
            for (int m = 0; m < 4; ++m)
#pragma unroll
                for (int n = 0; n < 2; ++n) acc[a][b][m][n] = (f32x4){0.f, 0.f, 0.f, 0.f};
    bf16x8 At[4][2], B0[2][2], B1[2][2];
    const char* cA = (const char*)g.A + (size_t)cur.pm * tstepA; const char* cB = (const char*)g.Bt + (size_t)cur.pn * tstepB;
    if constexpr (SP2) {
    PG8_STAGE(PG8_SB(0, 0), cB, voffB); PG8_STAGE(PG8_SB(0, 1), cB + hstepB, voffB); PG8_STAGE(PG8_SA(0, 0), cA, voffA); PG8_STAGE(PG8_SA(0, 1), cA + hstepA, voffA);
    if (wr == 1) PG8_BAR;
    PG8_WAIT_V(2); PG8_BAR;
    PG8_STAGE(PG8_SB(1, 0), cB + kstep, voffB); PG8_STAGE(PG8_SA(1, 0), cA + kstep, voffA); PG8_STAGE(PG8_SB(1, 1), cB + hstepB + kstep, voffB);
    PG8_WAIT_V(6); PG8_BAR;
    } else {
    PG8_STAGE(PG8_SB(0, 0), cB, voffB); PG8_STAGE(PG8_SA(0, 0), cA, voffA); PG8_STAGE(PG8_SB(0, 1), cB + hstepB, voffB); PG8_STAGE(PG8_SA(0, 1), cA + hstepA, voffA);
    if (wr == 1) PG8_BAR;
    PG8_WAIT_V(4); PG8_BAR;
    PG8_STAGE(PG8_SB(1, 0), cB + kstep, voffB); PG8_STAGE(PG8_SA(1, 0), cA + kstep, voffA); PG8_STAGE(PG8_SB(1, 1), cB + hstepB + kstep, voffB);
    PG8_WAIT_V(6); PG8_BAR;
    }
    for (;;) {
        const bool has_next = S.next(ui + 1, nxt);
        const char* nA = has_next ? (const char*)g.A + (size_t)nxt.pm * tstepA : cA; const char* nB = has_next ? (const char*)g.Bt + (size_t)nxt.pn * tstepB : cB;
        for (int t = 0; t < nt; t += 2) {
            const bool last = (t == nt - 2);
            const char* a1 = cA + (size_t)(t + 1) * kstep;
            const char* a2 = last ? nA : cA + (size_t)(t + 2) * kstep; const char* b2 = last ? nB : cB + (size_t)(t + 2) * kstep;
            const char* a3 = a2 + kstep; const char* b3 = b2 + kstep;
            if constexpr (SP2) {
            PG8_LDB(B0, 0, 0); PG8_LDB(B1, 0, 1); PG8_SCHED; PG8_LDA(At, 0, 0); PG8_STAGE(PG8_SA(1, 1), a1 + hstepA, voffA);
            PG8_WAIT_V(8); PG8_WAIT_L(0); PG8_BAR; PG8_MMA(0, 0, At, B0); PG8_MMA(0, 1, At, B1); PG8_BAR; PG8_SCHED;
            PG8_LDA(At, 0, 1); PG8_STAGE(PG8_SB(0, 0), b2, voffB); PG8_STAGE(PG8_SB(0, 1), b2 + hstepB, voffB); PG8_STAGE(PG8_SA(0, 0), a2, voffA);
            PG8_WAIT_V(8); PG8_WAIT_L(0); PG8_BAR; PG8_MMA(1, 0, At, B0); PG8_MMA(1, 1, At, B1); PG8_BAR; PG8_SCHED;
            PG8_LDB(B0, 1, 0); PG8_LDB(B1, 1, 1); PG8_SCHED; PG8_LDA(At, 1, 0); PG8_STAGE(PG8_SA(0, 1), a2 + hstepA, voffA);
            PG8_WAIT_V(8); PG8_WAIT_L(0); PG8_BAR; PG8_MMA(0, 0, At, B0); PG8_MMA(0, 1, At, B1); PG8_BAR; PG8_SCHED;
            PG8_LDA(At, 1, 1); PG8_STAGE(PG8_SB(1, 0), b3, voffB); PG8_STAGE(PG8_SB(1, 1), b3 + hstepB, voffB); PG8_STAGE(PG8_SA(1, 0), a3, voffA);
            PG8_WAIT_V(8); PG8_WAIT_L(0); PG8_BAR; PG8_MMA(1, 0, At, B0); PG8_MMA(1, 1, At, B1); PG8_BAR; PG8_SCHED;
            } else {
            PG8_LDB(B0, 0, 0); PG8_SCHED; PG8_LDA(At, 0, 0); PG8_STAGE(PG8_SA(1, 1), a1 + hstepA, voffA);
            PG8_WAIT_L(8); PG8_BAR; PG8_WAIT_L(0); PG8_MMA(0, 0, At, B0); PG8_BAR; PG8_SCHED;
            PG8_LDB(B1, 0, 1); PG8_STAGE(PG8_SB(0, 0), b2, voffB);
            PG8_BAR; PG8_WAIT_L(0); PG8_MMA(0, 1, At, B1); PG8_BAR;
            PG8_LDA(At, 0, 1); PG8_STAGE(PG8_SA(0, 0), a2, voffA);
            PG8_BAR; PG8_WAIT_L(0); PG8_MMA(1, 0, At, B0); PG8_BAR; PG8_SCHED;
            PG8_STAGE(PG8_SB(0, 1), b2 + hstepB, voffB);
            PG8_WAIT_V(6); PG8_BAR; PG8_MMA(1, 1, At, B1); PG8_BAR;
            PG8_LDB(B0, 1, 0); PG8_SCHED; PG8_LDA(At, 1, 0); PG8_STAGE(PG8_SA(0, 1), a2 + hstepA, voffA);
            PG8_WAIT_L(8); PG8_BAR; PG8_WAIT_L(0); PG8_MMA(0, 0, At, B0); PG8_BAR; PG8_SCHED;
            PG8_LDB(B1, 1, 1); PG8_STAGE(PG8_SB(1, 0), b3, voffB);
            PG8_BAR; PG8_WAIT_L(0); PG8_MMA(0, 1, At, B1); PG8_BAR;
            PG8_LDA(At, 1, 1); PG8_STAGE(PG8_SA(1, 0), a3, voffA);
            PG8_BAR; PG8_WAIT_L(0); PG8_MMA(1, 0, At, B0); PG8_BAR; PG8_SCHED;
            PG8_STAGE(PG8_SB(1, 1), b3 + hstepB, voffB);
            PG8_WAIT_V(6); PG8_BAR; PG8_MMA(1, 1, At, B1); PG8_BAR;
            }
        }
        if constexpr (ALIGN_EPI) { if (wr == 0) PG8_BAR; }
        E(acc, cur, wr, wc, fr, fq, rc);
        if (!has_next) break;
#pragma unroll
        for (int a = 0; a < 2; ++a)
#pragma unroll
            for (int b = 0; b < 2; ++b)
#pragma unroll
                for (int m = 0; m < 4; ++m)
#pragma unroll
                    for (int n = 0; n < 2; ++n) acc[a][b][m][n] = (f32x4){0.f, 0.f, 0.f, 0.f};
        cur = nxt; cA = nA; cB = nB; ++ui;
        if constexpr (ALIGN_EPI) { if (wr == 1) PG8_BAR; }
    }
    PG8_WAIT_V(0);
    if constexpr (!ALIGN_EPI) { if (wr == 0) PG8_BAR; }
    PG8_BAR;
#undef PG8_SA
#undef PG8_SB
#undef PG8_STAGE
#undef PG8_LDA
#undef PG8_LDB
#undef PG8_MMA
#undef PG8_WAIT_V
#undef PG8_WAIT_L
#undef PG8_BAR
#undef PG8_SCHED
}
}

__constant__ double kInvFreq[32] = {
    1.0, 0.7498942093324559, 0.5623413251903491, 0.4216965034285822, 0.31622776601683794, 0.23713737056616552, 0.1778279410038923, 0.1333521432163324,
    0.1, 0.07498942093324558, 0.05623413251903491, 0.04216965034285822, 0.03162277660168379, 0.023713737056616554, 0.01778279410038923, 0.01333521432163324,
    0.01, 0.007498942093324558, 0.005623413251903491, 0.004216965034285823, 0.0031622776601683794, 0.0023713737056616554, 0.001778279410038923, 0.001333521432163324,
    0.001, 0.0007498942093324559, 0.0005623413251903491, 0.0004216965034285823, 0.00031622776601683794, 0.00023713737056616554, 0.0001778279410038923, 0.0001333521432163324};

__device__ __forceinline__ float wave_sum(float v) {
#pragma unroll
    for (int o = 1; o < 64; o <<= 1) v += __shfl_xor(v, o);
    return v;
}
__device__ __forceinline__ void unpack8(const u32x4 w, float (&f)[8]) { f[0] = bflo(w.x); f[1] = bfhi(w.x); f[2] = bflo(w.y); f[3] = bfhi(w.y); f[4] = bflo(w.z); f[5] = bfhi(w.z); f[6] = bflo(w.w); f[7] = bfhi(w.w); }
__device__ __forceinline__ u32x4 pack8(const float (&f)[8]) { u32x4 w; w.x = cvt_pk_bf16(f[0], f[1]); w.y = cvt_pk_bf16(f[2], f[3]); w.z = cvt_pk_bf16(f[4], f[5]); w.w = cvt_pk_bf16(f[6], f[7]); return w; }

struct WDesc { const float* W; const float* gamma; bf16_t* dst; int K, N, Npad, mode, items; };
__device__ __forceinline__ WDesc wdesc(const Params& P, int id) {
    WDesc d; bf16_t* wb = (bf16_t*)(P.ws + OFF_W); d.gamma = nullptr; d.mode = 0;
    if (id < 12) {
        const int j = id & 1, f = id >> 1;
        switch (f) {
            case 0: d.W = P.in[6] + (size_t)j * DM * 704; d.K = DM; d.N = 704; d.Npad = LATP; d.dst = wb + WE_DOWN + (size_t)j * LATP * DM; d.gamma = P.in[3] + (2 * j) * DM; break;
            case 1: d.W = P.in[9] + (size_t)j * QLR * QP; d.K = QLR; d.N = QP; d.Npad = QP; d.dst = wb + WE_UQ + (size_t)j * QP * QLR; d.gamma = P.in[7] + j * QLR; d.mode = 1; break;
            case 2: d.W = P.in[10] + (size_t)j * KVLR * KVP; d.K = KVLR; d.N = KVP; d.Npad = KVP; d.dst = wb + WE_UKV + (size_t)j * KVP * KVLR; d.gamma = P.in[8] + j * KVLR; break;
            case 3: d.W = P.in[15] + (size_t)j * DM * DM; d.K = DM; d.N = DM; d.Npad = DM; d.dst = wb + WE_MOUT + (size_t)j * DM * DM; break;
            case 4: d.W = P.in[16] + (size_t)j * DM * ZP; d.K = DM; d.N = ZP; d.Npad = ZP; d.dst = wb + WE_GIN + (size_t)j * ZP * DM; d.gamma = P.in[3] + (2 * j + 1) * DM; break;
            default: d.W = P.in[21] + (size_t)j * 2048 * DM; d.K = 2048; d.N = DM; d.Npad = DM; d.dst = wb + WE_GOUT + (size_t)j * DM * 2048; break;
        }
    } else {
        const int i = (id - 12) & 3, f = (id - 12) >> 2;
        switch (f) {
            case 0: d.W = P.in[22] + (size_t)i * DM * DFF; d.K = DM; d.N = DFF; d.Npad = DFF; d.dst = wb + WE_UP + (size_t)i * DFF * DM; d.gamma = P.in[4] + i * DM; break;
            case 1: d.W = P.in[23] + (size_t)i * DFF * DM; d.K = DFF; d.N = DM; d.Npad = DM; d.dst = wb + WE_DN + (size_t)i * DM * DFF; break;
            case 2: d.W = P.in[24] + (size_t)i * DM * DM; d.K = DM; d.N = DM; d.Npad = DM; d.dst = wb + WE_GATE + (size_t)i * DM * DM; d.gamma = P.in[5] + i * DM; break;
            default: d.W = P.in[25] + (size_t)i * PLE * DM; d.K = PLE; d.N = DM; d.Npad = DM; d.dst = wb + WE_PROJ + (size_t)i * DM * PLE; break;
        }
    }
    d.items = (d.K / 64) * (d.Npad / 32);
    return d;
}
__device__ __forceinline__ void conv_item(const WDesc& d, int item, float* scr, int lane) {
    const int nblk = d.Npad / 32, kb = item / nblk, nb = item % nblk, k0 = 64 * kb, n0 = 32 * nb;
    int sn0 = n0;
    if (d.mode == 1) { if (n0 < 1024) sn0 = (n0 >> 7) * 192 + (n0 & 127); else { const int r = n0 - 1024; sn0 = (r >> 6) * 192 + 128 + (r & 63); } }
    const bool valid = sn0 < d.N;
#pragma unroll
    for (int i = 0; i < 32; ++i) { const int kk = 2 * i + (lane >> 5);
        float v = valid ? d.W[(size_t)(k0 + kk) * d.N + sn0 + (lane & 31)] : 0.f;
        if (d.gamma) v *= d.gamma[k0 + kk];
        scr[kk * 33 + (lane & 31)] = v; }
    asm volatile("s_waitcnt lgkmcnt(0)" ::: "memory");
    const int c = lane & 7;
#pragma unroll
    for (int j = 0; j < 4; ++j) { const int n = (lane >> 3) + 8 * j; const float* s = scr + (8 * c) * 33 + n;
        u32x4 o; o.x = cvt_pk_bf16(s[0 * 33], s[1 * 33]); o.y = cvt_pk_bf16(s[2 * 33], s[3 * 33]); o.z = cvt_pk_bf16(s[4 * 33], s[5 * 33]); o.w = cvt_pk_bf16(s[6 * 33], s[7 * 33]);
        *(u32x4*)(d.dst + (size_t)(n0 + n) * d.K + k0 + 8 * c) = o; }
    asm volatile("s_waitcnt lgkmcnt(0)" ::: "memory");
}
__device__ __forceinline__ void p0_prologue(int tid, const Params& P, unsigned char* lds) {
    const int lane = tid & 63, wave = __builtin_amdgcn_readfirstlane(tid >> 6);
    const int gw = blockIdx.x * 8 + wave, NGW = gridDim.x * 8;
    const size_t gt = (size_t)blockIdx.x * 512 + tid, NGT = (size_t)gridDim.x * 512;
    float* scr = (float*)(lds + wave * 8704);
    int total = 0;
    for (int id = 0; id < 28; ++id) total += wdesc(P, id).items;
    for (int it = gw; it < total; it += NGW) {
        int r = it, id = 0; WDesc d = wdesc(P, 0);
        while (r >= d.items) { r -= d.items; ++id; d = wdesc(P, id); }
        conv_item(d, r, scr, lane);
    }
    { unsigned* bw = (unsigned*)(P.ws + OFF_BAR); for (size_t i = gt; i < XCD_BAR_WORDS; i += NGT) bw[i] = 0u; }
    { const f32x4* src = (const f32x4*)P.in[1]; u32x4* dst = (u32x4*)(P.ws + OFF_PB); const size_t n8 = (size_t)DEPTH * T * PLE / 8;
      for (size_t i0 = gt; i0 < n8; i0 += 4 * NGT) {
          f32x4 a[4], b[4];
#pragma unroll
          for (int u = 0; u < 4; ++u) { const size_t i = i0 + u * NGT; if (i < n8) { a[u] = src[2 * i]; b[u] = src[2 * i + 1]; } }
#pragma unroll
          for (int u = 0; u < 4; ++u) { const size_t i = i0 + u * NGT; if (i < n8) { u32x4 w; w.x = cvt_pk_bf16(a[u][0], a[u][1]); w.y = cvt_pk_bf16(a[u][2], a[u][3]); w.z = cvt_pk_bf16(b[u][0], b[u][1]); w.w = cvt_pk_bf16(b[u][2], b[u][3]); dst[i] = w; } } } }
    { float* ssp = (float*)(P.ws + OFF_SS); bf16_t* hb = (bf16_t*)(P.ws + OFF_HB);
#pragma unroll 2
      for (int row = gw; row < T; row += NGW) {
          const f32x4* xr = (const f32x4*)(P.in[0] + (size_t)row * DM) + lane; float s = 0.f;
          unsigned long long* o8 = (unsigned long long*)(hb + (size_t)row * DM) + lane;
#pragma unroll
          for (int j = 0; j < 4; ++j) { const f32x4 v = xr[64 * j]; s += (v[0] * v[0] + v[1] * v[1]) + (v[2] * v[2] + v[3] * v[3]);
              o8[64 * j] = (unsigned long long)cvt_pk_bf16(v[0], v[1]) | ((unsigned long long)cvt_pk_bf16(v[2], v[3]) << 32); }
          s = wave_sum(s); if (lane < 16) ssp[(size_t)row * 16 + lane] = (lane == 0) ? s : 0.f; } }
}

__device__ __forceinline__ void r2_phase(int tid, const Params& P, int j) {
    const int lane = tid & 63, wave = __builtin_amdgcn_readfirstlane(tid >> 6);
    const int gw = blockIdx.x * 8 + wave, NGW = gridDim.x * 8;
    bf16_t* Q = (bf16_t*)(P.ws + OFF_FF + FF_Q); bf16_t* KV = (bf16_t*)(P.ws + OFF_FF + FF_KV); bf16_t* LAT = (bf16_t*)(P.ws + OFF_FF + FF_LAT);
    const float* gqn = P.in[11] + j * 128; const float* gqr = P.in[12] + j * 64; const float* gkn = P.in[13] + j * 128; const float* gkr = P.in[14] + j * 64;
    const int* pos = (const int*)P.in[2];
    float g_qn[2][8], g_kn[2][8], g_qr[8], g_kr[8];
#pragma unroll
    for (int i = 0; i < 2; ++i)
#pragma unroll
        for (int e = 0; e < 8; ++e) { const int d = (8 * lane + 512 * i + e) & 127; g_qn[i][e] = gqn[d] * QSCALE; g_kn[i][e] = gkn[d]; }
#pragma unroll
    for (int e = 0; e < 8; ++e) { const int r = 8 * (lane & 7) + e; g_qr[e] = gqr[r] * QSCALE; g_kr[e] = gkr[r]; }
    const double invf = kInvFreq[lane & 31];
#pragma unroll 2
    for (int row = gw; row < T; row += NGW) {
        float rq, rkv;
        { u32x4 z4 = {0u, 0u, 0u, 0u};
          const u32x4 lq = (lane < 48) ? *(const u32x4*)(LAT + (size_t)row * LATP + 8 * lane) : z4;
          const u32x4 lk = (lane < 32) ? *(const u32x4*)(LAT + (size_t)row * LATP + QLR + 8 * lane) : z4;
          float a[8], b[8]; unpack8(lq, a); unpack8(lk, b); float sa = 0.f, sb = 0.f;
#pragma unroll
          for (int e = 0; e < 8; ++e) { sa += a[e] * a[e]; sb += b[e] * b[e]; }
          rq = rsqrtf(wave_sum(sa) * (1.0f / QLR) + EPS); rkv = rsqrtf(wave_sum(sb) * (1.0f / KVLR) + EPS); }
        const double ang = (double)pos[row] * invf; double rev = ang * 0.15915494309189535; rev -= floor(rev);
        const float cs = __builtin_amdgcn_cosf((float)rev), sn = __builtin_amdgcn_sinf((float)rev);
        float cj[8], sj[8];
#pragma unroll
        for (int e = 0; e < 8; ++e) { cj[e] = __shfl(cs, 8 * (lane & 3) + e); sj[e] = __shfl(sn, 8 * (lane & 3) + e); }
#pragma unroll
        for (int i = 0; i < 2; ++i) {
            const int idx = 8 * lane + 512 * i, head = idx >> 7, d = idx & 127;
            u32x4* qp = (u32x4*)(Q + (size_t)row * QP + idx); u32x4* kp = (u32x4*)(KV + (size_t)row * KVP + head * 256 + d);
            float a[8], b[8]; unpack8(*qp, a); unpack8(*kp, b);
            { u32x4* vp = (u32x4*)(KV + (size_t)row * KVP + head * 256 + 128 + d); float vv[8]; unpack8(*vp, vv);
#pragma unroll
              for (int e = 0; e < 8; ++e) vv[e] *= rkv;
              *vp = pack8(vv); }
            float sa = 0.f, sb = 0.f;
#pragma unroll
            for (int e = 0; e < 8; ++e) { a[e] *= rq; b[e] *= rkv; sa += a[e] * a[e]; sb += b[e] * b[e]; }
#pragma unroll
            for (int o = 1; o < 16; o <<= 1) { sa += __shfl_xor(sa, o); sb += __shfl_xor(sb, o); }
            const float ra = rsqrtf(sa * (1.0f / 128) + EPS), rb = rsqrtf(sb * (1.0f / 128) + EPS);
#pragma unroll
            for (int e = 0; e < 8; ++e) { a[e] = a[e] * ra * g_qn[i][e]; b[e] = b[e] * rb * g_kn[i][e]; }
            *qp = pack8(a); *kp = pack8(b);
        }
        {
            u32x4* qp = (u32x4*)(Q + (size_t)row * QP + 1024 + 8 * lane); u32x4* kp = (u32x4*)(LAT + (size_t)row * LATP + 640 + 8 * (lane & 7));
            float a[8], b[8]; unpack8(*qp, a); unpack8(*kp, b);
            float sa = 0.f, sb = 0.f;
#pragma unroll
            for (int e = 0; e < 8; ++e) { a[e] *= rq; sa += a[e] * a[e]; sb += b[e] * b[e]; }
#pragma unroll
            for (int o = 1; o < 8; o <<= 1) { sa += __shfl_xor(sa, o); sb += __shfl_xor(sb, o); }
            const float ra = rsqrtf(sa * (1.0f / 64) + EPS), rb = rsqrtf(sb * (1.0f / 64) + EPS);
            const bool hi = (lane & 4) != 0;
#pragma unroll
            for (int e = 0; e < 8; ++e) {
                const float ya = a[e] * ra * g_qr[e], yb = b[e] * rb * g_kr[e];
                const float pa = __shfl_xor(ya, 4), pb = __shfl_xor(yb, 4);
                a[e] = hi ? (ya * cj[e] + pa * sj[e]) : (ya * cj[e] - pa * sj[e]);
                b[e] = hi ? (yb * cj[e] + pb * sj[e]) : (yb * cj[e] - pb * sj[e]);
            }
            *qp = pack8(a); if (lane < 8) *kp = pack8(b);
        }
    }
}

constexpr int KROW = 400, VROW = 288, KTILE = 64 * KROW, VTILE = 64 * VROW;
__device__ __forceinline__ void attn_unit(int tid, unsigned char* lds, const bf16_t* Q, const bf16_t* KV, const bf16_t* KR, bf16_t* O, int b, int h, int qb) {
    const int lane = tid & 63, w = __builtin_amdgcn_readfirstlane(tid >> 6), r = lane & 15, g = lane >> 4;
    const int row0 = b * SEQ + qb * 256, qrow = row0 + 32 * w + r;
    bf16x8 qf[2][6];
#pragma unroll
    for (int rg = 0; rg < 2; ++rg) {
#pragma unroll
        for (int ks = 0; ks < 4; ++ks) qf[rg][ks] = *(const bf16x8*)(Q + (size_t)(qrow + 16 * rg) * QP + h * 128 + 32 * ks + 8 * g);
#pragma unroll
        for (int ks = 0; ks < 2; ++ks) qf[rg][4 + ks] = *(const bf16x8*)(Q + (size_t)(qrow + 16 * rg) * QP + 1024 + h * 64 + 32 * ks + 8 * g);
    }
    const int ntiles = 4 * qb + 4, last_tile = 4 * qb + (w >> 1);
    const int kn_row0 = tid >> 4, kn_ch = tid & 15;
    const int kr_row = tid >> 3, kr_ch = tid & 7;
    const bf16_t* gk = KV + (size_t)(b * SEQ) * KVP + h * 256;
    const bf16_t* gr = KR + (size_t)(b * SEQ) * LATP;
    u32x4 sk0, sk1, sr, sv0, sv1;
#define ATT_LOAD(t) do { const size_t kb = (size_t)(t) * 64; \
        sk0 = *(const u32x4*)(gk + (kb + kn_row0) * KVP + kn_ch * 8); sk1 = *(const u32x4*)(gk + (kb + kn_row0 + 32) * KVP + kn_ch * 8); \
        sv0 = *(const u32x4*)(gk + (kb + kn_row0) * KVP + 128 + kn_ch * 8); sv1 = *(const u32x4*)(gk + (kb + kn_row0 + 32) * KVP + 128 + kn_ch * 8); \
        sr = *(const u32x4*)(gr + (kb + kr_row) * LATP + kr_ch * 8); } while (0)
#define ATT_STORE(buf) do { unsigned char* kb_ = lds + (buf) * KTILE; unsigned char* vb_ = lds + 2 * KTILE + (buf) * VTILE; \
        *(u32x4*)(kb_ + kn_row0 * KROW + kn_ch * 16) = sk0; *(u32x4*)(kb_ + (kn_row0 + 32) * KROW + kn_ch * 16) = sk1; \
        *(u32x4*)(kb_ + kr_row * KROW + 256 + kr_ch * 16) = sr; \
        *(u32x4*)(vb_ + kn_row0 * VROW + kn_ch * 16) = sv0; *(u32x4*)(vb_ + (kn_row0 + 32) * VROW + kn_ch * 16) = sv1; } while (0)
    f32x4 o[2][8];
#pragma unroll
    for (int rg = 0; rg < 2; ++rg)
#pragma unroll
        for (int i = 0; i < 8; ++i) o[rg][i] = (f32x4){0.f, 0.f, 0.f, 0.f};
    float m[2] = {-1e30f, -1e30f}, l[2] = {0.f, 0.f};
    ATT_LOAD(0); ATT_STORE(0);
    __syncthreads();
    const int q4 = r >> 2, p4 = lane & 3;
    const int vtr_off = (4 * g + q4) * VROW + (4 * p4) * 2;
    const int qidx = qb * 256 + 32 * w + r;
    for (int t = 0; t < ntiles; ++t) {
        const bool more = (t + 1 < ntiles);
        if (more) ATT_LOAD(t + 1);
        if (t <= last_tile) {
            const unsigned char* Kb = lds + (t & 1) * KTILE; const unsigned char* Vb = lds + 2 * KTILE + (t & 1) * VTILE;
            f32x4 p[2][4];
#pragma unroll
            for (int kb = 0; kb < 4; ++kb) {
                p[0][kb] = (f32x4){0.f, 0.f, 0.f, 0.f}; p[1][kb] = (f32x4){0.f, 0.f, 0.f, 0.f};
#pragma unroll
                for (int ks = 0; ks < 6; ++ks) {
                    const bf16x8 a = *(const bf16x8*)(Kb + (16 * kb + r) * KROW + ks * 64 + g * 16);
                    p[0][kb] = __builtin_amdgcn_mfma_f32_16x16x32_bf16(a, qf[0][ks], p[0][kb], 0, 0, 0);
                    p[1][kb] = __builtin_amdgcn_mfma_f32_16x16x32_bf16(a, qf[1][ks], p[1][kb], 0, 0, 0);
                }
            }
            const bool diag = (t * 64 + 63 > qb * 256 + 32 * w);
            bf16x8 pb[2][2];
#pragma unroll
            for (int rg = 0; rg < 2; ++rg) {
                if (diag) {
#pragma unroll
                    for (int kb = 0; kb < 4; ++kb)
#pragma unroll
                        for (int i = 0; i < 4; ++i) { const int kk = t * 64 + 16 * kb + 4 * g + i; if (kk > qidx + 16 * rg) p[rg][kb][i] = -1e30f; }
                }
                float mx = fmaxf(fmaxf(p[rg][0][0], p[rg][0][1]), fmaxf(p[rg][0][2], p[rg][0][3]));
#pragma unroll
                for (int kb = 1; kb < 4; ++kb) mx = fmaxf(mx, fmaxf(fmaxf(p[rg][kb][0], p[rg][kb][1]), fmaxf(p[rg][kb][2], p[rg][kb][3])));
                mx = fmaxf(mx, __shfl_xor(mx, 16)); mx = fmaxf(mx, __shfl_xor(mx, 32));
                if (!__all(mx <= m[rg] + 8.0f)) {
                    const float mn = fmaxf(m[rg], mx), alpha = fast_exp2(m[rg] - mn); m[rg] = mn;
                    l[rg] *= alpha;
#pragma unroll
                    for (int i = 0; i < 8; ++i) o[rg][i] *= alpha;
                }
                const float mref = m[rg];
                float rsum = 0.f;
#pragma unroll
                for (int kb = 0; kb < 4; ++kb)
#pragma unroll
                    for (int i = 0; i < 4; ++i) { p[rg][kb][i] = fast_exp2(p[rg][kb][i] - mref); rsum += p[rg][kb][i]; }
                l[rg] += rsum;
#pragma unroll
                for (int kk = 0; kk < 2; ++kk) {
                    u32x4 pw; pw.x = cvt_pk_bf16(p[rg][2 * kk][0], p[rg][2 * kk][1]); pw.y = cvt_pk_bf16(p[rg][2 * kk][2], p[rg][2 * kk][3]);
                    pw.z = cvt_pk_bf16(p[rg][2 * kk + 1][0], p[rg][2 * kk + 1][1]); pw.w = cvt_pk_bf16(p[rg][2 * kk + 1][2], p[rg][2 * kk + 1][3]);
                    pb[rg][kk] = __builtin_bit_cast(bf16x8, pw);
                }
            }
#pragma unroll
            for (int db = 0; db < 8; ++db)
#pragma unroll
                for (int kk = 0; kk < 2; ++kk) {
                    const LAS unsigned char* vp = (const LAS unsigned char*)(Vb + vtr_off + (32 * kk) * VROW + db * 32);
                    const s16x4 lo = __builtin_bit_cast(s16x4, __builtin_amdgcn_ds_read_tr16_b64_v4i16((LAS s16x4*)vp));
                    const s16x4 hi = __builtin_bit_cast(s16x4, __builtin_amdgcn_ds_read_tr16_b64_v4i16((LAS s16x4*)(vp + 16 * VROW)));
                    const bf16x8 vf = __builtin_shufflevector(lo, hi, 0, 1, 2, 3, 4, 5, 6, 7);
                    o[0][db] = __builtin_amdgcn_mfma_f32_16x16x32_bf16(vf, pb[0][kk], o[0][db], 0, 0, 0);
                    o[1][db] = __builtin_amdgcn_mfma_f32_16x16x32_bf16(vf, pb[1][kk], o[1][db], 0, 0, 0);
                }
        }
        if (more) ATT_STORE((t + 1) & 1);
        __syncthreads();
    }
#pragma unroll
    for (int rg = 0; rg < 2; ++rg) {
        float ls = l[rg]; ls += __shfl_xor(ls, 16); ls += __shfl_xor(ls, 32);
        const float inv = fast_rcp(ls);
        bf16_t* orow = O + (size_t)(qrow + 16 * rg) * QP + h * 128 + 4 * g;
#pragma unroll
        for (int db = 0; db < 8; ++db) {
            u32x2 wv; wv.x = cvt_pk_bf16(o[rg][db][0] * inv, o[rg][db][1] * inv); wv.y = cvt_pk_bf16(o[rg][db][2] * inv, o[rg][db][3] * inv);
            *(u32x2*)(orow + 16 * db) = wv;
        }
    }
#undef ATT_LOAD
#undef ATT_STORE
}
__device__ __forceinline__ void attn_phase(int tid, const Params& P, unsigned char* lds) {
    bf16_t* Q = (bf16_t*)(P.ws + OFF_FF + FF_Q); const bf16_t* KV = (const bf16_t*)(P.ws + OFF_FF + FF_KV); const bf16_t* KR = (const bf16_t*)(P.ws + OFF_FF + FF_LAT) + 640;
    for (int pr = blockIdx.x; pr < 512; pr += gridDim.x) {
        const int bh = pr >> 2, x = pr & 3, b = bh >> 3, h = bh & 7;
        attn_unit(tid, lds, Q, KV, KR, Q, b, h, 7 - x);
        attn_unit(tid, lds, Q, KV, KR, Q, b, h, x);
    }
}

constexpr int SROW = 576;
constexpr int SGU_STAT_OFF = 128 * SROW;
constexpr int SGU_W_OFF = SGU_STAT_OFF + 2048, SWROW = 272;
__device__ __forceinline__ void sgu_phase(int tid, const Params& P, unsigned char* lds, int j) {
    const int lane = tid & 63, w = __builtin_amdgcn_readfirstlane(tid >> 6), r = lane & 31, hh = lane >> 5;
    bf16_t* Z = (bf16_t*)(P.ws + OFF_FF);
    const float* lng = P.in[17] + j * 2048; const float* lnb = P.in[18] + j * 2048;
    const float* wsp = P.in[19] + (size_t)j * 8 * 128 * 128; const float* bsp = P.in[20] + j * 8 * 128;
    const int q4 = (lane & 15) >> 2, p4 = lane & 3, colblk = (lane >> 4) & 1;
    f32x2* stl = (f32x2*)(lds + SGU_STAT_OFF);
    for (int unit = blockIdx.x; unit < 256; unit += gridDim.x) {
        const int row0 = unit * 128;
        for (int rr0 = 0; rr0 < 16; rr0 += 4) {
            u32x4 raw[4][4];
#pragma unroll
            for (int a = 0; a < 4; ++a)
#pragma unroll
                for (int i = 0; i < 4; ++i) raw[a][i] = *(const u32x4*)(Z + (size_t)(row0 + 16 * w + rr0 + a) * ZP + 2048 + 8 * lane + 512 * i);
#pragma unroll
            for (int a = 0; a < 4; ++a) {
                float s1 = 0.f, s2 = 0.f;
#pragma unroll
                for (int i = 0; i < 4; ++i) { float v[8]; unpack8(raw[a][i], v);
#pragma unroll
                    for (int e = 0; e < 8; ++e) { s1 += v[e]; s2 += v[e] * v[e]; } }
                s1 = wave_sum(s1); s2 = wave_sum(s2);
                const float mu = s1 * (1.0f / 2048), var = s2 * (1.0f / 2048) - mu * mu;
                if (lane == 0) stl[16 * w + rr0 + a] = (f32x2){mu, rsqrtf(fmaxf(var, 0.f) + EPS)};
            }
        }
        __syncthreads();
        for (int g = 0; g < 8; ++g) {
#pragma unroll 2
            for (int i = 0; i < 8; ++i) {
                const int chunk = tid + 512 * i, row = chunk >> 5, ch = chunk & 31, col = g * 256 + ch * 8;
                float v[8]; unpack8(*(const u32x4*)(Z + (size_t)(row0 + row) * ZP + 2048 + col), v);
                const f32x2 st = stl[row]; const float mu = st.x, rstd = st.y;
                const f32x4 g0 = *(const f32x4*)(lng + col), g1 = *(const f32x4*)(lng + col + 4), b0 = *(const f32x4*)(lnb + col), b1 = *(const f32x4*)(lnb + col + 4);
#pragma unroll
                for (int e = 0; e < 4; ++e) { v[e] = (v[e] - mu) * rstd * g0[e] + b0[e]; v[4 + e] = (v[4 + e] - mu) * rstd * g1[e] + b1[e]; }
                *(u32x4*)(lds + row * SROW + ch * 16) = pack8(v);
            }
            {
                const float* wg = wsp + (size_t)g * 128 * 128;
                f32x4 w0[4], w1[4];
#pragma unroll
                for (int i = 0; i < 4; ++i) { const int c = tid + 512 * i, t = c >> 4, s0 = (c & 15) * 8; w0[i] = *(const f32x4*)(wg + t * 128 + s0); w1[i] = *(const f32x4*)(wg + t * 128 + s0 + 4); }
#pragma unroll
                for (int i = 0; i < 4; ++i) { const int c = tid + 512 * i, t = c >> 4, s0 = (c & 15) * 8;
                    float wv[8] = {w0[i][0], w0[i][1], w0[i][2], w0[i][3], w1[i][0], w1[i][1], w1[i][2], w1[i][3]};
#pragma unroll
                    for (int e = 0; e < 8; ++e) if (s0 + e > t) wv[e] = 0.f;
                    *(u32x4*)(lds + SGU_W_OFF + t * SWROW + s0 * 2) = pack8(wv); }
            }
            __syncthreads();
            bf16x8 af[8];
#pragma unroll
            for (int ks = 0; ks < 8; ++ks) {
                const LAS unsigned char* vp = (const LAS unsigned char*)(lds + (16 * ks + 8 * hh + q4) * SROW + (32 * w + 16 * colblk + 4 * p4) * 2);
                const s16x4 lo = __builtin_bit_cast(s16x4, __builtin_amdgcn_ds_read_tr16_b64_v4i16((LAS s16x4*)vp));
                const s16x4 hi = __builtin_bit_cast(s16x4, __builtin_amdgcn_ds_read_tr16_b64_v4i16((LAS s16x4*)(vp + 4 * SROW)));
                af[ks] = __builtin_shufflevector(lo, hi, 0, 1, 2, 3, 4, 5, 6, 7);
            }
#pragma unroll
            for (int tb = 0; tb < 4; ++tb) {
                f32x16 acc;
#pragma unroll
                for (int e = 0; e < 16; ++e) acc[e] = 0.f;
                const int t = 32 * tb + r;
#pragma unroll
                for (int ks = 0; ks < 8; ++ks) {
                    if (ks <= 2 * tb + 1) {
                        const bf16x8 bfr = *(const bf16x8*)(lds + SGU_W_OFF + t * SWROW + (16 * ks + 8 * hh) * 2);
                        acc = __builtin_amdgcn_mfma_f32_32x32x16_bf16(af[ks], bfr, acc, 0, 0, 0);
                    }
                }
                const float bias = bsp[g * 128 + t];
                bf16_t* up = Z + (size_t)(row0 + t) * ZP + g * 256 + 32 * w + 4 * hh;
#pragma unroll
                for (int i4 = 0; i4 < 4; ++i4) {
                    const u32x2 uu = *(const u32x2*)(up + 8 * i4);
                    u32x2 y; y.x = cvt_pk_bf16(bflo(uu.x) * (acc[4 * i4] + bias), bfhi(uu.x) * (acc[4 * i4 + 1] + bias));
                    y.y = cvt_pk_bf16(bflo(uu.y) * (acc[4 * i4 + 2] + bias), bfhi(uu.y) * (acc[4 * i4 + 3] + bias));
                    *(u32x2*)(up + 8 * i4) = y;
                }
            }
            __syncthreads();
        }
    }
}


#define XB_TMO      128
#define XB_XCNT(j)  (256  + 64 * (j))
#define XB_XSUB(j)  (1280 + 64 * (j))
#define XB_XGEN(j)  (2304 + 64 * (j))
#define XB_TOP      3328
#define XB_TOPGEN   3392
#define XB_SPIN_CAP (1u << 22)
__device__ __forceinline__ unsigned xb_ld(unsigned* p)              { return __hip_atomic_load(p, __ATOMIC_RELAXED, __HIP_MEMORY_SCOPE_AGENT); }
__device__ __forceinline__ unsigned xb_add(unsigned* p, unsigned v) { return __hip_atomic_fetch_add(p, v, __ATOMIC_RELAXED, __HIP_MEMORY_SCOPE_AGENT); }
__device__ __forceinline__ unsigned xb_xcc_id() { return (unsigned)__builtin_amdgcn_s_getreg((3 << 11) | 20) & 0xFu; }
#define XB_SPIN(cond, bar) do { unsigned _sp = 0; while (cond) { __builtin_amdgcn_s_sleep(1); \
    if ((++_sp & 255u) == 0u) { if (xb_ld(&(bar)[XB_TMO])) break; if (_sp > XB_SPIN_CAP) { atomicAdd(&(bar)[XB_TMO], 1u); break; } } } } while (0)
__device__ __forceinline__ void xcd_barrier_complete(unsigned* bar, unsigned x, unsigned& nloc, unsigned& nx) {
    const unsigned G = gridDim.x;
    unsigned sum, cnt, mine, sp = 0u;
    for (;;) {
        sum = 0u; cnt = 0u; mine = 0u;
#pragma unroll
        for (unsigned j = 0; j < 16; ++j) { const unsigned c = xb_ld(&bar[XB_XCNT(j)]); sum += c; cnt += (c > 0u) ? 1u : 0u; mine = (j == x) ? c : mine; }
        if (sum == G) break;
        __builtin_amdgcn_s_sleep(1);
        if ((++sp & 255u) == 0u) { if (xb_ld(&bar[XB_TMO])) break; if (sp > XB_SPIN_CAP) { atomicAdd(&bar[XB_TMO], 1u); break; } }
    }
    nloc = mine > 0u ? mine : 1u; nx = cnt > 0u ? cnt : 1u;
}
__device__ __forceinline__ void xcd_barrier(unsigned* bar, unsigned x, volatile LAS unsigned* st) {
    asm volatile("s_waitcnt vmcnt(0)" ::: "memory");
    __syncthreads();
    if (threadIdx.x == 0) {
        __builtin_amdgcn_s_waitcnt(0);
        unsigned nloc = st[0], nx = st[1];
        if (nloc == 0u) { xcd_barrier_complete(bar, x, nloc, nx); st[0] = nloc; st[1] = nx; }
        const unsigned old = xb_add(&bar[XB_XSUB(x)], 1u);
        const unsigned gen = old / nloc;
        if (old + 1u == (gen + 1u) * nloc) {
            __builtin_amdgcn_fence(__ATOMIC_RELEASE, "agent");
            asm volatile("s_waitcnt vmcnt(0)" ::: "memory");
            const unsigned og = xb_add(&bar[XB_TOP], 1u);
            const unsigned tg = og / nx;
            if (og + 1u == (tg + 1u) * nx) xb_add(&bar[XB_TOPGEN], 1u);
            else XB_SPIN(xb_ld(&bar[XB_TOPGEN]) == tg, bar);
            __builtin_amdgcn_fence(__ATOMIC_ACQUIRE, "agent");
            xb_add(&bar[XB_XGEN(x)], 1u);
            asm volatile("s_waitcnt vmcnt(0)" ::: "memory");
        } else {
            XB_SPIN(xb_ld(&bar[XB_XGEN(x)]) == gen, bar);
            __builtin_amdgcn_fence(__ATOMIC_ACQUIRE, "agent");
            asm volatile("s_waitcnt vmcnt(0)" ::: "memory");
        }
    }
    __syncthreads();
}

constexpr int NPHASE = 1 + 9 * DEPTH;
__device__ __forceinline__ int mktid(int wv0) { int t; asm volatile("v_mbcnt_lo_u32_b32 %0, -1, 0\n\tv_mbcnt_hi_u32_b32 %0, -1, %0" : "=v"(t)); return (t + wv0 * 64) & 511; }
__device__ __forceinline__ Params load_params() {
    Params P{};
#if defined(__HIP_DEVICE_COMPILE__)
    typedef const __attribute__((address_space(4))) unsigned long long* kp_t;
    kp_t kp = (kp_t)__builtin_amdgcn_kernarg_segment_ptr(); asm volatile("" : "+s"(kp));
#pragma unroll
    for (int i = 0; i < 26; ++i) P.in[i] = (const float*)kp[i];
    P.out = (float*)kp[26]; P.ws = (unsigned char*)kp[27];
#endif
    return P;
}
__host__ __device__ __forceinline__ bool phase_nonempty(int ph) {
    if (ph == 0) return true;
    const int layer = (ph - 1) / 9, slot = (ph - 1) % 9;
    if ((layer & 1) && (slot == 3 || slot == 4)) return false;
    return true;
}

__global__ void __launch_bounds__(512) fwd_megakernel(Params Parg) {
    extern __shared__ __attribute__((aligned(16))) unsigned char lds[];
    LAS unsigned char* ldsl = (LAS unsigned char*)lds;
    const int wv0 = __builtin_amdgcn_readfirstlane((int)threadIdx.x >> 6);
    volatile LAS unsigned* bst = (volatile LAS unsigned*)(ldsl + 131072);
    if (threadIdx.x == 0) { bst[0] = 0u; bst[1] = 0u; }
    __syncthreads();
    unsigned* const bar = (unsigned*)(Parg.ws + OFF_BAR);
    const unsigned xcc = xb_xcc_id();
    int nseam = 0;
    bool first = true;
    for (int ph = Parg.ph_lo; ph < Parg.ph_hi; ++ph) {
        if (!phase_nonempty(ph)) continue;
        if (!first) {
            if (nseam == 0) { cg::this_grid().sync(); if (threadIdx.x == 0) (void)xb_add(&bar[XB_XCNT(xcc)], 1u); }
            else xcd_barrier(bar, xcc, bst);
            ++nseam;
        }
        first = false;
        const Params P = load_params();
        unsigned char* ws = P.ws;
        bf16_t* wb = (bf16_t*)(ws + OFF_W);
        bf16_t* hb = (bf16_t*)(ws + OFF_HB);
        float* SS = (float*)(ws + OFF_SS);
        const int G = gridDim.x, c = blockIdx.x;
#ifndef NO_P0
        if (ph == 0) { p0_prologue(mktid(wv0), P, lds); continue; }
#else
        if (ph == 0) continue;
#endif
        const int layer = (ph - 1) / 9, slot = (ph - 1) % 9, j = layer >> 1;
        const bool mla = (layer & 1) == 0;
        float* ss_mix = SS; float* ss_ffn = SS; float* ss_ple = SS;
        float* ss_next = (layer + 1 < DEPTH) ? SS : nullptr;
        const float* hin = (layer == 0) ? P.in[0] : nullptr;
        pg8::StaticOrder S;
        if (slot == 0) {
            if (mla) {
                pg8::Gemm g{hb, wb + WE_DOWN + (size_t)j * LATP * DM, T, LATP, DM, DM}; S.init(T, LATP, G, c);
                pg8::EpiStore<0, 0> E{(bf16_t*)(ws + OFF_FF + FF_LAT), LATP, ss_mix, 1.0f / DM};
                pg8::gemm_phase(mktid(wv0), ldsl, g, S, E);
            } else {
                pg8::Gemm g{hb, wb + WE_GIN + (size_t)j * ZP * DM, T, ZP, DM, DM}; S.init(T, ZP, G, c);
                pg8::EpiStore<2, 0> E{(bf16_t*)(ws + OFF_FF), ZP, ss_mix, 1.0f / DM};
                pg8::gemm_phase(mktid(wv0), ldsl, g, S, E);
            }
        } else if (slot == 1) {
            if (mla) {
                { pg8::Gemm g{(const bf16_t*)(ws + OFF_FF + FF_LAT), wb + WE_UQ + (size_t)j * QP * QLR, T, QP, QLR, LATP}; S.init(T, QP, G, c);
                  pg8::EpiStore<0, 0> E{(bf16_t*)(ws + OFF_FF + FF_Q), QP, nullptr, 0.f};
                  pg8::gemm_phase(mktid(wv0), ldsl, g, S, E); }
                { pg8::Gemm g{(const bf16_t*)(ws + OFF_FF + FF_LAT) + QLR, wb + WE_UKV + (size_t)j * KVP * KVLR, T, KVP, KVLR, LATP}; S.init(T, KVP, G, c);
                  pg8::EpiStore<0, 0> E{(bf16_t*)(ws + OFF_FF + FF_KV), KVP, nullptr, 0.f};
                  pg8::gemm_phase(mktid(wv0), ldsl, g, S, E); }
            } else {
#ifndef NO_SGU
                sgu_phase(mktid(wv0), P, lds, j);
#endif
            }
        } else if (slot == 2) {
            if (mla) {
#ifndef NO_R2
                r2_phase(mktid(wv0), P, j);
#endif
            } else {
                pg8::Gemm g{(const bf16_t*)(ws + OFF_FF), wb + WE_GOUT + (size_t)j * DM * 2048, T, DM, 2048, ZP}; S.init(T, DM, G, c);
                pg8::EpiRes<0> E{hin, nullptr, hb, ss_ffn, nullptr};
                pg8::gemm_phase(mktid(wv0), ldsl, g, S, E);
            }
        } else if (slot == 3) {
#ifndef NO_ATT
            attn_phase(mktid(wv0), P, lds);
#endif
        } else if (slot == 4) {
            pg8::Gemm g{(const bf16_t*)(ws + OFF_FF + FF_Q), wb + WE_MOUT + (size_t)j * DM * DM, T, DM, DM, QP}; S.init(T, DM, G, c);
            pg8::EpiRes<0> E{hin, nullptr, hb, ss_ffn, nullptr};
            pg8::gemm_phase(mktid(wv0), ldsl, g, S, E);
        } else if (slot == 5) {
            pg8::Gemm g{hb, wb + WE_UP + (size_t)layer * DFF * DM, T, DFF, DM, DM}; S.init(T, DFF, G, c);
            pg8::EpiStore<1, 0> E{(bf16_t*)(ws + OFF_FF), DFF, ss_ffn, 1.0f / DM};
            pg8::gemm_phase(mktid(wv0), ldsl, g, S, E);
        } else if (slot == 6) {
            pg8::Gemm g{(const bf16_t*)(ws + OFF_FF), wb + WE_DN + (size_t)layer * DM * DFF, T, DM, DFF, DFF}; S.init(T, DM, G, c);
            pg8::EpiRes<0> E{nullptr, nullptr, hb, ss_ple, nullptr};
            pg8::gemm_phase(mktid(wv0), ldsl, g, S, E);
        } else if (slot == 7) {
            pg8::Gemm g{hb, wb + WE_GATE + (size_t)layer * DM * DM, T, DM, DM, DM}; S.init(T, DM, G, c);
            pg8::EpiStore<3, 0> E{(bf16_t*)(ws + OFF_FF), DM, ss_ple, 1.0f / DM};
            pg8::gemm_phase(mktid(wv0), ldsl, g, S, E);
        } else {
            pg8::Gemm g{(const bf16_t*)(ws + OFF_PB) + (size_t)layer * T * PLE, wb + WE_PROJ + (size_t)layer * DM * PLE, T, DM, PLE, PLE}; S.init(T, DM, G, c);
            pg8::EpiRes<1> E{nullptr, (layer == DEPTH - 1) ? P.out : nullptr, hb, ss_next, (const bf16_t*)(ws + OFF_FF)};
            pg8::gemm_phase(mktid(wv0), ldsl, g, S, E);
        }
    }
    asm volatile("s_waitcnt vmcnt(0)" ::: "memory");
    __builtin_amdgcn_fence(__ATOMIC_RELEASE, "agent");
    asm volatile("s_waitcnt vmcnt(0)" ::: "memory");
}


#ifdef DBG_CHECK
__global__ void dbg_check(const bf16_t* A, int lda, const bf16_t* Bt, int K, const bf16_t* C, int ldc, int N, const float* ss, int act, float* out) {
    const unsigned s = blockIdx.x * blockDim.x + threadIdx.x;
    const unsigned hsh = s * 2654435761u; const int row = (hsh >> 8) % T; const int col = (s * 40503u + (hsh >> 3)) % N;
    float acc = 0.f;
    for (int k = 0; k < K; ++k) acc += bf2f(A[(size_t)row * lda + k]) * bf2f(Bt[(size_t)col * K + k]);
    if (ss) acc *= rsqrtf(ss[row] * (1.0f / DM) + EPS);
    if (act == 3) acc = 1.0f / (1.0f + expf(-acc));
    if (act == 1) { acc = fmaxf(acc, 0.f); acc *= acc; }
    const float got = bf2f(C[(size_t)row * ldc + col]);
    if (!(fabsf(got - acc) <= 0.03f + 0.03f * fabsf(acc))) atomicAdd(out + 4096, 1.0f);
}
#endif

#ifdef DBG_CHECK
__global__ void dbg_check_ss(const float* h, const float* ss, float* out) {
    const int row = blockIdx.x * blockDim.x + threadIdx.x; if (row >= T) return;
    float a = 0.f; for (int k = 0; k < DM; ++k) { const float v = h[(size_t)row * DM + k]; a += v * v; }
    const float got = ss[row];
    if (!(fabsf(got - a) <= 1e-3f * fabsf(a))) out[(size_t)row * DM] = 1e30f;
}
#endif

#ifdef DBG_CHECK
__global__ void dbg_zero(float* out) { out[4096 + threadIdx.x] = 0.f; out[8192 + threadIdx.x] = 0.f; }
__global__ void dbg_reduce(float* out) {
    float bc = 0.f, br = 0.f; int ic = 0, ir = 0;
    for (int i = 0; i < 256; ++i) { if (out[4096 + i] > bc) { bc = out[4096 + i]; ic = i; } if (out[8192 + i] > br) { br = out[8192 + i]; ir = i; } }
    float v = 1e6f * out[4096];
    for (int i = 0; i < 256; ++i) { out[4096 + i] = 0.f; out[8192 + i] = 0.f; }
    out[0] = v; out[1] = 1e-3f * bc; out[2] = 1e-3f * br;
}
#endif
constexpr int LDS_BYTES = 131072 + 256 + 2048;
extern "C" void kernel_launch(void* const* d_in, const int* in_sizes, int n_in, void* d_out, int out_size, void* d_ws, size_t ws_size, hipStream_t stream) {
    static int grid = 0;
    if (grid == 0) {
        if (n_in != 26 || out_size != T * DM || ws_size < WS_NEED) { fprintf(stderr, "kernel_launch: unexpected problem (n_in %d out %d ws %zu)\n", n_in, out_size, ws_size); grid = -1; return; }
        int dev = 0, cus = 0, per_cu = 0;
        hipGetDevice(&dev); hipDeviceGetAttribute(&cus, hipDeviceAttributeMultiprocessorCount, dev);
        hipFuncSetAttribute((const void*)fwd_megakernel, hipFuncAttributeMaxDynamicSharedMemorySize, LDS_BYTES);
        hipOccupancyMaxActiveBlocksPerMultiprocessor(&per_cu, (const void*)fwd_megakernel, 512, LDS_BYTES);
        if (per_cu < 1) { fprintf(stderr, "kernel_launch: occupancy query says %d blocks/CU\n", per_cu); per_cu = 1; }
        (void)hipGetLastError();
        grid = cus;
    }
    if (grid < 0) return;
    Params p{};
    for (int i = 0; i < 26; ++i) p.in[i] = (const float*)d_in[i];
    p.out = (float*)d_out; p.ws = (unsigned char*)d_ws;
#if ONE_LAUNCH
    p.ph_lo = 0; p.ph_hi = NPHASE;
    for (int rep = 0; rep < DBG_REPS; ++rep)
    { void* args[] = {&p}; hipError_t e = hipLaunchCooperativeKernel((const void*)fwd_megakernel, dim3(grid), dim3(512), args, LDS_BYTES, stream);
      if (e != hipSuccess) fprintf(stderr, "cooperative launch failed: %s (grid %d)\n", hipGetErrorString(e), grid); }
#else
#ifndef DBG_STOP
#define DBG_STOP (NPHASE - 1)
#endif
    for (int ph = 0; ph <= DBG_STOP; ++ph) {
        if (!phase_nonempty(ph)) continue;
        p.ph_lo = ph; p.ph_hi = ph + 1;
#ifdef DBG_NANFILL
        if (ph == DBG_NANFILL) (void)hipMemsetAsync((char*)d_ws + OFF_FF, 0xFF, 64 * MiB, stream);
#endif
        void* args[] = {&p}; hipError_t e = hipLaunchCooperativeKernel((const void*)fwd_megakernel, dim3(grid), dim3(512), args, LDS_BYTES, stream);
        if (e != hipSuccess) { fprintf(stderr, "cooperative launch failed: %s (grid %d, phase %d)\n", hipGetErrorString(e), grid, ph); break; }
    }
#ifdef DBG_CHECK
    { unsigned char* ws = (unsigned char*)d_ws; bf16_t* wb = (bf16_t*)(ws + OFF_W);
      dbg_zero<<<1, 256, 0, stream>>>((float*)d_out); DBG_CHECK; dbg_reduce<<<1, 1, 0, stream>>>((float*)d_out); }
#endif
#endif
}
```

```cpp
#include <hip/hip_runtime.h>
#include <hip/hip_cooperative_groups.h>
#include <cstdio>
#include <cstdint>
namespace cg = cooperative_groups;

#ifndef DBG_NOGATE
#define DBG_NOGATE 0
#endif
#ifndef DBG_GATE_NOSS
#define DBG_GATE_NOSS 0
#endif
#ifndef DBG_REPS
#define DBG_REPS 1
#endif
#ifndef ONE_LAUNCH
#define ONE_LAUNCH 1
#endif

#define LAS __attribute__((address_space(3)))
typedef unsigned short bf16_t;
typedef short bf16x8 __attribute__((ext_vector_type(8)));
typedef short s16x4 __attribute__((ext_vector_type(4)));
typedef float f32x4 __attribute__((ext_vector_type(4)));
typedef float f32x2 __attribute__((ext_vector_type(2)));
typedef float f32x16 __attribute__((ext_vector_type(16)));
typedef unsigned u32x4 __attribute__((ext_vector_type(4)));
typedef unsigned u32x2 __attribute__((ext_vector_type(2)));

constexpr int T = 32768, DM = 1024, SEQ = 2048, NB = 16, DFF = 4096, PLE = 256, DEPTH = 4;
constexpr int NH = 8, QLR = 384, KVLR = 256, ROPE = 64, LATP = 768;
constexpr int QP = 1536, KVP = 2048, ZP = 4096;
constexpr float EPS = 1e-6f;
constexpr float QSCALE = 0.07216878364870322f * 1.4426950408889634f;

constexpr size_t MiB = 1u << 20;
constexpr size_t OFF_SS = 0;
constexpr size_t OFF_W = 2621440;
constexpr size_t OFF_HB = 112 * MiB;
constexpr size_t OFF_FF = 176 * MiB;
constexpr size_t OFF_PB = 448 * MiB;
constexpr size_t WS_NEED = 512 * MiB;
constexpr size_t OFF_BAR = 2 * MiB;
#define XCD_BAR_WORDS 3456
constexpr size_t WE_DOWN = 0, WE_UQ = WE_DOWN + 2ull * LATP * DM, WE_UKV = WE_UQ + 2ull * QP * QLR, WE_MOUT = WE_UKV + 2ull * KVP * KVLR,
                 WE_GIN = WE_MOUT + 2ull * DM * DM, WE_GOUT = WE_GIN + 2ull * ZP * DM, WE_UP = WE_GOUT + 2ull * DM * 2048,
                 WE_DN = WE_UP + 4ull * DFF * DM, WE_GATE = WE_DN + 4ull * DM * DFF, WE_PROJ = WE_GATE + 4ull * DM * DM, WE_END = WE_PROJ + 4ull * DM * PLE;
static_assert(OFF_W + WE_END * 2 <= OFF_HB, "weights fit");
constexpr size_t FF_Q = 0, FF_KV = 96 * MiB, FF_LAT = 224 * MiB;

struct Params { const float* in[26]; float* out; unsigned char* ws; int ph_lo, ph_hi; };

typedef __bf16 bf16x2_t __attribute__((ext_vector_type(2)));
__device__ __forceinline__ unsigned cvt_pk_bf16(float lo, float hi) { const f32x2 v = {lo, hi}; return __builtin_bit_cast(unsigned, __builtin_convertvector(v, bf16x2_t)); }
__device__ __forceinline__ float bf2f(unsigned short b) { return __uint_as_float((unsigned)b << 16); }
__device__ __forceinline__ float bflo(unsigned u) { return __uint_as_float(u << 16); }
__device__ __forceinline__ float bfhi(unsigned u) { return __uint_as_float(u & 0xffff0000u); }
__device__ __forceinline__ float fast_rcp(float x) { return __builtin_amdgcn_rcpf(x); }
__device__ __forceinline__ float fast_exp2(float x) { return __builtin_amdgcn_exp2f(x); }
__device__ __forceinline__ float gelu_tanh(float x) { const float y = x + 0.044715f * x * x * x; return x * fast_rcp(1.0f + fast_exp2(-2.3022082f * y)); }
__device__ __forceinline__ float sigmoidf_(float x) { return fast_rcp(1.0f + fast_exp2(-1.4426950409f * x)); }

namespace pg8 {
constexpr int BM = 256, BK = 64, HALF = 128, HTB = HALF * BK * 2, STAGE_BYTES = 8 * HTB, NXCD = 8, WGM = 8;
__host__ __device__ __forceinline__ int lds_byte(int r, int c) { const int st = (r >> 4) * 2 + (c >> 5), rr = r & 15, cc = c & 31, ob = rr * 64 + cc * 2; return st * 1024 + (ob ^ (((ob >> 9) & 1) << 5)); }
__host__ __device__ __forceinline__ void stage_rc(int b, int& R, int& C) { const int st = b / 1024, sb = b % 1024, swz = sb ^ (((sb >> 9) & 1) << 5); R = (st >> 1) * 16 + swz / 64; C = (st & 1) * 32 + (swz % 64) / 2; }
__host__ __device__ __forceinline__ int perm32(int rho) { const int n = rho >> 4, i = rho & 15; return 8 * (i >> 2) + 4 * n + (i & 3); }
struct Unit { int pm, pn; };
struct RsCtx { const LAS float* tab; int pmA, pmB; };
struct Gemm { const bf16_t* A; const bf16_t* Bt; int M, N, K, lda; };
struct StaticOrder {
    int nM, nN, nwg, G, c;
    __device__ void init(int M, int N, int G_, int c_) { nM = M / BM; nN = N / BM; nwg = nM * nN; G = G_; c = c_; }
    __device__ bool next(int i, Unit& u) const {
        const long L = (long)i * G + c; if (L >= nwg) return false;
        int wgid = (int)L; { const int q = nwg / NXCD, r = nwg % NXCD, xcd = wgid % NXCD, off = wgid / NXCD; wgid = (xcd < r ? xcd * (q + 1) : r * (q + 1) + (xcd - r) * q) + off; }
        const int nig = WGM * nN, gid = wgid / nig, fm = gid * WGM, gsz = (nM - fm) < WGM ? (nM - fm) : WGM;
        u.pm = fm + ((wgid % nig) % gsz); u.pn = (wgid % nig) / gsz; return true;
    }
};

template <int ACT, int STATS> struct EpiStore {
    static constexpr bool PERM = true; static constexpr bool HAS_RS = true;
    bf16_t* O; int ldc; const float* ss; float inv_n;
    int sst, s0, s1; float* lst;
    __device__ __forceinline__ float row_scale(int row) const { const float* sp = ss + (size_t)row * sst; float t = 0.f; for (int i = s0; i < s1; ++i) t += sp[i]; return rsqrtf(t * inv_n + EPS); }
    __device__ __forceinline__ void operator()(const f32x4 (&acc)[2][2][4][2], const Unit& u, int wr, int wc, int fr, int fq, const RsCtx& rc) const {
        const int row0 = u.pm * BM + wr * 64 + fr, col0 = u.pn * BM + wc * 32 + 8 * fq;
        const int rslot = (u.pm == rc.pmA) ? 0 : ((u.pm == rc.pmB) ? 1 : -1);
#pragma unroll
        for (int ai = 0; ai < 2; ++ai)
#pragma unroll
            for (int m = 0; m < 4; ++m) {
                const int row = row0 + ai * HALF + m * 16;
                float rs = 1.0f;
                if (ss && rslot >= 0) rs = rc.tab[rslot * 256 + wr * 64 + fr + ai * HALF + m * 16];
                else if (ss) rs = row_scale(row);
#pragma unroll
                for (int bj = 0; bj < 2; ++bj) {
                    f32x4 v0 = acc[ai][bj][m][0] * rs, v1 = acc[ai][bj][m][1] * rs;
                    if (ACT == 1) {
#pragma unroll
                        for (int e = 0; e < 4; ++e) { const float a = fmaxf(v0[e], 0.f), b = fmaxf(v1[e], 0.f); v0[e] = a * a; v1[e] = b * b; }
                    }
                    if (ACT == 2) {
#pragma unroll
                        for (int e = 0; e < 4; ++e) { v0[e] = gelu_tanh(v0[e]); v1[e] = gelu_tanh(v1[e]); }
                    }
                    if (ACT == 3) {
#pragma unroll
                        for (int e = 0; e < 4; ++e) { v0[e] = sigmoidf_(v0[e]); v1[e] = sigmoidf_(v1[e]); }
                    }
                    u32x4 w; w.x = cvt_pk_bf16(v0[0], v0[1]); w.y = cvt_pk_bf16(v0[2], v0[3]); w.z = cvt_pk_bf16(v1[0], v1[1]); w.w = cvt_pk_bf16(v1[2], v1[3]);
                    *(u32x4*)(O + (size_t)row * ldc + col0 + bj * HALF) = w;
                    if (STATS == 1) {
                        float q = (v0[0] * v0[0] + v0[1] * v0[1]) + (v0[2] * v0[2] + v0[3] * v0[3]) + (v1[0] * v1[0] + v1[1] * v1[1]) + (v1[2] * v1[2] + v1[3] * v1[3]);
                        q += __shfl_xor(q, 16); q += __shfl_xor(q, 32);
                        if (fq == 0) lst[(size_t)row * 24 + u.pn * 8 + bj * 4 + wc] = q;
                    }
                }
                asm volatile("" ::: "memory");
            }
    }
};
template <int MODE> struct EpiRes {
    static constexpr bool PERM = true; static constexpr bool HAS_RS = false;
    static constexpr int MB = (MODE == 1) ? 2 : 4;
    const float* hin32; float* hout32; bf16_t* hb; float* ssn; const bf16_t* pp;
    __device__ __forceinline__ void operator()(const f32x4 (&acc)[2][2][4][2], const Unit& u, int wr, int wc, int fr, int fq, const RsCtx&) const {
        const int row0 = u.pm * BM + wr * 64 + fr, col0 = u.pn * BM + wc * 32 + 8 * fq;
#pragma unroll
        for (int ai = 0; ai < 2; ++ai)
#pragma unroll
            for (int mg = 0; mg < 4; mg += MB) {
                f32x4 hv[MB][2][2]; u32x4 pw[MB][2];
#pragma unroll
                for (int mm = 0; mm < MB; ++mm)
#pragma unroll
                    for (int bj = 0; bj < 2; ++bj) {
                        const size_t off = (size_t)(row0 + ai * HALF + (mg + mm) * 16) * DM + col0 + bj * HALF;
                        if (hin32) { hv[mm][bj][0] = *(const f32x4*)(hin32 + off); hv[mm][bj][1] = *(const f32x4*)(hin32 + off + 4); }
                        else { const u32x4 b = *(const u32x4*)(hb + off); hv[mm][bj][0] = (f32x4){bflo(b.x), bfhi(b.x), bflo(b.y), bfhi(b.y)}; hv[mm][bj][1] = (f32x4){bflo(b.z), bfhi(b.z), bflo(b.w), bfhi(b.w)}; }
                        if (MODE == 1) pw[mm][bj] = *(const u32x4*)(pp + off);
                    }
#pragma unroll
                for (int mm = 0; mm < MB; ++mm) {
                    const int m = mg + mm, row = row0 + ai * HALF + m * 16;
                    float q = 0.f;
#pragma unroll
                    for (int bj = 0; bj < 2; ++bj) {
                        const size_t off = (size_t)row * DM + col0 + bj * HALF;
                        f32x4 v0 = acc[ai][bj][m][0], v1 = acc[ai][bj][m][1];
                        if (MODE == 1) {
                            const u32x4 g = pw[mm][bj];
                            v0[0] *= bflo(g.x); v0[1] *= bfhi(g.x); v0[2] *= bflo(g.y); v0[3] *= bfhi(g.y);
                            v1[0] *= bflo(g.z); v1[1] *= bfhi(g.z); v1[2] *= bflo(g.w); v1[3] *= bfhi(g.w);
                        }
                        v0 += hv[mm][bj][0]; v1 += hv[mm][bj][1];
                        if (hout32) { *(f32x4*)(hout32 + off) = v0; *(f32x4*)(hout32 + off + 4) = v1; }
                        else { u32x4 w; w.x = cvt_pk_bf16(v0[0], v0[1]); w.y = cvt_pk_bf16(v0[2], v0[3]); w.z = cvt_pk_bf16(v1[0], v1[1]); w.w = cvt_pk_bf16(v1[2], v1[3]);
                               *(u32x4*)(hb + off) = w; }
                        q += (v0[0] * v0[0] + v0[1] * v0[1]) + (v0[2] * v0[2] + v0[3] * v0[3]) + (v1[0] * v1[0] + v1[1] * v1[1]) + (v1[2] * v1[2] + v1[3] * v1[3]);
                    }
                    if (ssn) { q += __shfl_xor(q, 16); q += __shfl_xor(q, 32); if (fq == 0) ssn[(size_t)row * 16 + u.pn * 4 + wc] = q; }
                }
                asm volatile("" ::: "memory");
            }
    }
};

#ifndef PG8_SP2
#define PG8_SP2 true
#endif
#ifndef PG8_ALIGN
#define PG8_ALIGN true
#endif
template <class Epi, bool ALIGN_EPI = PG8_ALIGN, bool SP2 = PG8_SP2>
__device__ __forceinline__ void gemm_phase(int tid, LAS unsigned char* lds, const Gemm g, const StaticOrder& S, const Epi& E) {
    const int wid = __builtin_amdgcn_readfirstlane(tid >> 6), lane = tid & 63, wr = wid >> 2, wc = wid & 3, fr = lane & 15, fq = lane >> 4;
    const int K = g.K, nt = K / BK, lda = g.lda;
    unsigned voffA[2], voffB[2];
#pragma unroll
    for (int i = 0; i < 2; ++i) { int R, C; stage_rc(tid * 16 + i * 8192, R, C); const int Rb = Epi::PERM ? ((R & ~31) + perm32(R & 31)) : R;
        voffA[i] = (unsigned)(R * lda + C) * 2u; voffB[i] = (unsigned)(Rb * K + C) * 2u; }
    const size_t kstep = (size_t)(BK * 2);
    const size_t hstepA = (size_t)HALF * lda * 2, hstepB = (size_t)HALF * K * 2;
    const size_t tstepA = 2 * hstepA, tstepB = 2 * hstepB;
    const unsigned ldsw = (unsigned)wid * 1024u;
    const int aoff = lds_byte(wr * 64 + fr, fq * 8), boff = lds_byte(wc * 32 + fr, fq * 8);
#define PG8_SA(b, h) (((b) * 2 + (h)) * HTB)
#define PG8_SB(b, h) ((4 + (b) * 2 + (h)) * HTB)
#define PG8_STAGE(bufoff, gbase, voff) do { _Pragma("unroll") for (int _i = 0; _i < 2; ++_i) \
        __builtin_amdgcn_global_load_lds((const unsigned*)((const char*)(gbase) + (voff)[_i]), (LAS unsigned*)(lds + (bufoff) + ldsw + _i * 8192), 16, 0, 0); } while (0)
#define PG8_LDA(dst, b, h) do { _Pragma("unroll") for (int m = 0; m < 4; ++m) _Pragma("unroll") for (int k = 0; k < 2; ++k) dst[m][k] = *(const LAS bf16x8*)(lds + PG8_SA(b, h) + aoff + m * 2048 + k * 1024); } while (0)
#define PG8_LDB(dst, b, h) do { _Pragma("unroll") for (int n = 0; n < 2; ++n) _Pragma("unroll") for (int k = 0; k < 2; ++k) dst[n][k] = *(const LAS bf16x8*)(lds + PG8_SB(b, h) + boff + n * 2048 + k * 1024); } while (0)
#define PG8_MMA(ai, bj, At, Bt) do { __builtin_amdgcn_s_setprio(1); _Pragma("unroll") for (int m = 0; m < 4; ++m) _Pragma("unroll") for (int n = 0; n < 2; ++n) _Pragma("unroll") for (int k = 0; k < 2; ++k) \
        acc[ai][bj][m][n] = __builtin_amdgcn_mfma_f32_16x16x32_bf16(Bt[n][k], At[m][k], acc[ai][bj][m][n], 0, 0, 0); __builtin_amdgcn_s_setprio(0); } while (0)
#define PG8_WAIT_V(n) asm volatile("s_waitcnt vmcnt(" #n ")" ::: "memory")
#define PG8_WAIT_L(n) asm volatile("s_waitcnt lgkmcnt(" #n ")" ::: "memory")
#define PG8_BAR __builtin_amdgcn_s_barrier()
#define PG8_SCHED __builtin_amdgcn_sched_barrier(0)
    Unit cur, nxt; int ui = 0;
    if (!S.next(0, cur)) return;
    RsCtx rc; rc.tab = (const LAS float*)(lds + STAGE_BYTES + 256); rc.pmA = cur.pm; rc.pmB = cur.pm;
    if constexpr (Epi::HAS_RS) {
        if (E.ss) {
            Unit lu = cur; for (int i = 1; S.next(i, nxt); ++i) lu = nxt;
            rc.pmB = lu.pm;
            const int rowl = tid & 255, pmx = (tid >> 8) ? rc.pmB : rc.pmA;
            ((LAS float*)(lds + STAGE_BYTES + 256))[tid] = E.row_scale(pmx * BM + rowl);
            __syncthreads();
        }
    }
    f32x4 acc[2][2][4][2];
#pragma unroll
    for (int a = 0; a < 2; ++a)
#pragma unroll
        for (int b = 0; b < 2; ++b)
#pragma unroll
            for (int m = 0; m < 4; ++m)
#pragma unroll
                for (int n = 0; n < 2; ++n) acc[a][b][m][n] = (f32x4){0.f, 0.f, 0.f, 0.f};
    bf16x8 At[4][2], B0[2][2], B1[2][2];
    const char* cA = (const char*)g.A + (size_t)cur.pm * tstepA; const char* cB = (const char*)g.Bt + (size_t)cur.pn * tstepB;
    if constexpr (SP2) {
    PG8_STAGE(PG8_SB(0, 0), cB, voffB); PG8_STAGE(PG8_SB(0, 1), cB + hstepB, voffB); PG8_STAGE(PG8_SA(0, 0), cA, voffA); PG8_STAGE(PG8_SA(0, 1), cA + hstepA, voffA);
    if (wr == 1) PG8_BAR;
    PG8_WAIT_V(2); PG8_BAR;
    PG8_STAGE(PG8_SB(1, 0), cB + kstep, voffB); PG8_STAGE(PG8_SA(1, 0), cA + kstep, voffA); PG8_STAGE(PG8_SB(1, 1), cB + hstepB + kstep, voffB);
    PG8_WAIT_V(6); PG8_BAR;
    } else {
    PG8_STAGE(PG8_SB(0, 0), cB, voffB); PG8_STAGE(PG8_SA(0, 0), cA, voffA); PG8_STAGE(PG8_SB(0, 1), cB + hstepB, voffB); PG8_STAGE(PG8_SA(0, 1), cA + hstepA, voffA);
    if (wr == 1) PG8_BAR;
    PG8_WAIT_V(4); PG8_BAR;
    PG8_STAGE(PG8_SB(1, 0), cB + kstep, voffB); PG8_STAGE(PG8_SA(1, 0), cA + kstep, voffA); PG8_STAGE(PG8_SB(1, 1), cB + hstepB + kstep, voffB);
    PG8_WAIT_V(6); PG8_BAR;
    }
    for (;;) {
        const bool has_next = S.next(ui + 1, nxt);
        const char* nA = has_next ? (const char*)g.A + (size_t)nxt.pm * tstepA : cA; const char* nB = has_next ? (const char*)g.Bt + (size_t)nxt.pn * tstepB : cB;
        for (int t = 0; t < nt; t += 2) {
            const bool last = (t == nt - 2);
            const char* a1 = cA + (size_t)(t + 1) * kstep;
            const char* a2 = last ? nA : cA + (size_t)(t + 2) * kstep; const char* b2 = last ? nB : cB + (size_t)(t + 2) * kstep;
            const char* a3 = a2 + kstep; const char* b3 = b2 + kstep;
            if constexpr (SP2) {
            PG8_LDB(B0, 0, 0); PG8_LDB(B1, 0, 1); PG8_SCHED; PG8_LDA(At, 0, 0); PG8_STAGE(PG8_SA(1, 1), a1 + hstepA, voffA);
            PG8_WAIT_V(8); PG8_WAIT_L(0); PG8_BAR; PG8_MMA(0, 0, At, B0); PG8_MMA(0, 1, At, B1); PG8_BAR; PG8_SCHED;
            PG8_LDA(At, 0, 1); PG8_STAGE(PG8_SB(0, 0), b2, voffB); PG8_STAGE(PG8_SB(0, 1), b2 + hstepB, voffB); PG8_STAGE(PG8_SA(0, 0), a2, voffA);
            PG8_WAIT_V(8); PG8_WAIT_L(0); PG8_BAR; PG8_MMA(1, 0, At, B0); PG8_MMA(1, 1, At, B1); PG8_BAR; PG8_SCHED;
            PG8_LDB(B0, 1, 0); PG8_LDB(B1, 1, 1); PG8_SCHED; PG8_LDA(At, 1, 0); PG8_STAGE(PG8_SA(0, 1), a2 + hstepA, voffA);
            PG8_WAIT_V(8); PG8_WAIT_L(0); PG8_BAR; PG8_MMA(0, 0, At, B0); PG8_MMA(0, 1, At, B1); PG8_BAR; PG8_SCHED;
            PG8_LDA(At, 1, 1); PG8_STAGE(PG8_SB(1, 0), b3, voffB); PG8_STAGE(PG8_SB(1, 1), b3 + hstepB, voffB); PG8_STAGE(PG8_SA(1, 0), a3, voffA);
            PG8_WAIT_V(8); PG8_WAIT_L(0); PG8_BAR; PG8_MMA(1, 0, At, B0); PG8_MMA(1, 1, At, B1); PG8_BAR; PG8_SCHED;
            } else {
            PG8_LDB(B0, 0, 0); PG8_SCHED; PG8_LDA(At, 0, 0); PG8_STAGE(PG8_SA(1, 1), a1 + hstepA, voffA);
            PG8_WAIT_L(8); PG8_BAR; PG8_WAIT_L(0); PG8_MMA(0, 0, At, B0); PG8_BAR; PG8_SCHED;
            PG8_LDB(B1, 0, 1); PG8_STAGE(PG8_SB(0, 0), b2, voffB);
            PG8_BAR; PG8_WAIT_L(0); PG8_MMA(0, 1, At, B1); PG8_BAR;
            PG8_LDA(At, 0, 1); PG8_STAGE(PG8_SA(0, 0), a2, voffA);
            PG8_BAR; PG8_WAIT_L(0); PG8_MMA(1, 0, At, B0); PG8_BAR; PG8_SCHED;
            PG8_STAGE(PG8_SB(0, 1), b2 + hstepB, voffB);
            PG8_WAIT_V(6); PG8_BAR; PG8_MMA(1, 1, At, B1); PG8_BAR;
            PG8_LDB(B0, 1, 0); PG8_SCHED; PG8_LDA(At, 1, 0); PG8_STAGE(PG8_SA(0, 1), a2 + hstepA, voffA);
            PG8_WAIT_L(8); PG8_BAR; PG8_WAIT_L(0); PG8_MMA(0, 0, At, B0); PG8_BAR; PG8_SCHED;
            PG8_LDB(B1, 1, 1); PG8_STAGE(PG8_SB(1, 0), b3, voffB);
            PG8_BAR; PG8_WAIT_L(0); PG8_MMA(0, 1, At, B1); PG8_BAR;
            PG8_LDA(At, 1, 1); PG8_STAGE(PG8_SA(1, 0), a3, voffA);
            PG8_BAR; PG8_WAIT_L(0); PG8_MMA(1, 0, At, B0); PG8_BAR; PG8_SCHED;
            PG8_STAGE(PG8_SB(1, 1), b3 + hstepB, voffB);
            PG8_WAIT_V(6); PG8_BAR; PG8_MMA(1, 1, At, B1); PG8_BAR;
            }
        }
        if constexpr (ALIGN_EPI) { if (wr == 0) PG8_BAR; }
        E(acc, cur, wr, wc, fr, fq, rc);
        if (!has_next) break;
#pragma unroll
        for (int a = 0; a < 2; ++a)
#pragma unroll
            for (int b = 0; b < 2; ++b)
#pragma unroll
                for (int m = 0; m < 4; ++m)
#pragma unroll
                    for (int n = 0; n < 2; ++n) acc[a][b][m][n] = (f32x4){0.f, 0.f, 0.f, 0.f};
        cur = nxt; cA = nA; cB = nB; ++ui;
        if constexpr (ALIGN_EPI) { if (wr == 1) PG8_BAR; }
    }
    PG8_WAIT_V(0);
    if constexpr (!ALIGN_EPI) { if (wr == 0) PG8_BAR; }
    PG8_BAR;
#undef PG8_SA
#undef PG8_SB
#undef PG8_STAGE
#undef PG8_LDA
#undef PG8_LDB
#undef PG8_MMA
#undef PG8_WAIT_V
#undef PG8_WAIT_L
#undef PG8_BAR
#undef PG8_SCHED
}
}

__constant__ double kInvFreq[32] = {
    1.0, 0.7498942093324559, 0.5623413251903491, 0.4216965034285822, 0.31622776601683794, 0.23713737056616552, 0.1778279410038923, 0.1333521432163324,
    0.1, 0.07498942093324558, 0.05623413251903491, 0.04216965034285822, 0.03162277660168379, 0.023713737056616554, 0.01778279410038923, 0.01333521432163324,
    0.01, 0.007498942093324558, 0.005623413251903491, 0.004216965034285823, 0.0031622776601683794, 0.0023713737056616554, 0.001778279410038923, 0.001333521432163324,
    0.001, 0.0007498942093324559, 0.0005623413251903491, 0.0004216965034285823, 0.00031622776601683794, 0.00023713737056616554, 0.0001778279410038923, 0.0001333521432163324};

__device__ __forceinline__ float wave_sum(float v) {
#pragma unroll
    for (int o = 1; o < 64; o <<= 1) v += __shfl_xor(v, o);
    return v;
}
__device__ __forceinline__ void unpack8(const u32x4 w, float (&f)[8]) { f[0] = bflo(w.x); f[1] = bfhi(w.x); f[2] = bflo(w.y); f[3] = bfhi(w.y); f[4] = bflo(w.z); f[5] = bfhi(w.z); f[6] = bflo(w.w); f[7] = bfhi(w.w); }
__device__ __forceinline__ u32x4 pack8(const float (&f)[8]) { u32x4 w; w.x = cvt_pk_bf16(f[0], f[1]); w.y = cvt_pk_bf16(f[2], f[3]); w.z = cvt_pk_bf16(f[4], f[5]); w.w = cvt_pk_bf16(f[6], f[7]); return w; }

struct WDesc { const float* W; const float* gamma; bf16_t* dst; int K, N, Npad, mode, items; };
__device__ __forceinline__ WDesc wdesc(const Params& P, int id) {
    WDesc d; bf16_t* wb = (bf16_t*)(P.ws + OFF_W); d.gamma = nullptr; d.mode = 0;
    if (id < 12) {
        const int j = id & 1, f = id >> 1;
        switch (f) {
            case 0: d.W = P.in[6] + (size_t)j * DM * 704; d.K = DM; d.N = 704; d.Npad = LATP; d.dst = wb + WE_DOWN + (size_t)j * LATP * DM; d.gamma = P.in[3] + (2 * j) * DM; break;
            case 1: d.W = P.in[9] + (size_t)j * QLR * QP; d.K = QLR; d.N = QP; d.Npad = QP; d.dst = wb + WE_UQ + (size_t)j * QP * QLR; d.gamma = P.in[7] + j * QLR; d.mode = 1; break;
            case 2: d.W = P.in[10] + (size_t)j * KVLR * KVP; d.K = KVLR; d.N = KVP; d.Npad = KVP; d.dst = wb + WE_UKV + (size_t)j * KVP * KVLR; d.gamma = P.in[8] + j * KVLR; break;
            case 3: d.W = P.in[15] + (size_t)j * DM * DM; d.K = DM; d.N = DM; d.Npad = DM; d.dst = wb + WE_MOUT + (size_t)j * DM * DM; break;
            case 4: d.W = P.in[16] + (size_t)j * DM * ZP; d.K = DM; d.N = ZP; d.Npad = ZP; d.dst = wb + WE_GIN + (size_t)j * ZP * DM; d.gamma = P.in[3] + (2 * j + 1) * DM; break;
            default: d.W = P.in[21] + (size_t)j * 2048 * DM; d.K = 2048; d.N = DM; d.Npad = DM; d.dst = wb + WE_GOUT + (size_t)j * DM * 2048; break;
        }
    } else {
        const int i = (id - 12) & 3, f = (id - 12) >> 2;
        switch (f) {
            case 0: d.W = P.in[22] + (size_t)i * DM * DFF; d.K = DM; d.N = DFF; d.Npad = DFF; d.dst = wb + WE_UP + (size_t)i * DFF * DM; d.gamma = P.in[4] + i * DM; break;
            case 1: d.W = P.in[23] + (size_t)i * DFF * DM; d.K = DFF; d.N = DM; d.Npad = DM; d.dst = wb + WE_DN + (size_t)i * DM * DFF; break;
            case 2: d.W = P.in[24] + (size_t)i * DM * DM; d.K = DM; d.N = DM; d.Npad = DM; d.dst = wb + WE_GATE + (size_t)i * DM * DM; d.gamma = P.in[5] + i * DM; break;
            default: d.W = P.in[25] + (size_t)i * PLE * DM; d.K = PLE; d.N = DM; d.Npad = DM; d.dst = wb + WE_PROJ + (size_t)i * DM * PLE; break;
        }
    }
    d.items = (d.K / 64) * (d.Npad / 32);
    return d;
}
__device__ __forceinline__ void conv_item(const WDesc& d, int item, float* scr, int lane) {
    const int nblk = d.Npad / 32, kb = item / nblk, nb = item % nblk, k0 = 64 * kb, n0 = 32 * nb;
    int sn0 = n0;
    if (d.mode == 1) { if (n0 < 1024) sn0 = (n0 >> 7) * 192 + (n0 & 127); else { const int r = n0 - 1024; sn0 = (r >> 6) * 192 + 128 + (r & 63); } }
    const bool valid = sn0 < d.N;
#pragma unroll
    for (int i = 0; i < 32; ++i) { const int kk = 2 * i + (lane >> 5);
        float v = valid ? d.W[(size_t)(k0 + kk) * d.N + sn0 + (lane & 31)] : 0.f;
        if (d.gamma) v *= d.gamma[k0 + kk];
        scr[kk * 33 + (lane & 31)] = v; }
    asm volatile("s_waitcnt lgkmcnt(0)" ::: "memory");
    const int c = lane & 7;
#pragma unroll
    for (int j = 0; j < 4; ++j) { const int n = (lane >> 3) + 8 * j; const float* s = scr + (8 * c) * 33 + n;
        u32x4 o; o.x = cvt_pk_bf16(s[0 * 33], s[1 * 33]); o.y = cvt_pk_bf16(s[2 * 33], s[3 * 33]); o.z = cvt_pk_bf16(s[4 * 33], s[5 * 33]); o.w = cvt_pk_bf16(s[6 * 33], s[7 * 33]);
        *(u32x4*)(d.dst + (size_t)(n0 + n) * d.K + k0 + 8 * c) = o; }
    asm volatile("s_waitcnt lgkmcnt(0)" ::: "memory");
}
__device__ __forceinline__ void p0_prologue(int tid, const Params& P, unsigned char* lds) {
    const int lane = tid & 63, wave = __builtin_amdgcn_readfirstlane(tid >> 6);
    const int gw = blockIdx.x * 8 + wave, NGW = gridDim.x * 8;
    const size_t gt = (size_t)blockIdx.x * 512 + tid, NGT = (size_t)gridDim.x * 512;
    float* scr = (float*)(lds + wave * 8704);
    int total = 0;
    for (int id = 0; id < 28; ++id) total += wdesc(P, id).items;
    for (int it = gw; it < total; it += NGW) {
        int r = it, id = 0; WDesc d = wdesc(P, 0);
        while (r >= d.items) { r -= d.items; ++id; d = wdesc(P, id); }
        conv_item(d, r, scr, lane);
    }
    { unsigned* bw = (unsigned*)(P.ws + OFF_BAR); for (size_t i = gt; i < XCD_BAR_WORDS; i += NGT) bw[i] = 0u; }
    { const f32x4* src = (const f32x4*)P.in[1]; u32x4* dst = (u32x4*)(P.ws + OFF_PB); const size_t n8 = (size_t)DEPTH * T * PLE / 8;
      for (size_t i0 = gt; i0 < n8; i0 += 4 * NGT) {
          f32x4 a[4], b[4];
#pragma unroll
          for (int u = 0; u < 4; ++u) { const size_t i = i0 + u * NGT; if (i < n8) { a[u] = src[2 * i]; b[u] = src[2 * i + 1]; } }
#pragma unroll
          for (int u = 0; u < 4; ++u) { const size_t i = i0 + u * NGT; if (i < n8) { u32x4 w; w.x = cvt_pk_bf16(a[u][0], a[u][1]); w.y = cvt_pk_bf16(a[u][2], a[u][3]); w.z = cvt_pk_bf16(b[u][0], b[u][1]); w.w = cvt_pk_bf16(b[u][2], b[u][3]); dst[i] = w; } } } }
    { float* ssp = (float*)(P.ws + OFF_SS); bf16_t* hb = (bf16_t*)(P.ws + OFF_HB);
#pragma unroll 2
      for (int row = gw; row < T; row += NGW) {
          const f32x4* xr = (const f32x4*)(P.in[0] + (size_t)row * DM) + lane; float s = 0.f;
          unsigned long long* o8 = (unsigned long long*)(hb + (size_t)row * DM) + lane;
#pragma unroll
          for (int j = 0; j < 4; ++j) { const f32x4 v = xr[64 * j]; s += (v[0] * v[0] + v[1] * v[1]) + (v[2] * v[2] + v[3] * v[3]);
              o8[64 * j] = (unsigned long long)cvt_pk_bf16(v[0], v[1]) | ((unsigned long long)cvt_pk_bf16(v[2], v[3]) << 32); }
          s = wave_sum(s); if (lane < 16) ssp[(size_t)row * 16 + lane] = (lane == 0) ? s : 0.f; } }
}

__device__ __forceinline__ void r2_phase(int tid, const Params& P, int j) {
    const int lane = tid & 63, wave = __builtin_amdgcn_readfirstlane(tid >> 6);
    const int gw = blockIdx.x * 8 + wave, NGW = gridDim.x * 8;
    bf16_t* Q = (bf16_t*)(P.ws + OFF_FF + FF_Q); bf16_t* KV = (bf16_t*)(P.ws + OFF_FF + FF_KV); bf16_t* LAT = (bf16_t*)(P.ws + OFF_FF + FF_LAT);
    const float* gqn = P.in[11] + j * 128; const float* gqr = P.in[12] + j * 64; const float* gkn = P.in[13] + j * 128; const float* gkr = P.in[14] + j * 64;
    const int* pos = (const int*)P.in[2];
    float g_qn[2][8], g_kn[2][8], g_qr[8], g_kr[8];
#pragma unroll
    for (int i = 0; i < 2; ++i)
#pragma unroll
        for (int e = 0; e < 8; ++e) { const int d = (8 * lane + 512 * i + e) & 127; g_qn[i][e] = gqn[d] * QSCALE; g_kn[i][e] = gkn[d]; }
#pragma unroll
    for (int e = 0; e < 8; ++e) { const int r = 8 * (lane & 7) + e; g_qr[e] = gqr[r] * QSCALE; g_kr[e] = gkr[r]; }
    const double invf = kInvFreq[lane & 31];
#pragma unroll 2
    for (int row = gw; row < T; row += NGW) {
        const double ang = (double)pos[row] * invf; double rev = ang * 0.15915494309189535; rev -= floor(rev);
        const float cs = __builtin_amdgcn_cosf((float)rev), sn = __builtin_amdgcn_sinf((float)rev);
        float cj[8], sj[8];
#pragma unroll
        for (int e = 0; e < 8; ++e) { cj[e] = __shfl(cs, 8 * (lane & 3) + e); sj[e] = __shfl(sn, 8 * (lane & 3) + e); }
#pragma unroll
        for (int i = 0; i < 2; ++i) {
            const int idx = 8 * lane + 512 * i, head = idx >> 7, d = idx & 127;
            u32x4* qp = (u32x4*)(Q + (size_t)row * QP + idx); u32x4* kp = (u32x4*)(KV + (size_t)row * KVP + head * 256 + d);
            float a[8], b[8]; unpack8(*qp, a); unpack8(*kp, b);
            float sa = 0.f, sb = 0.f;
#pragma unroll
            for (int e = 0; e < 8; ++e) { sa += a[e] * a[e]; sb += b[e] * b[e]; }
#pragma unroll
            for (int o = 1; o < 16; o <<= 1) { sa += __shfl_xor(sa, o); sb += __shfl_xor(sb, o); }
            const float ra = rsqrtf(sa * (1.0f / 128) + EPS), rb = rsqrtf(sb * (1.0f / 128) + EPS);
#pragma unroll
            for (int e = 0; e < 8; ++e) { a[e] = a[e] * ra * g_qn[i][e]; b[e] = b[e] * rb * g_kn[i][e]; }
            *qp = pack8(a); *kp = pack8(b);
        }
        {
            u32x4* qp = (u32x4*)(Q + (size_t)row * QP + 1024 + 8 * lane); u32x4* kp = (u32x4*)(LAT + (size_t)row * LATP + 640 + 8 * (lane & 7));
            float a[8], b[8]; unpack8(*qp, a); unpack8(*kp, b);
            float sa = 0.f, sb = 0.f;
#pragma unroll
            for (int e = 0; e < 8; ++e) { sa += a[e] * a[e]; sb += b[e] * b[e]; }
#pragma unroll
            for (int o = 1; o < 8; o <<= 1) { sa += __shfl_xor(sa, o); sb += __shfl_xor(sb, o); }
            const float ra = rsqrtf(sa * (1.0f / 64) + EPS), rb = rsqrtf(sb * (1.0f / 64) + EPS);
            const bool hi = (lane & 4) != 0;
#pragma unroll
            for (int e = 0; e < 8; ++e) {
                const float ya = a[e] * ra * g_qr[e], yb = b[e] * rb * g_kr[e];
                const float pa = __shfl_xor(ya, 4), pb = __shfl_xor(yb, 4);
                a[e] = hi ? (ya * cj[e] + pa * sj[e]) : (ya * cj[e] - pa * sj[e]);
                b[e] = hi ? (yb * cj[e] + pb * sj[e]) : (yb * cj[e] - pb * sj[e]);
            }
            *qp = pack8(a); if (lane < 8) *kp = pack8(b);
        }
    }
}

constexpr int KROW = 400, VROW = 288, KTILE = 64 * KROW, VTILE = 64 * VROW;
__device__ __forceinline__ void attn_unit(int tid, unsigned char* lds, const bf16_t* Q, const bf16_t* KV, const bf16_t* KR, bf16_t* O, int b, int h, int qb) {
    const int lane = tid & 63, w = __builtin_amdgcn_readfirstlane(tid >> 6), r = lane & 15, g = lane >> 4;
    const int row0 = b * SEQ + qb * 256, qrow = row0 + 32 * w + r;
    bf16x8 qf[2][6];
#pragma unroll
    for (int rg = 0; rg < 2; ++rg) {
#pragma unroll
        for (int ks = 0; ks < 4; ++ks) qf[rg][ks] = *(const bf16x8*)(Q + (size_t)(qrow + 16 * rg) * QP + h * 128 + 32 * ks + 8 * g);
#pragma unroll
        for (int ks = 0; ks < 2; ++ks) qf[rg][4 + ks] = *(const bf16x8*)(Q + (size_t)(qrow + 16 * rg) * QP + 1024 + h * 64 + 32 * ks + 8 * g);
    }
    const int ntiles = 4 * qb + 4, last_tile = 4 * qb + (w >> 1);
    const int kn_row0 = tid >> 4, kn_ch = tid & 15;
    const int kr_row = tid >> 3, kr_ch = tid & 7;
    const bf16_t* gk = KV + (size_t)(b * SEQ) * KVP + h * 256;
    const bf16_t* gr = KR + (size_t)(b * SEQ) * LATP;
    u32x4 sk0, sk1, sr, sv0, sv1;
#define ATT_LOAD(t) do { const size_t kb = (size_t)(t) * 64; \
        sk0 = *(const u32x4*)(gk + (kb + kn_row0) * KVP + kn_ch * 8); sk1 = *(const u32x4*)(gk + (kb + kn_row0 + 32) * KVP + kn_ch * 8); \
        sv0 = *(const u32x4*)(gk + (kb + kn_row0) * KVP + 128 + kn_ch * 8); sv1 = *(const u32x4*)(gk + (kb + kn_row0 + 32) * KVP + 128 + kn_ch * 8); \
        sr = *(const u32x4*)(gr + (kb + kr_row) * LATP + kr_ch * 8); } while (0)
#define ATT_STORE(buf) do { unsigned char* kb_ = lds + (buf) * KTILE; unsigned char* vb_ = lds + 2 * KTILE + (buf) * VTILE; \
        *(u32x4*)(kb_ + kn_row0 * KROW + kn_ch * 16) = sk0; *(u32x4*)(kb_ + (kn_row0 + 32) * KROW + kn_ch * 16) = sk1; \
        *(u32x4*)(kb_ + kr_row * KROW + 256 + kr_ch * 16) = sr; \
        *(u32x4*)(vb_ + kn_row0 * VROW + kn_ch * 16) = sv0; *(u32x4*)(vb_ + (kn_row0 + 32) * VROW + kn_ch * 16) = sv1; } while (0)
    f32x4 o[2][8];
#pragma unroll
    for (int rg = 0; rg < 2; ++rg)
#pragma unroll
        for (int i = 0; i < 8; ++i) o[rg][i] = (f32x4){0.f, 0.f, 0.f, 0.f};
    float m[2] = {-1e30f, -1e30f}, l[2] = {0.f, 0.f};
    ATT_LOAD(0); ATT_STORE(0);
    __syncthreads();
    const int q4 = r >> 2, p4 = lane & 3;
    const int vtr_off = (4 * g + q4) * VROW + (4 * p4) * 2;
    const int qidx = qb * 256 + 32 * w + r;
    for (int t = 0; t < ntiles; ++t) {
        const bool more = (t + 1 < ntiles);
        if (more) ATT_LOAD(t + 1);
        if (t <= last_tile) {
            const unsigned char* Kb = lds + (t & 1) * KTILE; const unsigned char* Vb = lds + 2 * KTILE + (t & 1) * VTILE;
            f32x4 p[2][4];
#pragma unroll
            for (int kb = 0; kb < 4; ++kb) {
                p[0][kb] = (f32x4){0.f, 0.f, 0.f, 0.f}; p[1][kb] = (f32x4){0.f, 0.f, 0.f, 0.f};
#pragma unroll
                for (int ks = 0; ks < 6; ++ks) {
                    const bf16x8 a = *(const bf16x8*)(Kb + (16 * kb + r) * KROW + ks * 64 + g * 16);
                    p[0][kb] = __builtin_amdgcn_mfma_f32_16x16x32_bf16(a, qf[0][ks], p[0][kb], 0, 0, 0);
                    p[1][kb] = __builtin_amdgcn_mfma_f32_16x16x32_bf16(a, qf[1][ks], p[1][kb], 0, 0, 0);
                }
            }
            const bool diag = (t * 64 + 63 > qb * 256 + 32 * w);
            bf16x8 pb[2][2];
#pragma unroll
            for (int rg = 0; rg < 2; ++rg) {
                if (diag) {
#pragma unroll
                    for (int kb = 0; kb < 4; ++kb)
#pragma unroll
                        for (int i = 0; i < 4; ++i) { const int kk = t * 64 + 16 * kb + 4 * g + i; if (kk > qidx + 16 * rg) p[rg][kb][i] = -1e30f; }
                }
                float mx = fmaxf(fmaxf(p[rg][0][0], p[rg][0][1]), fmaxf(p[rg][0][2], p[rg][0][3]));
#pragma unroll
                for (int kb = 1; kb < 4; ++kb) mx = fmaxf(mx, fmaxf(fmaxf(p[rg][kb][0], p[rg][kb][1]), fmaxf(p[rg][kb][2], p[rg][kb][3])));
                mx = fmaxf(mx, __shfl_xor(mx, 16)); mx = fmaxf(mx, __shfl_xor(mx, 32));
                if (!__all(mx <= m[rg] + 8.0f)) {
                    const float mn = fmaxf(m[rg], mx), alpha = fast_exp2(m[rg] - mn); m[rg] = mn;
                    l[rg] *= alpha;
#pragma unroll
                    for (int i = 0; i < 8; ++i) o[rg][i] *= alpha;
                }
                const float mref = m[rg];
                float rsum = 0.f;
#pragma unroll
                for (int kb = 0; kb < 4; ++kb)
#pragma unroll
                    for (int i = 0; i < 4; ++i) { p[rg][kb][i] = fast_exp2(p[rg][kb][i] - mref); rsum += p[rg][kb][i]; }
                l[rg] += rsum;
#pragma unroll
                for (int kk = 0; kk < 2; ++kk) {
                    u32x4 pw; pw.x = cvt_pk_bf16(p[rg][2 * kk][0], p[rg][2 * kk][1]); pw.y = cvt_pk_bf16(p[rg][2 * kk][2], p[rg][2 * kk][3]);
                    pw.z = cvt_pk_bf16(p[rg][2 * kk + 1][0], p[rg][2 * kk + 1][1]); pw.w = cvt_pk_bf16(p[rg][2 * kk + 1][2], p[rg][2 * kk + 1][3]);
                    pb[rg][kk] = __builtin_bit_cast(bf16x8, pw);
                }
            }
#pragma unroll
            for (int db = 0; db < 8; ++db)
#pragma unroll
                for (int kk = 0; kk < 2; ++kk) {
                    const LAS unsigned char* vp = (const LAS unsigned char*)(Vb + vtr_off + (32 * kk) * VROW + db * 32);
                    const s16x4 lo = __builtin_bit_cast(s16x4, __builtin_amdgcn_ds_read_tr16_b64_v4i16((LAS s16x4*)vp));
                    const s16x4 hi = __builtin_bit_cast(s16x4, __builtin_amdgcn_ds_read_tr16_b64_v4i16((LAS s16x4*)(vp + 16 * VROW)));
                    const bf16x8 vf = __builtin_shufflevector(lo, hi, 0, 1, 2, 3, 4, 5, 6, 7);
                    o[0][db] = __builtin_amdgcn_mfma_f32_16x16x32_bf16(vf, pb[0][kk], o[0][db], 0, 0, 0);
                    o[1][db] = __builtin_amdgcn_mfma_f32_16x16x32_bf16(vf, pb[1][kk], o[1][db], 0, 0, 0);
                }
        }
        if (more) ATT_STORE((t + 1) & 1);
        __syncthreads();
    }
#pragma unroll
    for (int rg = 0; rg < 2; ++rg) {
        float ls = l[rg]; ls += __shfl_xor(ls, 16); ls += __shfl_xor(ls, 32);
        const float inv = fast_rcp(ls);
        bf16_t* orow = O + (size_t)(qrow + 16 * rg) * QP + h * 128 + 4 * g;
#pragma unroll
        for (int db = 0; db < 8; ++db) {
            u32x2 wv; wv.x = cvt_pk_bf16(o[rg][db][0] * inv, o[rg][db][1] * inv); wv.y = cvt_pk_bf16(o[rg][db][2] * inv, o[rg][db][3] * inv);
            *(u32x2*)(orow + 16 * db) = wv;
        }
    }
#undef ATT_LOAD
#undef ATT_STORE
}
__device__ __forceinline__ void attn_phase(int tid, const Params& P, unsigned char* lds) {
    bf16_t* Q = (bf16_t*)(P.ws + OFF_FF + FF_Q); const bf16_t* KV = (const bf16_t*)(P.ws + OFF_FF + FF_KV); const bf16_t* KR = (const bf16_t*)(P.ws + OFF_FF + FF_LAT) + 640;
    const int nwg8 = (gridDim.x % 8 == 0) ? gridDim.x / 8 : 0;
    for (int it = 0;; ++it) {
        int pr;
        if (nwg8) { const int idx = (int)(blockIdx.x >> 3) + it * nwg8; if (idx >= 64) break; pr = (int)(blockIdx.x & 7) * 64 + idx; }
        else { pr = blockIdx.x + it * gridDim.x; if (pr >= 512) break; }
        const int bh = pr >> 2, x = pr & 3, b = bh >> 3, h = bh & 7;
        attn_unit(tid, lds, Q, KV, KR, Q, b, h, 7 - x);
        attn_unit(tid, lds, Q, KV, KR, Q, b, h, x);
    }
}

constexpr int SROW = 576;
constexpr int SGU_STAT_OFF = 128 * SROW;
constexpr int SGU_W_OFF = SGU_STAT_OFF + 2048, SWROW = 272;
__device__ __forceinline__ void sgu_phase(int tid, const Params& P, unsigned char* lds, int j) {
    const int lane = tid & 63, w = __builtin_amdgcn_readfirstlane(tid >> 6), r = lane & 31, hh = lane >> 5;
    bf16_t* Z = (bf16_t*)(P.ws + OFF_FF);
    const float* lng = P.in[17] + j * 2048; const float* lnb = P.in[18] + j * 2048;
    const float* wsp = P.in[19] + (size_t)j * 8 * 128 * 128; const float* bsp = P.in[20] + j * 8 * 128;
    const int q4 = (lane & 15) >> 2, p4 = lane & 3, colblk = (lane >> 4) & 1;
    f32x2* stl = (f32x2*)(lds + SGU_STAT_OFF);
    for (int unit = blockIdx.x; unit < 256; unit += gridDim.x) {
        const int row0 = unit * 128;
        for (int rr0 = 0; rr0 < 16; rr0 += 4) {
            u32x4 raw[4][4];
#pragma unroll
            for (int a = 0; a < 4; ++a)
#pragma unroll
                for (int i = 0; i < 4; ++i) raw[a][i] = *(const u32x4*)(Z + (size_t)(row0 + 16 * w + rr0 + a) * ZP + 2048 + 8 * lane + 512 * i);
#pragma unroll
            for (int a = 0; a < 4; ++a) {
                float s1 = 0.f, s2 = 0.f;
#pragma unroll
                for (int i = 0; i < 4; ++i) { float v[8]; unpack8(raw[a][i], v);
#pragma unroll
                    for (int e = 0; e < 8; ++e) { s1 += v[e]; s2 += v[e] * v[e]; } }
                s1 = wave_sum(s1); s2 = wave_sum(s2);
                const float mu = s1 * (1.0f / 2048), var = s2 * (1.0f / 2048) - mu * mu;
                if (lane == 0) stl[16 * w + rr0 + a] = (f32x2){mu, rsqrtf(fmaxf(var, 0.f) + EPS)};
            }
        }
        __syncthreads();
        for (int g = 0; g < 8; ++g) {
#pragma unroll 2
            for (int i = 0; i < 8; ++i) {
                const int chunk = tid + 512 * i, row = chunk >> 5, ch = chunk & 31, col = g * 256 + ch * 8;
                float v[8]; unpack8(*(const u32x4*)(Z + (size_t)(row0 + row) * ZP + 2048 + col), v);
                const f32x2 st = stl[row]; const float mu = st.x, rstd = st.y;
                const f32x4 g0 = *(const f32x4*)(lng + col), g1 = *(const f32x4*)(lng + col + 4), b0 = *(const f32x4*)(lnb + col), b1 = *(const f32x4*)(lnb + col + 4);
#pragma unroll
                for (int e = 0; e < 4; ++e) { v[e] = (v[e] - mu) * rstd * g0[e] + b0[e]; v[4 + e] = (v[4 + e] - mu) * rstd * g1[e] + b1[e]; }
                *(u32x4*)(lds + row * SROW + ch * 16) = pack8(v);
            }
            {
                const float* wg = wsp + (size_t)g * 128 * 128;
                f32x4 w0[4], w1[4];
#pragma unroll
                for (int i = 0; i < 4; ++i) { const int c = tid + 512 * i, t = c >> 4, s0 = (c & 15) * 8; w0[i] = *(const f32x4*)(wg + t * 128 + s0); w1[i] = *(const f32x4*)(wg + t * 128 + s0 + 4); }
#pragma unroll
                for (int i = 0; i < 4; ++i) { const int c = tid + 512 * i, t = c >> 4, s0 = (c & 15) * 8;
                    float wv[8] = {w0[i][0], w0[i][1], w0[i][2], w0[i][3], w1[i][0], w1[i][1], w1[i][2], w1[i][3]};
#pragma unroll
                    for (int e = 0; e < 8; ++e) if (s0 + e > t) wv[e] = 0.f;
                    *(u32x4*)(lds + SGU_W_OFF + t * SWROW + s0 * 2) = pack8(wv); }
            }
            __syncthreads();
            bf16x8 af[8];
#pragma unroll
            for (int ks = 0; ks < 8; ++ks) {
                const LAS unsigned char* vp = (const LAS unsigned char*)(lds + (16 * ks + 8 * hh + q4) * SROW + (32 * w + 16 * colblk + 4 * p4) * 2);
                const s16x4 lo = __builtin_bit_cast(s16x4, __builtin_amdgcn_ds_read_tr16_b64_v4i16((LAS s16x4*)vp));
                const s16x4 hi = __builtin_bit_cast(s16x4, __builtin_amdgcn_ds_read_tr16_b64_v4i16((LAS s16x4*)(vp + 4 * SROW)));
                af[ks] = __builtin_shufflevector(lo, hi, 0, 1, 2, 3, 4, 5, 6, 7);
            }
#pragma unroll
            for (int tb = 0; tb < 4; ++tb) {
                f32x16 acc;
#pragma unroll
                for (int e = 0; e < 16; ++e) acc[e] = 0.f;
                const int t = 32 * tb + r;
#pragma unroll
                for (int ks = 0; ks < 8; ++ks) {
                    if (ks <= 2 * tb + 1) {
                        const bf16x8 bfr = *(const bf16x8*)(lds + SGU_W_OFF + t * SWROW + (16 * ks + 8 * hh) * 2);
                        acc = __builtin_amdgcn_mfma_f32_32x32x16_bf16(af[ks], bfr, acc, 0, 0, 0);
                    }
                }
                const float bias = bsp[g * 128 + t];
                bf16_t* up = Z + (size_t)(row0 + t) * ZP + g * 256 + 32 * w + 4 * hh;
#pragma unroll
                for (int i4 = 0; i4 < 4; ++i4) {
                    const u32x2 uu = *(const u32x2*)(up + 8 * i4);
                    u32x2 y; y.x = cvt_pk_bf16(bflo(uu.x) * (acc[4 * i4] + bias), bfhi(uu.x) * (acc[4 * i4 + 1] + bias));
                    y.y = cvt_pk_bf16(bflo(uu.y) * (acc[4 * i4 + 2] + bias), bfhi(uu.y) * (acc[4 * i4 + 3] + bias));
                    *(u32x2*)(up + 8 * i4) = y;
                }
            }
            __syncthreads();
        }
    }
}


#define XB_TMO      128
#define XB_XCNT(j)  (256  + 64 * (j))
#define XB_XSUB(j)  (1280 + 64 * (j))
#define XB_XGEN(j)  (2304 + 64 * (j))
#define XB_TOP      3328
#define XB_TOPGEN   3392
#define XB_SPIN_CAP (1u << 22)
__device__ __forceinline__ unsigned xb_ld(unsigned* p)              { return __hip_atomic_load(p, __ATOMIC_RELAXED, __HIP_MEMORY_SCOPE_AGENT); }
__device__ __forceinline__ unsigned xb_add(unsigned* p, unsigned v) { return __hip_atomic_fetch_add(p, v, __ATOMIC_RELAXED, __HIP_MEMORY_SCOPE_AGENT); }
__device__ __forceinline__ unsigned xb_xcc_id() { return (unsigned)__builtin_amdgcn_s_getreg((3 << 11) | 20) & 0xFu; }
#define XB_SPIN(cond, bar) do { unsigned _sp = 0; while (cond) { __builtin_amdgcn_s_sleep(1); \
    if ((++_sp & 255u) == 0u) { if (xb_ld(&(bar)[XB_TMO])) break; if (_sp > XB_SPIN_CAP) { atomicAdd(&(bar)[XB_TMO], 1u); break; } } } } while (0)
__device__ __forceinline__ void xcd_barrier_complete(unsigned* bar, unsigned x, unsigned& nloc, unsigned& nx) {
    const unsigned G = gridDim.x;
    unsigned sum, cnt, mine, sp = 0u;
    for (;;) {
        sum = 0u; cnt = 0u; mine = 0u;
#pragma unroll
        for (unsigned j = 0; j < 16; ++j) { const unsigned c = xb_ld(&bar[XB_XCNT(j)]); sum += c; cnt += (c > 0u) ? 1u : 0u; mine = (j == x) ? c : mine; }
        if (sum == G) break;
        __builtin_amdgcn_s_sleep(1);
        if ((++sp & 255u) == 0u) { if (xb_ld(&bar[XB_TMO])) break; if (sp > XB_SPIN_CAP) { atomicAdd(&bar[XB_TMO], 1u); break; } }
    }
    nloc = mine > 0u ? mine : 1u; nx = cnt > 0u ? cnt : 1u;
}
__device__ __forceinline__ void xcd_barrier(unsigned* bar, unsigned x, volatile LAS unsigned* st) {
    asm volatile("s_waitcnt vmcnt(0)" ::: "memory");
    __syncthreads();
    if (threadIdx.x == 0) {
        __builtin_amdgcn_s_waitcnt(0);
        unsigned nloc = st[0], nx = st[1];
        if (nloc == 0u) { xcd_barrier_complete(bar, x, nloc, nx); st[0] = nloc; st[1] = nx; }
        const unsigned old = xb_add(&bar[XB_XSUB(x)], 1u);
        const unsigned gen = old / nloc;
        if (old + 1u == (gen + 1u) * nloc) {
            __builtin_amdgcn_fence(__ATOMIC_RELEASE, "agent");
            asm volatile("s_waitcnt vmcnt(0)" ::: "memory");
            const unsigned og = xb_add(&bar[XB_TOP], 1u);
            const unsigned tg = og / nx;
            if (og + 1u == (tg + 1u) * nx) xb_add(&bar[XB_TOPGEN], 1u);
            else XB_SPIN(xb_ld(&bar[XB_TOPGEN]) == tg, bar);
            __builtin_amdgcn_fence(__ATOMIC_ACQUIRE, "agent");
            xb_add(&bar[XB_XGEN(x)], 1u);
            asm volatile("s_waitcnt vmcnt(0)" ::: "memory");
        } else {
            XB_SPIN(xb_ld(&bar[XB_XGEN(x)]) == gen, bar);
            __builtin_amdgcn_fence(__ATOMIC_ACQUIRE, "agent");
            asm volatile("s_waitcnt vmcnt(0)" ::: "memory");
        }
    }
    __syncthreads();
}

constexpr int NPHASE = 1 + 9 * DEPTH;
__device__ __forceinline__ int mktid(int wv0) { int t; asm volatile("v_mbcnt_lo_u32_b32 %0, -1, 0\n\tv_mbcnt_hi_u32_b32 %0, -1, %0" : "=v"(t)); return (t + wv0 * 64) & 511; }
__device__ __forceinline__ Params load_params() {
    Params P{};
#if defined(__HIP_DEVICE_COMPILE__)
    typedef const __attribute__((address_space(4))) unsigned long long* kp_t;
    kp_t kp = (kp_t)__builtin_amdgcn_kernarg_segment_ptr(); asm volatile("" : "+s"(kp));
#pragma unroll
    for (int i = 0; i < 26; ++i) P.in[i] = (const float*)kp[i];
    P.out = (float*)kp[26]; P.ws = (unsigned char*)kp[27];
#endif
    return P;
}
__host__ __device__ __forceinline__ bool phase_nonempty(int ph) {
    if (ph == 0) return true;
    const int layer = (ph - 1) / 9, slot = (ph - 1) % 9;
    if ((layer & 1) && (slot == 3 || slot == 4)) return false;
    return true;
}

__global__ void __launch_bounds__(512) fwd_megakernel(Params Parg) {
    extern __shared__ __attribute__((aligned(16))) unsigned char lds[];
    LAS unsigned char* ldsl = (LAS unsigned char*)lds;
    const int wv0 = __builtin_amdgcn_readfirstlane((int)threadIdx.x >> 6);
    volatile LAS unsigned* bst = (volatile LAS unsigned*)(ldsl + 131072);
    if (threadIdx.x == 0) { bst[0] = 0u; bst[1] = 0u; }
    __syncthreads();
    unsigned* const bar = (unsigned*)(Parg.ws + OFF_BAR);
    const unsigned xcc = xb_xcc_id();
    int nseam = 0;
    bool first = true;
    for (int ph = Parg.ph_lo; ph < Parg.ph_hi; ++ph) {
        if (!phase_nonempty(ph)) continue;
        if (!first) {
            if (nseam == 0) { cg::this_grid().sync(); if (threadIdx.x == 0) (void)xb_add(&bar[XB_XCNT(xcc)], 1u); }
            else xcd_barrier(bar, xcc, bst);
            ++nseam;
        }
        first = false;
        const Params P = load_params();
        unsigned char* ws = P.ws;
        bf16_t* wb = (bf16_t*)(ws + OFF_W);
        bf16_t* hb = (bf16_t*)(ws + OFF_HB);
        float* SS = (float*)(ws + OFF_SS);
        const int G = gridDim.x, c = blockIdx.x;
#ifndef NO_P0
        if (ph == 0) { p0_prologue(mktid(wv0), P, lds); continue; }
#else
        if (ph == 0) continue;
#endif
        const int layer = (ph - 1) / 9, slot = (ph - 1) % 9, j = layer >> 1;
        const bool mla = (layer & 1) == 0;
        float* ss_mix = SS; float* ss_ffn = SS; float* ss_ple = SS;
        float* ss_next = (layer + 1 < DEPTH) ? SS : nullptr;
        const float* hin = (layer == 0) ? P.in[0] : nullptr;
        pg8::StaticOrder S;
        if (slot == 0) {
            if (mla) {
                pg8::Gemm g{hb, wb + WE_DOWN + (size_t)j * LATP * DM, T, LATP, DM, DM}; S.init(T, LATP, G, c);
                pg8::EpiStore<0, 1> E{(bf16_t*)(ws + OFF_FF + FF_LAT), LATP, ss_mix, 1.0f / DM, 16, 0, 16, P.out};
                pg8::gemm_phase(mktid(wv0), ldsl, g, S, E);
            } else {
                pg8::Gemm g{hb, wb + WE_GIN + (size_t)j * ZP * DM, T, ZP, DM, DM}; S.init(T, ZP, G, c);
                pg8::EpiStore<2, 0> E{(bf16_t*)(ws + OFF_FF), ZP, ss_mix, 1.0f / DM, 16, 0, 16, nullptr};
                pg8::gemm_phase(mktid(wv0), ldsl, g, S, E);
            }
        } else if (slot == 1) {
            if (mla) {
                { pg8::Gemm g{(const bf16_t*)(ws + OFF_FF + FF_LAT), wb + WE_UQ + (size_t)j * QP * QLR, T, QP, QLR, LATP}; S.init(T, QP, G, c);
                  pg8::EpiStore<0, 0> E{(bf16_t*)(ws + OFF_FF + FF_Q), QP, P.out, 1.0f / QLR, 24, 0, 12, nullptr};
                  pg8::gemm_phase(mktid(wv0), ldsl, g, S, E); }
                { pg8::Gemm g{(const bf16_t*)(ws + OFF_FF + FF_LAT) + QLR, wb + WE_UKV + (size_t)j * KVP * KVLR, T, KVP, KVLR, LATP}; S.init(T, KVP, G, c);
                  pg8::EpiStore<0, 0> E{(bf16_t*)(ws + OFF_FF + FF_KV), KVP, P.out, 1.0f / KVLR, 24, 12, 20, nullptr};
                  pg8::gemm_phase(mktid(wv0), ldsl, g, S, E); }
            } else {
#ifndef NO_SGU
                sgu_phase(mktid(wv0), P, lds, j);
#endif
            }
        } else if (slot == 2) {
            if (mla) {
#ifndef NO_R2
                r2_phase(mktid(wv0), P, j);
#endif
            } else {
                pg8::Gemm g{(const bf16_t*)(ws + OFF_FF), wb + WE_GOUT + (size_t)j * DM * 2048, T, DM, 2048, ZP}; S.init(T, DM, G, c);
                pg8::EpiRes<0> E{hin, nullptr, hb, ss_ffn, nullptr};
                pg8::gemm_phase(mktid(wv0), ldsl, g, S, E);
            }
        } else if (slot == 3) {
#ifndef NO_ATT
            attn_phase(mktid(wv0), P, lds);
#endif
        } else if (slot == 4) {
            pg8::Gemm g{(const bf16_t*)(ws + OFF_FF + FF_Q), wb + WE_MOUT + (size_t)j * DM * DM, T, DM, DM, QP}; S.init(T, DM, G, c);
            pg8::EpiRes<0> E{hin, nullptr, hb, ss_ffn, nullptr};
            pg8::gemm_phase(mktid(wv0), ldsl, g, S, E);
        } else if (slot == 5) {
            pg8::Gemm g{hb, wb + WE_UP + (size_t)layer * DFF * DM, T, DFF, DM, DM}; S.init(T, DFF, G, c);
            pg8::EpiStore<1, 0> E{(bf16_t*)(ws + OFF_FF), DFF, ss_ffn, 1.0f / DM, 16, 0, 16, nullptr};
            pg8::gemm_phase(mktid(wv0), ldsl, g, S, E);
        } else if (slot == 6) {
            pg8::Gemm g{(const bf16_t*)(ws + OFF_FF), wb + WE_DN + (size_t)layer * DM * DFF, T, DM, DFF, DFF}; S.init(T, DM, G, c);
            pg8::EpiRes<0> E{nullptr, nullptr, hb, ss_ple, nullptr};
            pg8::gemm_phase(mktid(wv0), ldsl, g, S, E);
        } else if (slot == 7) {
            pg8::Gemm g{hb, wb + WE_GATE + (size_t)layer * DM * DM, T, DM, DM, DM}; S.init(T, DM, G, c);
            pg8::EpiStore<3, 0> E{(bf16_t*)(ws + OFF_FF), DM, ss_ple, 1.0f / DM, 16, 0, 16, nullptr};
            pg8::gemm_phase(mktid(wv0), ldsl, g, S, E);
        } else {
            pg8::Gemm g{(const bf16_t*)(ws + OFF_PB) + (size_t)layer * T * PLE, wb + WE_PROJ + (size_t)layer * DM * PLE, T, DM, PLE, PLE}; S.init(T, DM, G, c);
            pg8::EpiRes<1> E{nullptr, (layer == DEPTH - 1) ? P.out : nullptr, hb, ss_next, (const bf16_t*)(ws + OFF_FF)};
            pg8::gemm_phase(mktid(wv0), ldsl, g, S, E);
        }
    }
    asm volatile("s_waitcnt vmcnt(0)" ::: "memory");
    __builtin_amdgcn_fence(__ATOMIC_RELEASE, "agent");
    asm volatile("s_waitcnt vmcnt(0)" ::: "memory");
}


#ifdef DBG_CHECK
__global__ void dbg_check(const bf16_t* A, int lda, const bf16_t* Bt, int K, const bf16_t* C, int ldc, int N, const float* ss, int act, float* out) {
    const unsigned s = blockIdx.x * blockDim.x + threadIdx.x;
    const unsigned hsh = s * 2654435761u; const int row = (hsh >> 8) % T; const int col = (s * 40503u + (hsh >> 3)) % N;
    float acc = 0.f;
    for (int k = 0; k < K; ++k) acc += bf2f(A[(size_t)row * lda + k]) * bf2f(Bt[(size_t)col * K + k]);
    if (ss) acc *= rsqrtf(ss[row] * (1.0f / DM) + EPS);
    if (act == 3) acc = 1.0f / (1.0f + expf(-acc));
    if (act == 1) { acc = fmaxf(acc, 0.f); acc *= acc; }
    const float got = bf2f(C[(size_t)row * ldc + col]);
    if (!(fabsf(got - acc) <= 0.03f + 0.03f * fabsf(acc))) atomicAdd(out + 4096, 1.0f);
}
#endif

#ifdef DBG_CHECK
__global__ void dbg_check_ss(const float* h, const float* ss, float* out) {
    const int row = blockIdx.x * blockDim.x + threadIdx.x; if (row >= T) return;
    float a = 0.f; for (int k = 0; k < DM; ++k) { const float v = h[(size_t)row * DM + k]; a += v * v; }
    const float got = ss[row];
    if (!(fabsf(got - a) <= 1e-3f * fabsf(a))) out[(size_t)row * DM] = 1e30f;
}
#endif

#ifdef DBG_CHECK
__global__ void dbg_zero(float* out) { out[4096 + threadIdx.x] = 0.f; out[8192 + threadIdx.x] = 0.f; }
__global__ void dbg_reduce(float* out) {
    float bc = 0.f, br = 0.f; int ic = 0, ir = 0;
    for (int i = 0; i < 256; ++i) { if (out[4096 + i] > bc) { bc = out[4096 + i]; ic = i; } if (out[8192 + i] > br) { br = out[8192 + i]; ir = i; } }
    float v = 1e6f * out[4096];
    for (int i = 0; i < 256; ++i) { out[4096 + i] = 0.f; out[8192 + i] = 0.f; }
    out[0] = v; out[1] = 1e-3f * bc; out[2] = 1e-3f * br;
}
#endif
constexpr int LDS_BYTES = 131072 + 256 + 2048;
extern "C" void kernel_launch(void* const* d_in, const int* in_sizes, int n_in, void* d_out, int out_size, void* d_ws, size_t ws_size, hipStream_t stream) {
    static int grid = 0;
    if (grid == 0) {
        if (n_in != 26 || out_size != T * DM || ws_size < WS_NEED) { fprintf(stderr, "kernel_launch: unexpected problem (n_in %d out %d ws %zu)\n", n_in, out_size, ws_size); grid = -1; return; }
        int dev = 0, cus = 0, per_cu = 0;
        hipGetDevice(&dev); hipDeviceGetAttribute(&cus, hipDeviceAttributeMultiprocessorCount, dev);
        hipFuncSetAttribute((const void*)fwd_megakernel, hipFuncAttributeMaxDynamicSharedMemorySize, LDS_BYTES);
        hipOccupancyMaxActiveBlocksPerMultiprocessor(&per_cu, (const void*)fwd_megakernel, 512, LDS_BYTES);
        if (per_cu < 1) { fprintf(stderr, "kernel_launch: occupancy query says %d blocks/CU\n", per_cu); per_cu = 1; }
        (void)hipGetLastError();
        grid = cus;
    }
    if (grid < 0) return;
    Params p{};
    for (int i = 0; i < 26; ++i) p.in[i] = (const float*)d_in[i];
    p.out = (float*)d_out; p.ws = (unsigned char*)d_ws;
#if ONE_LAUNCH
    p.ph_lo = 0; p.ph_hi = NPHASE;
    for (int rep = 0; rep < DBG_REPS; ++rep)
    { void* args[] = {&p}; hipError_t e = hipLaunchCooperativeKernel((const void*)fwd_megakernel, dim3(grid), dim3(512), args, LDS_BYTES, stream);
      if (e != hipSuccess) fprintf(stderr, "cooperative launch failed: %s (grid %d)\n", hipGetErrorString(e), grid); }
#else
#ifndef DBG_STOP
#define DBG_STOP (NPHASE - 1)
#endif
    for (int ph = 0; ph <= DBG_STOP; ++ph) {
        if (!phase_nonempty(ph)) continue;
        p.ph_lo = ph; p.ph_hi = ph + 1;
#ifdef DBG_NANFILL
        if (ph == DBG_NANFILL) (void)hipMemsetAsync((char*)d_ws + OFF_FF, 0xFF, 64 * MiB, stream);
#endif
        void* args[] = {&p}; hipError_t e = hipLaunchCooperativeKernel((const void*)fwd_megakernel, dim3(grid), dim3(512), args, LDS_BYTES, stream);
        if (e != hipSuccess) { fprintf(stderr, "cooperative launch failed: %s (grid %d, phase %d)\n", hipGetErrorString(e), grid, ph); break; }
    }
#ifdef DBG_CHECK
    { unsigned char* ws = (unsigned char*)d_ws; bf16_t* wb = (bf16_t*)(ws + OFF_W);
      dbg_zero<<<1, 256, 0, stream>>>((float*)d_out); DBG_CHECK; dbg_reduce<<<1, 1, 0, stream>>>((float*)d_out); }
#endif
#endif
}
```

```cpp
#include <hip/hip_runtime.h>
#include <hip/hip_cooperative_groups.h>
#include <cstdio>
#include <cstdint>
namespace cg = cooperative_groups;

#ifndef DBG_NOGATE
#define DBG_NOGATE 0
#endif
#ifndef DBG_GATE_NOSS
#define DBG_GATE_NOSS 0
#endif
#ifndef DBG_REPS
#define DBG_REPS 1
#endif
#ifndef ONE_LAUNCH
#define ONE_LAUNCH 1
#endif

#define LAS __attribute__((address_space(3)))
typedef unsigned short bf16_t;
typedef short bf16x8 __attribute__((ext_vector_type(8)));
typedef short s16x4 __attribute__((ext_vector_type(4)));
typedef float f32x4 __attribute__((ext_vector_type(4)));
typedef float f32x2 __attribute__((ext_vector_type(2)));
typedef float f32x16 __attribute__((ext_vector_type(16)));
typedef unsigned u32x4 __attribute__((ext_vector_type(4)));
typedef unsigned u32x2 __attribute__((ext_vector_type(2)));

constexpr int T = 32768, DM = 1024, SEQ = 2048, NB = 16, DFF = 4096, PLE = 256, DEPTH = 4;
constexpr int NH = 8, QLR = 384, KVLR = 256, ROPE = 64, LATP = 768;
constexpr int QP = 1536, KVP = 2048, ZP = 4096;
constexpr float EPS = 1e-6f;
constexpr float QSCALE = 0.07216878364870322f * 1.4426950408889634f;

constexpr size_t MiB = 1u << 20;
constexpr size_t OFF_SS = 0;
constexpr size_t OFF_W = 2621440;
constexpr size_t OFF_HB = 112 * MiB;
constexpr size_t OFF_FF = 176 * MiB;
constexpr size_t OFF_PB = 448 * MiB;
constexpr size_t WS_NEED = 512 * MiB;
constexpr size_t OFF_BAR = 2 * MiB;
#define XCD_BAR_WORDS 3456
constexpr size_t WE_DOWN = 0, WE_UQ = WE_DOWN + 2ull * LATP * DM, WE_UKV = WE_UQ + 2ull * QP * QLR, WE_MOUT = WE_UKV + 2ull * KVP * KVLR,
                 WE_GIN = WE_MOUT + 2ull * DM * DM, WE_GOUT = WE_GIN + 2ull * ZP * DM, WE_UP = WE_GOUT + 2ull * DM * 2048,
                 WE_DN = WE_UP + 4ull * DFF * DM, WE_GATE = WE_DN + 4ull * DM * DFF, WE_PROJ = WE_GATE + 4ull * DM * DM, WE_END = WE_PROJ + 4ull * DM * PLE;
static_assert(OFF_W + WE_END * 2 <= OFF_HB, "weights fit");
constexpr size_t FF_Q = 0, FF_KV = 96 * MiB, FF_LAT = 224 * MiB;

struct Params { const float* in[26]; float* out; unsigned char* ws; int ph_lo, ph_hi; };

typedef __bf16 bf16x2_t __attribute__((ext_vector_type(2)));
__device__ __forceinline__ unsigned cvt_pk_bf16(float lo, float hi) { const f32x2 v = {lo, hi}; return __builtin_bit_cast(unsigned, __builtin_convertvector(v, bf16x2_t)); }
__device__ __forceinline__ float bf2f(unsigned short b) { return __uint_as_float((unsigned)b << 16); }
__device__ __forceinline__ float bflo(unsigned u) { return __uint_as_float(u << 16); }
__device__ __forceinline__ float bfhi(unsigned u) { return __uint_as_float(u & 0xffff0000u); }
__device__ __forceinline__ float fast_rcp(float x) { return __builtin_amdgcn_rcpf(x); }
__device__ __forceinline__ float fast_exp2(float x) { return __builtin_amdgcn_exp2f(x); }
__device__ __forceinline__ float gelu_tanh(float x) { const float y = x + 0.044715f * x * x * x; return x * fast_rcp(1.0f + fast_exp2(-2.3022082f * y)); }
__device__ __forceinline__ float sigmoidf_(float x) { return fast_rcp(1.0f + fast_exp2(-1.4426950409f * x)); }

namespace pg8 {
constexpr int BM = 256, BK = 64, HALF = 128, HTB = HALF * BK * 2, STAGE_BYTES = 8 * HTB, NXCD = 8, WGM = 8;
__host__ __device__ __forceinline__ int lds_byte(int r, int c) { const int st = (r >> 4) * 2 + (c >> 5), rr = r & 15, cc = c & 31, ob = rr * 64 + cc * 2; return st * 1024 + (ob ^ (((ob >> 9) & 1) << 5)); }
__host__ __device__ __forceinline__ void stage_rc(int b, int& R, int& C) { const int st = b / 1024, sb = b % 1024, swz = sb ^ (((sb >> 9) & 1) << 5); R = (st >> 1) * 16 + swz / 64; C = (st & 1) * 32 + (swz % 64) / 2; }
__host__ __device__ __forceinline__ int perm32(int rho) { const int n = rho >> 4, i = rho & 15; return 8 * (i >> 2) + 4 * n + (i & 3); }
struct Unit { int pm, pn; };
struct RsCtx { const LAS float* tab; int pmA, pmB; };
struct Gemm { const bf16_t* A; const bf16_t* Bt; int M, N, K, lda; };
struct StaticOrder {
    int nM, nN, nwg, G, c;
    __device__ void init(int M, int N, int G_, int c_) { nM = M / BM; nN = N / BM; nwg = nM * nN; G = G_; c = c_; }
    __device__ bool next(int i, Unit& u) const {
        const long L = (long)i * G + c; if (L >= nwg) return false;
        int wgid = (int)L; { const int q = nwg / NXCD, r = nwg % NXCD, xcd = wgid % NXCD, off = wgid / NXCD; wgid = (xcd < r ? xcd * (q + 1) : r * (q + 1) + (xcd - r) * q) + off; }
        const int nig = WGM * nN, gid = wgid / nig, fm = gid * WGM, gsz = (nM - fm) < WGM ? (nM - fm) : WGM;
        u.pm = fm + ((wgid % nig) % gsz); u.pn = (wgid % nig) / gsz; return true;
    }
};

template <int ACT, int STATS> struct EpiStore {
    static constexpr bool PERM = true; static constexpr bool HAS_RS = true;
    bf16_t* O; int ldc; const float* ss; float inv_n;
    int sst, s0, s1; float* lst;
    __device__ __forceinline__ float row_scale(int row) const { const float* sp = ss + (size_t)row * sst; float t = 0.f; for (int i = s0; i < s1; ++i) t += sp[i]; return rsqrtf(t * inv_n + EPS); }
    __device__ __forceinline__ void operator()(const f32x4 (&acc)[2][2][4][2], const Unit& u, int wr, int wc, int fr, int fq, const RsCtx& rc) const {
        const int row0 = u.pm * BM + wr * 64 + fr, col0 = u.pn * BM + wc * 32 + 8 * fq;
        const int rslot = (u.pm == rc.pmA) ? 0 : ((u.pm == rc.pmB) ? 1 : -1);
#pragma unroll
        for (int ai = 0; ai < 2; ++ai)
#pragma unroll
            for (int m = 0; m < 4; ++m) {
                const int row = row0 + ai * HALF + m * 16;
                float rs = 1.0f;
                if (ss && rslot >= 0) rs = rc.tab[rslot * 256 + wr * 64 + fr + ai * HALF + m * 16];
                else if (ss) rs = row_scale(row);
#pragma unroll
                for (int bj = 0; bj < 2; ++bj) {
                    f32x4 v0 = acc[ai][bj][m][0] * rs, v1 = acc[ai][bj][m][1] * rs;
                    if (ACT == 1) {
#pragma unroll
                        for (int e = 0; e < 4; ++e) { const float a = fmaxf(v0[e], 0.f), b = fmaxf(v1[e], 0.f); v0[e] = a * a; v1[e] = b * b; }
                    }
                    if (ACT == 2) {
#pragma unroll
                        for (int e = 0; e < 4; ++e) { v0[e] = gelu_tanh(v0[e]); v1[e] = gelu_tanh(v1[e]); }
                    }
                    if (ACT == 3) {
#pragma unroll
                        for (int e = 0; e < 4; ++e) { v0[e] = sigmoidf_(v0[e]); v1[e] = sigmoidf_(v1[e]); }
                    }
                    u32x4 w; w.x = cvt_pk_bf16(v0[0], v0[1]); w.y = cvt_pk_bf16(v0[2], v0[3]); w.z = cvt_pk_bf16(v1[0], v1[1]); w.w = cvt_pk_bf16(v1[2], v1[3]);
                    *(u32x4*)(O + (size_t)row * ldc + col0 + bj * HALF) = w;
                    if (STATS == 1) {
                        float q = (v0[0] * v0[0] + v0[1] * v0[1]) + (v0[2] * v0[2] + v0[3] * v0[3]) + (v1[0] * v1[0] + v1[1] * v1[1]) + (v1[2] * v1[2] + v1[3] * v1[3]);
                        q += __shfl_xor(q, 16); q += __shfl_xor(q, 32);
                        if (fq == 0) lst[(size_t)row * 24 + u.pn * 8 + bj * 4 + wc] = q;
                    }
                }
                asm volatile("" ::: "memory");
            }
    }
};
template <int MODE> struct EpiRes {
    static constexpr bool PERM = true; static constexpr bool HAS_RS = false;
    static constexpr int MB = (MODE == 1) ? 2 : 4;
    const float* hin32; float* hout32; bf16_t* hb; float* ssn; const bf16_t* pp;
    __device__ __forceinline__ void operator()(const f32x4 (&acc)[2][2][4][2], const Unit& u, int wr, int wc, int fr, int fq, const RsCtx&) const {
        const int row0 = u.pm * BM + wr * 64 + fr, col0 = u.pn * BM + wc * 32 + 8 * fq;
#pragma unroll
        for (int ai = 0; ai < 2; ++ai)
#pragma unroll
            for (int mg = 0; mg < 4; mg += MB) {
                f32x4 hv[MB][2][2]; u32x4 pw[MB][2];
#pragma unroll
                for (int mm = 0; mm < MB; ++mm)
#pragma unroll
                    for (int bj = 0; bj < 2; ++bj) {
                        const size_t off = (size_t)(row0 + ai * HALF + (mg + mm) * 16) * DM + col0 + bj * HALF;
                        if (hin32) { hv[mm][bj][0] = *(const f32x4*)(hin32 + off); hv[mm][bj][1] = *(const f32x4*)(hin32 + off + 4); }
                        else { const u32x4 b = *(const u32x4*)(hb + off); hv[mm][bj][0] = (f32x4){bflo(b.x), bfhi(b.x), bflo(b.y), bfhi(b.y)}; hv[mm][bj][1] = (f32x4){bflo(b.z), bfhi(b.z), bflo(b.w), bfhi(b.w)}; }
                        if (MODE == 1) pw[mm][bj] = *(const u32x4*)(pp + off);
                    }
#pragma unroll
                for (int mm = 0; mm < MB; ++mm) {
                    const int m = mg + mm, row = row0 + ai * HALF + m * 16;
                    float q = 0.f;
#pragma unroll
                    for (int bj = 0; bj < 2; ++bj) {
                        const size_t off = (size_t)row * DM + col0 + bj * HALF;
                        f32x4 v0 = acc[ai][bj][m][0], v1 = acc[ai][bj][m][1];
                        if (MODE == 1) {
                            const u32x4 g = pw[mm][bj];
                            v0[0] *= bflo(g.x); v0[1] *= bfhi(g.x); v0[2] *= bflo(g.y); v0[3] *= bfhi(g.y);
                            v1[0] *= bflo(g.z); v1[1] *= bfhi(g.z); v1[2] *= bflo(g.w); v1[3] *= bfhi(g.w);
                        }
                        v0 += hv[mm][bj][0]; v1 += hv[mm][bj][1];
                        if (hout32) { *(f32x4*)(hout32 + off) = v0; *(f32x4*)(hout32 + off + 4) = v1; }
                        else { u32x4 w; w.x = cvt_pk_bf16(v0[0], v0[1]); w.y = cvt_pk_bf16(v0[2], v0[3]); w.z = cvt_pk_bf16(v1[0], v1[1]); w.w = cvt_pk_bf16(v1[2], v1[3]);
                               *(u32x4*)(hb + off) = w; }
                        q += (v0[0] * v0[0] + v0[1] * v0[1]) + (v0[2] * v0[2] + v0[3] * v0[3]) + (v1[0] * v1[0] + v1[1] * v1[1]) + (v1[2] * v1[2] + v1[3] * v1[3]);
                    }
                    if (ssn) { q += __shfl_xor(q, 16); q += __shfl_xor(q, 32); if (fq == 0) ssn[(size_t)row * 16 + u.pn * 4 + wc] = q; }
                }
                asm volatile("" ::: "memory");
            }
    }
};

#ifndef PG8_SP2
#define PG8_SP2 true
#endif
#ifndef PG8_ALIGN
#define PG8_ALIGN true
#endif
template <class Epi, bool ALIGN_EPI = PG8_ALIGN, bool SP2 = PG8_SP2>
__device__ __forceinline__ void gemm_phase(int tid, LAS unsigned char* lds, const Gemm g, const StaticOrder& S, const Epi& E) {
    const int wid = __builtin_amdgcn_readfirstlane(tid >> 6), lane = tid & 63, wr = wid >> 2, wc = wid & 3, fr = lane & 15, fq = lane >> 4;
    const int K = g.K, nt = K / BK, lda = g.lda;
    unsigned voffA[2], voffB[2];
#pragma unroll
    for (int i = 0; i < 2; ++i) { int R, C; stage_rc(tid * 16 + i * 8192, R, C); const int Rb = Epi::PERM ? ((R & ~31) + perm32(R & 31)) : R;
        voffA[i] = (unsigned)(R * lda + C) * 2u; voffB[i] = (unsigned)(Rb * K + C) * 2u; }
    const size_t kstep = (size_t)(BK * 2);
    const size_t hstepA = (size_t)HALF * lda * 2, hstepB = (size_t)HALF * K * 2;
    const size_t tstepA = 2 * hstepA, tstepB = 2 * hstepB;
    const unsigned ldsw = (unsigned)wid * 1024u;
    const int aoff = lds_byte(wr * 64 + fr, fq * 8), boff = lds_byte(wc * 32 + fr, fq * 8);
#define PG8_SA(b, h) (((b) * 2 + (h)) * HTB)
#define PG8_SB(b, h) ((4 + (b) * 2 + (h)) * HTB)
#define PG8_STAGE(bufoff, gbase, voff) do { _Pragma("unroll") for (int _i = 0; _i < 2; ++_i) \
        __builtin_amdgcn_global_load_lds((const unsigned*)((const char*)(gbase) + (voff)[_i]), (LAS unsigned*)(lds + (bufoff) + ldsw + _i * 8192), 16, 0, 0); } while (0)
#define PG8_LDA(dst, b, h) do { _Pragma("unroll") for (int m = 0; m < 4; ++m) _Pragma("unroll") for (int k = 0; k < 2; ++k) dst[m][k] = *(const LAS bf16x8*)(lds + PG8_SA(b, h) + aoff + m * 2048 + k * 1024); } while (0)
#define PG8_LDB(dst, b, h) do { _Pragma("unroll") for (int n = 0; n < 2; ++n) _Pragma("unroll") for (int k = 0; k < 2; ++k) dst[n][k] = *(const LAS bf16x8*)(lds + PG8_SB(b, h) + boff + n * 2048 + k * 1024); } while (0)
#define PG8_MMA(ai, bj, At, Bt) do { __builtin_amdgcn_s_setprio(1); _Pragma("unroll") for (int m = 0; m < 4; ++m) _Pragma("unroll") for (int n = 0; n < 2; ++n) _Pragma("unroll") for (int k = 0; k < 2; ++k) \
        acc[ai][bj][m][n] = __builtin_amdgcn_mfma_f32_16x16x32_bf16(Bt[n][k], At[m][k], acc[ai][bj][m][n], 0, 0, 0); __builtin_amdgcn_s_setprio(0); } while (0)
#define PG8_WAIT_V(n) asm volatile("s_waitcnt vmcnt(" #n ")" ::: "memory")
#define PG8_WAIT_L(n) asm volatile("s_waitcnt lgkmcnt(" #n ")" ::: "memory")
#define PG8_BAR __builtin_amdgcn_s_barrier()
#define PG8_SCHED __builtin_amdgcn_sched_barrier(0)
    Unit cur, nxt; int ui = 0;
    if (!S.next(0, cur)) return;
    RsCtx rc; rc.tab = (const LAS float*)(lds + STAGE_BYTES); rc.pmA = cur.pm; rc.pmB = cur.pm;
    if constexpr (Epi::HAS_RS) {
        if (E.ss) {
            Unit lu = cur; for (int i = 1; S.next(i, nxt); ++i) lu = nxt;
            rc.pmB = lu.pm;
            const int rowl = tid & 255, pmx = (tid >> 8) ? rc.pmB : rc.pmA;
            ((LAS float*)(lds + STAGE_BYTES))[tid] = E.row_scale(pmx * BM + rowl);
            __syncthreads();
        }
    }
    f32x4 acc[2][2][4][2];
#pragma unroll
    for (int a = 0; a < 2; ++a)
#pragma unroll
        for (int b = 0; b < 2; ++b)
#pragma unroll
            for (int m = 0; m < 4; ++m)
#pragma unroll
                for (int n = 0; n < 2; ++n) acc[a][b][m][n] = (f32x4){0.f, 0.f, 0.f, 0.f};
    bf16x8 At[4][2], B0[2][2], B1[2][2];
    const char* cA = (const char*)g.A + (size_t)cur.pm * tstepA; const char* cB = (const char*)g.Bt + (size_t)cur.pn * tstepB;
    if constexpr (SP2) {
    PG8_STAGE(PG8_SB(0, 0), cB, voffB); PG8_STAGE(PG8_SB(0, 1), cB + hstepB, voffB); PG8_STAGE(PG8_SA(0, 0), cA, voffA); PG8_STAGE(PG8_SA(0, 1), cA + hstepA, voffA);
    if (wr == 1) PG8_BAR;
    PG8_WAIT_V(2); PG8_BAR;
    PG8_STAGE(PG8_SB(1, 0), cB + kstep, voffB); PG8_STAGE(PG8_SA(1, 0), cA + kstep, voffA); PG8_STAGE(PG8_SB(1, 1), cB + hstepB + kstep, voffB);
    PG8_WAIT_V(6); PG8_BAR;
    } else {
    PG8_STAGE(PG8_SB(0, 0), cB, voffB); PG8_STAGE(PG8_SA(0, 0), cA, voffA); PG8_STAGE(PG8_SB(0, 1), cB + hstepB, voffB); PG8_STAGE(PG8_SA(0, 1), cA + hstepA, voffA);
    if (wr == 1) PG8_BAR;
    PG8_WAIT_V(4); PG8_BAR;
    PG8_STAGE(PG8_SB(1, 0), cB + kstep, voffB); PG8_STAGE(PG8_SA(1, 0), cA + kstep, voffA); PG8_STAGE(PG8_SB(1, 1), cB + hstepB + kstep, voffB);
    PG8_WAIT_V(6); PG8_BAR;
    }
    for (;;) {
        const bool has_next = S.next(ui + 1, nxt);
        const char* nA = has_next ? (const char*)g.A + (size_t)nxt.pm * tstepA : cA; const char* nB = has_next ? (const char*)g.Bt + (size_t)nxt.pn * tstepB : cB;
        for (int t = 0; t < nt; t += 2) {
            const bool last = (t == nt - 2);
            const char* a1 = cA + (size_t)(t + 1) * kstep;
            const char* a2 = last ? nA : cA + (size_t)(t + 2) * kstep; const char* b2 = last ? nB : cB + (size_t)(t + 2) * kstep;
            const char* a3 = a2 + kstep; const char* b3 = b2 + kstep;
            if constexpr (SP2) {
            PG8_LDB(B0, 0, 0); PG8_LDB(B1, 0, 1); PG8_SCHED; PG8_LDA(At, 0, 0); PG8_STAGE(PG8_SA(1, 1), a1 + hstepA, voffA);
            PG8_WAIT_V(8); PG8_WAIT_L(0); PG8_BAR; PG8_MMA(0, 0, At, B0); PG8_MMA(0, 1, At, B1); PG8_BAR; PG8_SCHED;
            PG8_LDA(At, 0, 1); PG8_STAGE(PG8_SB(0, 0), b2, voffB); PG8_STAGE(PG8_SB(0, 1), b2 + hstepB, voffB); PG8_STAGE(PG8_SA(0, 0), a2, voffA);
            PG8_WAIT_V(8); PG8_WAIT_L(0); PG8_BAR; PG8_MMA(1, 0, At, B0); PG8_MMA(1, 1, At, B1); PG8_BAR; PG8_SCHED;
            PG8_LDB(B0, 1, 0); PG8_LDB(B1, 1, 1); PG8_SCHED; PG8_LDA(At, 1, 0); PG8_STAGE(PG8_SA(0, 1), a2 + hstepA, voffA);
            PG8_WAIT_V(8); PG8_WAIT_L(0); PG8_BAR; PG8_MMA(0, 0, At, B0); PG8_MMA(0, 1, At, B1); PG8_BAR; PG8_SCHED;
            PG8_LDA(At, 1, 1); PG8_STAGE(PG8_SB(1, 0), b3, voffB); PG8_STAGE(PG8_SB(1, 1), b3 + hstepB, voffB); PG8_STAGE(PG8_SA(1, 0), a3, voffA);
            PG8_WAIT_V(8); PG8_WAIT_L(0); PG8_BAR; PG8_MMA(1, 0, At, B0); PG8_MMA(1, 1, At, B1); PG8_BAR; PG8_SCHED;
            } else {
            PG8_LDB(B0, 0, 0); PG8_SCHED; PG8_LDA(At, 0, 0); PG8_STAGE(PG8_SA(1, 1), a1 + hstepA, voffA);
            PG8_WAIT_L(8); PG8_BAR; PG8_WAIT_L(0); PG8_MMA(0, 0, At, B0); PG8_BAR; PG8_SCHED;
            PG8_LDB(B1, 0, 1); PG8_STAGE(PG8_SB(0, 0), b2, voffB);
            PG8_BAR; PG8_WAIT_L(0); PG8_MMA(0, 1, At, B1); PG8_BAR;
            PG8_LDA(At, 0, 1); PG8_STAGE(PG8_SA(0, 0), a2, voffA);
            PG8_BAR; PG8_WAIT_L(0); PG8_MMA(1, 0, At, B0); PG8_BAR; PG8_SCHED;
            PG8_STAGE(PG8_SB(0, 1), b2 + hstepB, voffB);
            PG8_WAIT_V(6); PG8_BAR; PG8_MMA(1, 1, At, B1); PG8_BAR;
            PG8_LDB(B0, 1, 0); PG8_SCHED; PG8_LDA(At, 1, 0); PG8_STAGE(PG8_SA(0, 1), a2 + hstepA, voffA);
            PG8_WAIT_L(8); PG8_BAR; PG8_WAIT_L(0); PG8_MMA(0, 0, At, B0); PG8_BAR; PG8_SCHED;
            PG8_LDB(B1, 1, 1); PG8_STAGE(PG8_SB(1, 0), b3, voffB);
            PG8_BAR; PG8_WAIT_L(0); PG8_MMA(0, 1, At, B1); PG8_BAR;
            PG8_LDA(At, 1, 1); PG8_STAGE(PG8_SA(1, 0), a3, voffA);
            PG8_BAR; PG8_WAIT_L(0); PG8_MMA(1, 0, At, B0); PG8_BAR; PG8_SCHED;
            PG8_STAGE(PG8_SB(1, 1), b3 + hstepB, voffB);
            PG8_WAIT_V(6); PG8_BAR; PG8_MMA(1, 1, At, B1); PG8_BAR;
            }
        }
        if constexpr (ALIGN_EPI) { if (wr == 0) PG8_BAR; }
        E(acc, cur, wr, wc, fr, fq, rc);
        if (!has_next) break;
#pragma unroll
        for (int a = 0; a < 2; ++a)
#pragma unroll
            for (int b = 0; b < 2; ++b)
#pragma unroll
                for (int m = 0; m < 4; ++m)
#pragma unroll
                    for (int n = 0; n < 2; ++n) acc[a][b][m][n] = (f32x4){0.f, 0.f, 0.f, 0.f};
        cur = nxt; cA = nA; cB = nB; ++ui;
        if constexpr (ALIGN_EPI) { if (wr == 1) PG8_BAR; }
    }
    PG8_WAIT_V(0);
    if constexpr (!ALIGN_EPI) { if (wr == 0) PG8_BAR; }
    PG8_BAR;
#undef PG8_SA
#undef PG8_SB
#undef PG8_STAGE
#undef PG8_LDA
#undef PG8_LDB
#undef PG8_MMA
#undef PG8_WAIT_V
#undef PG8_WAIT_L
#undef PG8_BAR
#undef PG8_SCHED
}
}

__constant__ double kInvFreq[32] = {
    1.0, 0.7498942093324559, 0.5623413251903491, 0.4216965034285822, 0.31622776601683794, 0.23713737056616552, 0.1778279410038923, 0.1333521432163324,
    0.1, 0.07498942093324558, 0.05623413251903491, 0.04216965034285822, 0.03162277660168379, 0.023713737056616554, 0.01778279410038923, 0.01333521432163324,
    0.01, 0.007498942093324558, 0.005623413251903491, 0.004216965034285823, 0.0031622776601683794, 0.0023713737056616554, 0.001778279410038923, 0.001333521432163324,
    0.001, 0.0007498942093324559, 0.0005623413251903491, 0.0004216965034285823, 0.00031622776601683794, 0.00023713737056616554, 0.0001778279410038923, 0.0001333521432163324};

__device__ __forceinline__ float wave_sum(float v) {
#pragma unroll
    for (int o = 1; o < 64; o <<= 1) v += __shfl_xor(v, o);
    return v;
}
__device__ __forceinline__ void unpack8(const u32x4 w, float (&f)[8]) { f[0] = bflo(w.x); f[1] = bfhi(w.x); f[2] = bflo(w.y); f[3] = bfhi(w.y); f[4] = bflo(w.z); f[5] = bfhi(w.z); f[6] = bflo(w.w); f[7] = bfhi(w.w); }
__device__ __forceinline__ u32x4 pack8(const float (&f)[8]) { u32x4 w; w.x = cvt_pk_bf16(f[0], f[1]); w.y = cvt_pk_bf16(f[2], f[3]); w.z = cvt_pk_bf16(f[4], f[5]); w.w = cvt_pk_bf16(f[6], f[7]); return w; }

struct WDesc { const float* W; const float* gamma; bf16_t* dst; int K, N, Npad, mode, items; };
__device__ __forceinline__ WDesc wdesc(const Params& P, int id) {
    WDesc d; bf16_t* wb = (bf16_t*)(P.ws + OFF_W); d.gamma = nullptr; d.mode = 0;
    if (id < 12) {
        const int j = id & 1, f = id >> 1;
        switch (f) {
            case 0: d.W = P.in[6] + (size_t)j * DM * 704; d.K = DM; d.N = 704; d.Npad = LATP; d.dst = wb + WE_DOWN + (size_t)j * LATP * DM; d.gamma = P.in[3] + (2 * j) * DM; break;
            case 1: d.W = P.in[9] + (size_t)j * QLR * QP; d.K = QLR; d.N = QP; d.Npad = QP; d.dst = wb + WE_UQ + (size_t)j * QP * QLR; d.gamma = P.in[7] + j * QLR; d.mode = 1; break;
            case 2: d.W = P.in[10] + (size_t)j * KVLR * KVP; d.K = KVLR; d.N = KVP; d.Npad = KVP; d.dst = wb + WE_UKV + (size_t)j * KVP * KVLR; d.gamma = P.in[8] + j * KVLR; break;
            case 3: d.W = P.in[15] + (size_t)j * DM * DM; d.K = DM; d.N = DM; d.Npad = DM; d.dst = wb + WE_MOUT + (size_t)j * DM * DM; break;
            case 4: d.W = P.in[16] + (size_t)j * DM * ZP; d.K = DM; d.N = ZP; d.Npad = ZP; d.dst = wb + WE_GIN + (size_t)j * ZP * DM; d.gamma = P.in[3] + (2 * j + 1) * DM; break;
            default: d.W = P.in[21] + (size_t)j * 2048 * DM; d.K = 2048; d.N = DM; d.Npad = DM; d.dst = wb + WE_GOUT + (size_t)j * DM * 2048; break;
        }
    } else {
        const int i = (id - 12) & 3, f = (id - 12) >> 2;
        switch (f) {
            case 0: d.W = P.in[22] + (size_t)i * DM * DFF; d.K = DM; d.N = DFF; d.Npad = DFF; d.dst = wb + WE_UP + (size_t)i * DFF * DM; d.gamma = P.in[4] + i * DM; break;
            case 1: d.W = P.in[23] + (size_t)i * DFF * DM; d.K = DFF; d.N = DM; d.Npad = DM; d.dst = wb + WE_DN + (size_t)i * DM * DFF; break;
            case 2: d.W = P.in[24] + (size_t)i * DM * DM; d.K = DM; d.N = DM; d.Npad = DM; d.dst = wb + WE_GATE + (size_t)i * DM * DM; d.gamma = P.in[5] + i * DM; break;
            default: d.W = P.in[25] + (size_t)i * PLE * DM; d.K = PLE; d.N = DM; d.Npad = DM; d.dst = wb + WE_PROJ + (size_t)i * DM * PLE; break;
        }
    }
    d.items = (d.K / 64) * (d.Npad / 64);
    return d;
}
__device__ __forceinline__ void conv_item(const WDesc& d, int item, float* scr, int lane) {
    const int nblk = d.Npad / 64, kb = item / nblk, nb = item % nblk, k0 = 64 * kb, n0 = 64 * nb;
    int sn0 = n0;
    if (d.mode == 1) { if (n0 < 1024) sn0 = (n0 >> 7) * 192 + (n0 & 127); else { const int r = n0 - 1024; sn0 = (r >> 6) * 192 + 128 + (r & 63); } }
    const bool valid = sn0 < d.N;
    const float* src = d.W + (size_t)k0 * d.N + sn0 + lane;
#pragma unroll
    for (int h = 0; h < 2; ++h) {
        float v[32];
#pragma unroll
        for (int i = 0; i < 32; ++i) v[i] = valid ? src[(size_t)(32 * h + i) * d.N] : 0.f;
#pragma unroll
        for (int i = 0; i < 32; ++i) scr[(32 * h + i) * 65 + lane] = v[i];
    }
    asm volatile("s_waitcnt lgkmcnt(0)" ::: "memory");
    const int c = lane & 7;
    f32x4 ga = {1.f, 1.f, 1.f, 1.f}, gb = {1.f, 1.f, 1.f, 1.f};
    if (d.gamma) { ga = *(const f32x4*)(d.gamma + k0 + 8 * c); gb = *(const f32x4*)(d.gamma + k0 + 8 * c + 4); }
#pragma unroll
    for (int j = 0; j < 8; ++j) { const int n = (lane >> 3) + 8 * j; const float* s = scr + (8 * c) * 65 + n;
        u32x4 o; o.x = cvt_pk_bf16(s[0 * 65] * ga[0], s[1 * 65] * ga[1]); o.y = cvt_pk_bf16(s[2 * 65] * ga[2], s[3 * 65] * ga[3]); o.z = cvt_pk_bf16(s[4 * 65] * gb[0], s[5 * 65] * gb[1]); o.w = cvt_pk_bf16(s[6 * 65] * gb[2], s[7 * 65] * gb[3]);
        *(u32x4*)(d.dst + (size_t)(n0 + n) * d.K + k0 + 8 * c) = o; }
    asm volatile("s_waitcnt lgkmcnt(0)" ::: "memory");
}
__device__ __forceinline__ void p0_prologue(int tid, const Params& P, unsigned char* lds) {
    const int lane = tid & 63, wave = __builtin_amdgcn_readfirstlane(tid >> 6);
    const int gw = blockIdx.x * 8 + wave, NGW = gridDim.x * 8;
    const size_t gt = (size_t)blockIdx.x * 512 + tid, NGT = (size_t)gridDim.x * 512;
    float* scr = (float*)(lds + wave * 16640);
    int total = 0;
    for (int id = 0; id < 28; ++id) total += wdesc(P, id).items;
    for (int it = gw; it < total; it += NGW) {
        int r = it, id = 0; WDesc d = wdesc(P, 0);
        while (r >= d.items) { r -= d.items; ++id; d = wdesc(P, id); }
        conv_item(d, r, scr, lane);
    }
    { unsigned* bw = (unsigned*)(P.ws + OFF_BAR); for (size_t i = gt; i < XCD_BAR_WORDS; i += NGT) bw[i] = 0u; }
    { const f32x4* src = (const f32x4*)P.in[1]; u32x4* dst = (u32x4*)(P.ws + OFF_PB); const size_t n8 = (size_t)DEPTH * T * PLE / 8;
      for (size_t i0 = gt; i0 < n8; i0 += 4 * NGT) {
          f32x4 a[4], b[4];
#pragma unroll
          for (int u = 0; u < 4; ++u) { const size_t i = i0 + u * NGT; if (i < n8) { a[u] = src[2 * i]; b[u] = src[2 * i + 1]; } }
#pragma unroll
          for (int u = 0; u < 4; ++u) { const size_t i = i0 + u * NGT; if (i < n8) { u32x4 w; w.x = cvt_pk_bf16(a[u][0], a[u][1]); w.y = cvt_pk_bf16(a[u][2], a[u][3]); w.z = cvt_pk_bf16(b[u][0], b[u][1]); w.w = cvt_pk_bf16(b[u][2], b[u][3]); dst[i] = w; } } } }
    { float* ssp = (float*)(P.ws + OFF_SS); bf16_t* hb = (bf16_t*)(P.ws + OFF_HB);
#pragma unroll 2
      for (int row = gw; row < T; row += NGW) {
          const f32x4* xr = (const f32x4*)(P.in[0] + (size_t)row * DM) + lane; float s = 0.f;
          unsigned long long* o8 = (unsigned long long*)(hb + (size_t)row * DM) + lane;
#pragma unroll
          for (int j = 0; j < 4; ++j) { const f32x4 v = xr[64 * j]; s += (v[0] * v[0] + v[1] * v[1]) + (v[2] * v[2] + v[3] * v[3]);
              o8[64 * j] = (unsigned long long)cvt_pk_bf16(v[0], v[1]) | ((unsigned long long)cvt_pk_bf16(v[2], v[3]) << 32); }
          s = wave_sum(s); if (lane < 16) ssp[(size_t)row * 16 + lane] = (lane == 0) ? s : 0.f; } }
}

__device__ __forceinline__ void r2_phase(int tid, const Params& P, int j) {
    const int lane = tid & 63, wave = __builtin_amdgcn_readfirstlane(tid >> 6);
    const int gw = blockIdx.x * 8 + wave, NGW = gridDim.x * 8;
    bf16_t* Q = (bf16_t*)(P.ws + OFF_FF + FF_Q); bf16_t* KV = (bf16_t*)(P.ws + OFF_FF + FF_KV); bf16_t* LAT = (bf16_t*)(P.ws + OFF_FF + FF_LAT);
    const float* gqn = P.in[11] + j * 128; const float* gqr = P.in[12] + j * 64; const float* gkn = P.in[13] + j * 128; const float* gkr = P.in[14] + j * 64;
    const int* pos = (const int*)P.in[2];
    float g_qn[2][8], g_kn[2][8], g_qr[8], g_kr[8];
#pragma unroll
    for (int i = 0; i < 2; ++i)
#pragma unroll
        for (int e = 0; e < 8; ++e) { const int d = (8 * lane + 512 * i + e) & 127; g_qn[i][e] = gqn[d] * QSCALE; g_kn[i][e] = gkn[d]; }
#pragma unroll
    for (int e = 0; e < 8; ++e) { const int r = 8 * (lane & 7) + e; g_qr[e] = gqr[r] * QSCALE; g_kr[e] = gkr[r]; }
    const double invf = kInvFreq[lane & 31];
#pragma unroll 2
    for (int row = gw; row < T; row += NGW) {
        const double ang = (double)pos[row] * invf; double rev = ang * 0.15915494309189535; rev -= floor(rev);
        const float cs = __builtin_amdgcn_cosf((float)rev), sn = __builtin_amdgcn_sinf((float)rev);
        float cj[8], sj[8];
#pragma unroll
        for (int e = 0; e < 8; ++e) { cj[e] = __shfl(cs, 8 * (lane & 3) + e); sj[e] = __shfl(sn, 8 * (lane & 3) + e); }
#pragma unroll
        for (int i = 0; i < 2; ++i) {
            const int idx = 8 * lane + 512 * i, head = idx >> 7, d = idx & 127;
            u32x4* qp = (u32x4*)(Q + (size_t)row * QP + idx); u32x4* kp = (u32x4*)(KV + (size_t)row * KVP + head * 256 + d);
            float a[8], b[8]; unpack8(*qp, a); unpack8(*kp, b);
            float sa = 0.f, sb = 0.f;
#pragma unroll
            for (int e = 0; e < 8; ++e) { sa += a[e] * a[e]; sb += b[e] * b[e]; }
#pragma unroll
            for (int o = 1; o < 16; o <<= 1) { sa += __shfl_xor(sa, o); sb += __shfl_xor(sb, o); }
            const float ra = rsqrtf(sa * (1.0f / 128) + EPS), rb = rsqrtf(sb * (1.0f / 128) + EPS);
#pragma unroll
            for (int e = 0; e < 8; ++e) { a[e] = a[e] * ra * g_qn[i][e]; b[e] = b[e] * rb * g_kn[i][e]; }
            *qp = pack8(a); *kp = pack8(b);
        }
        {
            u32x4* qp = (u32x4*)(Q + (size_t)row * QP + 1024 + 8 * lane); u32x4* kp = (u32x4*)(LAT + (size_t)row * LATP + 640 + 8 * (lane & 7));
            float a[8], b[8]; unpack8(*qp, a); unpack8(*kp, b);
            float sa = 0.f, sb = 0.f;
#pragma unroll
            for (int e = 0; e < 8; ++e) { sa += a[e] * a[e]; sb += b[e] * b[e]; }
#pragma unroll
            for (int o = 1; o < 8; o <<= 1) { sa += __shfl_xor(sa, o); sb += __shfl_xor(sb, o); }
            const float ra = rsqrtf(sa * (1.0f / 64) + EPS), rb = rsqrtf(sb * (1.0f / 64) + EPS);
            const bool hi = (lane & 4) != 0;
#pragma unroll
            for (int e = 0; e < 8; ++e) {
                const float ya = a[e] * ra * g_qr[e], yb = b[e] * rb * g_kr[e];
                const float pa = __shfl_xor(ya, 4), pb = __shfl_xor(yb, 4);
                a[e] = hi ? (ya * cj[e] + pa * sj[e]) : (ya * cj[e] - pa * sj[e]);
                b[e] = hi ? (yb * cj[e] + pb * sj[e]) : (yb * cj[e] - pb * sj[e]);
            }
            *qp = pack8(a); if (lane < 8) *kp = pack8(b);
        }
    }
}

constexpr int KROW = 400, VROW = 288, KTILE = 64 * KROW, VTILE = 64 * VROW;
__device__ __forceinline__ void attn_unit(int tid, unsigned char* lds, const bf16_t* Q, const bf16_t* KV, const bf16_t* KR, bf16_t* O, int b, int h, int qb) {
    const int lane = tid & 63, w = __builtin_amdgcn_readfirstlane(tid >> 6), r = lane & 15, g = lane >> 4;
    const int row0 = b * SEQ + qb * 256, qrow = row0 + 32 * w + r;
    bf16x8 qf[2][6];
#pragma unroll
    for (int rg = 0; rg < 2; ++rg) {
#pragma unroll
        for (int ks = 0; ks < 4; ++ks) qf[rg][ks] = *(const bf16x8*)(Q + (size_t)(qrow + 16 * rg) * QP + h * 128 + 32 * ks + 8 * g);
#pragma unroll
        for (int ks = 0; ks < 2; ++ks) qf[rg][4 + ks] = *(const bf16x8*)(Q + (size_t)(qrow + 16 * rg) * QP + 1024 + h * 64 + 32 * ks + 8 * g);
    }
    const int ntiles = 4 * qb + 4, last_tile = 4 * qb + (w >> 1);
    const int kn_row0 = tid >> 4, kn_ch = tid & 15;
    const int kr_row = tid >> 3, kr_ch = tid & 7;
    const bf16_t* gk = KV + (size_t)(b * SEQ) * KVP + h * 256;
    const bf16_t* gr = KR + (size_t)(b * SEQ) * LATP;
    u32x4 sk0, sk1, sr, sv0, sv1;
#define ATT_LOAD(t) do { const size_t kb = (size_t)(t) * 64; \
        sk0 = *(const u32x4*)(gk + (kb + kn_row0) * KVP + kn_ch * 8); sk1 = *(const u32x4*)(gk + (kb + kn_row0 + 32) * KVP + kn_ch * 8); \
        sv0 = *(const u32x4*)(gk + (kb + kn_row0) * KVP + 128 + kn_ch * 8); sv1 = *(const u32x4*)(gk + (kb + kn_row0 + 32) * KVP + 128 + kn_ch * 8); \
        sr = *(const u32x4*)(gr + (kb + kr_row) * LATP + kr_ch * 8); } while (0)
#define ATT_STORE(buf) do { unsigned char* kb_ = lds + (buf) * KTILE; unsigned char* vb_ = lds + 2 * KTILE + (buf) * VTILE; \
        *(u32x4*)(kb_ + kn_row0 * KROW + kn_ch * 16) = sk0; *(u32x4*)(kb_ + (kn_row0 + 32) * KROW + kn_ch * 16) = sk1; \
        *(u32x4*)(kb_ + kr_row * KROW + 256 + kr_ch * 16) = sr; \
        *(u32x4*)(vb_ + kn_row0 * VROW + kn_ch * 16) = sv0; *(u32x4*)(vb_ + (kn_row0 + 32) * VROW + kn_ch * 16) = sv1; } while (0)
    f32x4 o[2][8];
#pragma unroll
    for (int rg = 0; rg < 2; ++rg)
#pragma unroll
        for (int i = 0; i < 8; ++i) o[rg][i] = (f32x4){0.f, 0.f, 0.f, 0.f};
    float m[2] = {-1e30f, -1e30f}, l[2] = {0.f, 0.f};
    ATT_LOAD(0); ATT_STORE(0);
    __syncthreads();
    const int q4 = r >> 2, p4 = lane & 3;
    const int vtr_off = (4 * g + q4) * VROW + (4 * p4) * 2;
    const int qidx = qb * 256 + 32 * w + r;
    for (int t = 0; t < ntiles; ++t) {
        const bool more = (t + 1 < ntiles);
        if (more) ATT_LOAD(t + 1);
        if (t <= last_tile) {
            const unsigned char* Kb = lds + (t & 1) * KTILE; const unsigned char* Vb = lds + 2 * KTILE + (t & 1) * VTILE;
            f32x4 p[2][4];
#pragma unroll
            for (int kb = 0; kb < 4; ++kb) {
                p[0][kb] = (f32x4){0.f, 0.f, 0.f, 0.f}; p[1][kb] = (f32x4){0.f, 0.f, 0.f, 0.f};
#pragma unroll
                for (int ks = 0; ks < 6; ++ks) {
                    const bf16x8 a = *(const bf16x8*)(Kb + (16 * kb + r) * KROW + ks * 64 + g * 16);
                    p[0][kb] = __builtin_amdgcn_mfma_f32_16x16x32_bf16(a, qf[0][ks], p[0][kb], 0, 0, 0);
                    p[1][kb] = __builtin_amdgcn_mfma_f32_16x16x32_bf16(a, qf[1][ks], p[1][kb], 0, 0, 0);
                }
            }
            const bool diag = (t * 64 + 63 > qb * 256 + 32 * w);
            bf16x8 pb[2][2];
#pragma unroll
            for (int rg = 0; rg < 2; ++rg) {
                if (diag) {
#pragma unroll
                    for (int kb = 0; kb < 4; ++kb)
#pragma unroll
                        for (int i = 0; i < 4; ++i) { const int kk = t * 64 + 16 * kb + 4 * g + i; if (kk > qidx + 16 * rg) p[rg][kb][i] = -1e30f; }
                }
                float mx = fmaxf(fmaxf(p[rg][0][0], p[rg][0][1]), fmaxf(p[rg][0][2], p[rg][0][3]));
#pragma unroll
                for (int kb = 1; kb < 4; ++kb) mx = fmaxf(mx, fmaxf(fmaxf(p[rg][kb][0], p[rg][kb][1]), fmaxf(p[rg][kb][2], p[rg][kb][3])));
                mx = fmaxf(mx, __shfl_xor(mx, 16)); mx = fmaxf(mx, __shfl_xor(mx, 32));
                if (!__all(mx <= m[rg] + 8.0f)) {
                    const float mn = fmaxf(m[rg], mx), alpha = fast_exp2(m[rg] - mn); m[rg] = mn;
                    l[rg] *= alpha;
#pragma unroll
                    for (int i = 0; i < 8; ++i) o[rg][i] *= alpha;
                }
                const float mref = m[rg];
                float rsum = 0.f;
#pragma unroll
                for (int kb = 0; kb < 4; ++kb)
#pragma unroll
                    for (int i = 0; i < 4; ++i) { p[rg][kb][i] = fast_exp2(p[rg][kb][i] - mref); rsum += p[rg][kb][i]; }
                l[rg] += rsum;
#pragma unroll
                for (int kk = 0; kk < 2; ++kk) {
                    u32x4 pw; pw.x = cvt_pk_bf16(p[rg][2 * kk][0], p[rg][2 * kk][1]); pw.y = cvt_pk_bf16(p[rg][2 * kk][2], p[rg][2 * kk][3]);
                    pw.z = cvt_pk_bf16(p[rg][2 * kk + 1][0], p[rg][2 * kk + 1][1]); pw.w = cvt_pk_bf16(p[rg][2 * kk + 1][2], p[rg][2 * kk + 1][3]);
                    pb[rg][kk] = __builtin_bit_cast(bf16x8, pw);
                }
            }
#pragma unroll
            for (int db = 0; db < 8; ++db)
#pragma unroll
                for (int kk = 0; kk < 2; ++kk) {
                    const LAS unsigned char* vp = (const LAS unsigned char*)(Vb + vtr_off + (32 * kk) * VROW + db * 32);
                    const s16x4 lo = __builtin_bit_cast(s16x4, __builtin_amdgcn_ds_read_tr16_b64_v4i16((LAS s16x4*)vp));
                    const s16x4 hi = __builtin_bit_cast(s16x4, __builtin_amdgcn_ds_read_tr16_b64_v4i16((LAS s16x4*)(vp + 16 * VROW)));
                    const bf16x8 vf = __builtin_shufflevector(lo, hi, 0, 1, 2, 3, 4, 5, 6, 7);
                    o[0][db] = __builtin_amdgcn_mfma_f32_16x16x32_bf16(vf, pb[0][kk], o[0][db], 0, 0, 0);
                    o[1][db] = __builtin_amdgcn_mfma_f32_16x16x32_bf16(vf, pb[1][kk], o[1][db], 0, 0, 0);
                }
        }
        if (more) ATT_STORE((t + 1) & 1);
        __syncthreads();
    }
#pragma unroll
    for (int rg = 0; rg < 2; ++rg) {
        float ls = l[rg]; ls += __shfl_xor(ls, 16); ls += __shfl_xor(ls, 32);
        const float inv = fast_rcp(ls);
        bf16_t* orow = O + (size_t)(qrow + 16 * rg) * QP + h * 128 + 4 * g;
#pragma unroll
        for (int db = 0; db < 8; ++db) {
            u32x2 wv; wv.x = cvt_pk_bf16(o[rg][db][0] * inv, o[rg][db][1] * inv); wv.y = cvt_pk_bf16(o[rg][db][2] * inv, o[rg][db][3] * inv);
            *(u32x2*)(orow + 16 * db) = wv;
        }
    }
#undef ATT_LOAD
#undef ATT_STORE
}
__device__ __forceinline__ void attn_phase(int tid, const Params& P, unsigned char* lds) {
    bf16_t* Q = (bf16_t*)(P.ws + OFF_FF + FF_Q); const bf16_t* KV = (const bf16_t*)(P.ws + OFF_FF + FF_KV); const bf16_t* KR = (const bf16_t*)(P.ws + OFF_FF + FF_LAT) + 640;
    const int nwg8 = (gridDim.x % 8 == 0) ? gridDim.x / 8 : 0;
    for (int it = 0;; ++it) {
        int pr;
        if (nwg8) { const int idx = (int)(blockIdx.x >> 3) + it * nwg8; if (idx >= 64) break; pr = (int)(blockIdx.x & 7) * 64 + idx; }
        else { pr = blockIdx.x + it * gridDim.x; if (pr >= 512) break; }
        const int bh = pr >> 2, x = pr & 3, b = bh >> 3, h = bh & 7;
        attn_unit(tid, lds, Q, KV, KR, Q, b, h, 7 - x);
        attn_unit(tid, lds, Q, KV, KR, Q, b, h, x);
    }
}

constexpr int SROW = 576;
constexpr int SGU_STAT_OFF = 128 * SROW;
constexpr int SGU_W_OFF = SGU_STAT_OFF + 2048, SWROW = 272;
__device__ __forceinline__ void sgu_phase(int tid, const Params& P, unsigned char* lds, int j) {
    const int lane = tid & 63, w = __builtin_amdgcn_readfirstlane(tid >> 6), r = lane & 31, hh = lane >> 5;
    bf16_t* Z = (bf16_t*)(P.ws + OFF_FF);
    const float* lng = P.in[17] + j * 2048; const float* lnb = P.in[18] + j * 2048;
    const float* wsp = P.in[19] + (size_t)j * 8 * 128 * 128; const float* bsp = P.in[20] + j * 8 * 128;
    const int q4 = (lane & 15) >> 2, p4 = lane & 3, colblk = (lane >> 4) & 1;
    f32x2* stl = (f32x2*)(lds + SGU_STAT_OFF);
    for (int unit = blockIdx.x; unit < 256; unit += gridDim.x) {
        const int row0 = unit * 128;
        for (int rr0 = 0; rr0 < 16; rr0 += 4) {
            u32x4 raw[4][4];
#pragma unroll
            for (int a = 0; a < 4; ++a)
#pragma unroll
                for (int i = 0; i < 4; ++i) raw[a][i] = *(const u32x4*)(Z + (size_t)(row0 + 16 * w + rr0 + a) * ZP + 2048 + 8 * lane + 512 * i);
#pragma unroll
            for (int a = 0; a < 4; ++a) {
                float s1 = 0.f, s2 = 0.f;
#pragma unroll
                for (int i = 0; i < 4; ++i) { float v[8]; unpack8(raw[a][i], v);
#pragma unroll
                    for (int e = 0; e < 8; ++e) { s1 += v[e]; s2 += v[e] * v[e]; } }
                s1 = wave_sum(s1); s2 = wave_sum(s2);
                const float mu = s1 * (1.0f / 2048), var = s2 * (1.0f / 2048) - mu * mu;
                if (lane == 0) stl[16 * w + rr0 + a] = (f32x2){mu, rsqrtf(fmaxf(var, 0.f) + EPS)};
            }
        }
        __syncthreads();
        for (int g = 0; g < 8; ++g) {
#pragma unroll 2
            for (int i = 0; i < 8; ++i) {
                const int chunk = tid + 512 * i, row = chunk >> 5, ch = chunk & 31, col = g * 256 + ch * 8;
                float v[8]; unpack8(*(const u32x4*)(Z + (size_t)(row0 + row) * ZP + 2048 + col), v);
                const f32x2 st = stl[row]; const float mu = st.x, rstd = st.y;
                const f32x4 g0 = *(const f32x4*)(lng + col), g1 = *(const f32x4*)(lng + col + 4), b0 = *(const f32x4*)(lnb + col), b1 = *(const f32x4*)(lnb + col + 4);
#pragma unroll
                for (int e = 0; e < 4; ++e) { v[e] = (v[e] - mu) * rstd * g0[e] + b0[e]; v[4 + e] = (v[4 + e] - mu) * rstd * g1[e] + b1[e]; }
                *(u32x4*)(lds + row * SROW + ch * 16) = pack8(v);
            }
            {
                const float* wg = wsp + (size_t)g * 128 * 128;
                f32x4 w0[4], w1[4];
#pragma unroll
                for (int i = 0; i < 4; ++i) { const int c = tid + 512 * i, t = c >> 4, s0 = (c & 15) * 8; w0[i] = *(const f32x4*)(wg + t * 128 + s0); w1[i] = *(const f32x4*)(wg + t * 128 + s0 + 4); }
#pragma unroll
                for (int i = 0; i < 4; ++i) { const int c = tid + 512 * i, t = c >> 4, s0 = (c & 15) * 8;
                    float wv[8] = {w0[i][0], w0[i][1], w0[i][2], w0[i][3], w1[i][0], w1[i][1], w1[i][2], w1[i][3]};
#pragma unroll
                    for (int e = 0; e < 8; ++e) if (s0 + e > t) wv[e] = 0.f;
                    *(u32x4*)(lds + SGU_W_OFF + t * SWROW + s0 * 2) = pack8(wv); }
            }
            __syncthreads();
            bf16x8 af[8];
#pragma unroll
            for (int ks = 0; ks < 8; ++ks) {
                const LAS unsigned char* vp = (const LAS unsigned char*)(lds + (16 * ks + 8 * hh + q4) * SROW + (32 * w + 16 * colblk + 4 * p4) * 2);
                const s16x4 lo = __builtin_bit_cast(s16x4, __builtin_amdgcn_ds_read_tr16_b64_v4i16((LAS s16x4*)vp));
                const s16x4 hi = __builtin_bit_cast(s16x4, __builtin_amdgcn_ds_read_tr16_b64_v4i16((LAS s16x4*)(vp + 4 * SROW)));
                af[ks] = __builtin_shufflevector(lo, hi, 0, 1, 2, 3, 4, 5, 6, 7);
            }
#pragma unroll
            for (int tb = 0; tb < 4; ++tb) {
                f32x16 acc;
#pragma unroll
                for (int e = 0; e < 16; ++e) acc[e] = 0.f;
                const int t = 32 * tb + r;
#pragma unroll
                for (int ks = 0; ks < 8; ++ks) {
                    if (ks <= 2 * tb + 1) {
                        const bf16x8 bfr = *(const bf16x8*)(lds + SGU_W_OFF + t * SWROW + (16 * ks + 8 * hh) * 2);
                        acc = __builtin_amdgcn_mfma_f32_32x32x16_bf16(af[ks], bfr, acc, 0, 0, 0);
                    }
                }
                const float bias = bsp[g * 128 + t];
                bf16_t* up = Z + (size_t)(row0 + t) * ZP + g * 256 + 32 * w + 4 * hh;
#pragma unroll
                for (int i4 = 0; i4 < 4; ++i4) {
                    const u32x2 uu = *(const u32x2*)(up + 8 * i4);
                    u32x2 y; y.x = cvt_pk_bf16(bflo(uu.x) * (acc[4 * i4] + bias), bfhi(uu.x) * (acc[4 * i4 + 1] + bias));
                    y.y = cvt_pk_bf16(bflo(uu.y) * (acc[4 * i4 + 2] + bias), bfhi(uu.y) * (acc[4 * i4 + 3] + bias));
                    *(u32x2*)(up + 8 * i4) = y;
                }
            }
            __syncthreads();
        }
    }
}


#define XB_TMO      128
#define XB_XCNT(j)  (256  + 64 * (j))
#define XB_XSUB(j)  (1280 + 64 * (j))
#define XB_XGEN(j)  (2304 + 64 * (j))
#define XB_TOP      3328
#define XB_TOPGEN   3392
#define XB_SPIN_CAP (1u << 22)
__device__ __forceinline__ unsigned xb_ld(unsigned* p)              { return __hip_atomic_load(p, __ATOMIC_RELAXED, __HIP_MEMORY_SCOPE_AGENT); }
__device__ __forceinline__ unsigned xb_add(unsigned* p, unsigned v) { return __hip_atomic_fetch_add(p, v, __ATOMIC_RELAXED, __HIP_MEMORY_SCOPE_AGENT); }
__device__ __forceinline__ unsigned xb_xcc_id() { return (unsigned)__builtin_amdgcn_s_getreg((3 << 11) | 20) & 0xFu; }
#define XB_SPIN(cond, bar) do { unsigned _sp = 0; while (cond) { __builtin_amdgcn_s_sleep(1); \
    if ((++_sp & 255u) == 0u) { if (xb_ld(&(bar)[XB_TMO])) break; if (_sp > XB_SPIN_CAP) { atomicAdd(&(bar)[XB_TMO], 1u); break; } } } } while (0)
__device__ __forceinline__ void xcd_barrier_complete(unsigned* bar, unsigned x, unsigned& nloc, unsigned& nx) {
    const unsigned G = gridDim.x;
    unsigned sum, cnt, mine, sp = 0u;
    for (;;) {
        sum = 0u; cnt = 0u; mine = 0u;
#pragma unroll
        for (unsigned j = 0; j < 16; ++j) { const unsigned c = xb_ld(&bar[XB_XCNT(j)]); sum += c; cnt += (c > 0u) ? 1u : 0u; mine = (j == x) ? c : mine; }
        if (sum == G) break;
        __builtin_amdgcn_s_sleep(1);
        if ((++sp & 255u) == 0u) { if (xb_ld(&bar[XB_TMO])) break; if (sp > XB_SPIN_CAP) { atomicAdd(&bar[XB_TMO], 1u); break; } }
    }
    nloc = mine > 0u ? mine : 1u; nx = cnt > 0u ? cnt : 1u;
}
__device__ __forceinline__ void xcd_barrier(unsigned* bar, unsigned x, volatile LAS unsigned* st) {
    asm volatile("s_waitcnt vmcnt(0)" ::: "memory");
    __syncthreads();
    if (threadIdx.x == 0) {
        __builtin_amdgcn_s_waitcnt(0);
        unsigned nloc = st[0], nx = st[1];
        if (nloc == 0u) { xcd_barrier_complete(bar, x, nloc, nx); st[0] = nloc; st[1] = nx; }
        const unsigned old = xb_add(&bar[XB_XSUB(x)], 1u);
        const unsigned gen = old / nloc;
        if (old + 1u == (gen + 1u) * nloc) {
            __builtin_amdgcn_fence(__ATOMIC_RELEASE, "agent");
            asm volatile("s_waitcnt vmcnt(0)" ::: "memory");
            const unsigned og = xb_add(&bar[XB_TOP], 1u);
            const unsigned tg = og / nx;
            if (og + 1u == (tg + 1u) * nx) xb_add(&bar[XB_TOPGEN], 1u);
            else XB_SPIN(xb_ld(&bar[XB_TOPGEN]) == tg, bar);
            __builtin_amdgcn_fence(__ATOMIC_ACQUIRE, "agent");
            xb_add(&bar[XB_XGEN(x)], 1u);
            asm volatile("s_waitcnt vmcnt(0)" ::: "memory");
        } else {
            XB_SPIN(xb_ld(&bar[XB_XGEN(x)]) == gen, bar);
            __builtin_amdgcn_fence(__ATOMIC_ACQUIRE, "agent");
            asm volatile("s_waitcnt vmcnt(0)" ::: "memory");
        }
    }
    __syncthreads();
}

constexpr int NPHASE = 1 + 9 * DEPTH;
__device__ __forceinline__ int mktid(int wv0) { int t; asm volatile("v_mbcnt_lo_u32_b32 %0, -1, 0\n\tv_mbcnt_hi_u32_b32 %0, -1, %0" : "=v"(t)); return (t + wv0 * 64) & 511; }
__device__ __forceinline__ Params load_params() {
    Params P{};
#if defined(__HIP_DEVICE_COMPILE__)
    typedef const __attribute__((address_space(4))) unsigned long long* kp_t;
    kp_t kp = (kp_t)__builtin_amdgcn_kernarg_segment_ptr(); asm volatile("" : "+s"(kp));
#pragma unroll
    for (int i = 0; i < 26; ++i) P.in[i] = (const float*)kp[i];
    P.out = (float*)kp[26]; P.ws = (unsigned char*)kp[27];
#endif
    return P;
}
__host__ __device__ __forceinline__ bool phase_nonempty(int ph) {
    if (ph == 0) return true;
    const int layer = (ph - 1) / 9, slot = (ph - 1) % 9;
    if ((layer & 1) && (slot == 3 || slot == 4)) return false;
    return true;
}

__global__ void __launch_bounds__(512) fwd_megakernel(Params Parg) {
    extern __shared__ __attribute__((aligned(16))) unsigned char lds[];
    LAS unsigned char* ldsl = (LAS unsigned char*)lds;
    const int wv0 = __builtin_amdgcn_readfirstlane((int)threadIdx.x >> 6);
    volatile LAS unsigned* bst = (volatile LAS unsigned*)(ldsl + 133120);
    if (threadIdx.x == 0) { bst[0] = 0u; bst[1] = 0u; }
    __syncthreads();
    unsigned* const bar = (unsigned*)(Parg.ws + OFF_BAR);
    const unsigned xcc = xb_xcc_id();
    int nseam = 0;
    bool first = true;
    for (int ph = Parg.ph_lo; ph < Parg.ph_hi; ++ph) {
        if (!phase_nonempty(ph)) continue;
        if (!first) {
            if (nseam == 0) { cg::this_grid().sync(); if (threadIdx.x == 0) (void)xb_add(&bar[XB_XCNT(xcc)], 1u); }
            else xcd_barrier(bar, xcc, bst);
            ++nseam;
        }
        first = false;
        const Params P = load_params();
        unsigned char* ws = P.ws;
        bf16_t* wb = (bf16_t*)(ws + OFF_W);
        bf16_t* hb = (bf16_t*)(ws + OFF_HB);
        float* SS = (float*)(ws + OFF_SS);
        const int G = gridDim.x, c = blockIdx.x;
#ifndef NO_P0
        if (ph == 0) { p0_prologue(mktid(wv0), P, lds); continue; }
#else
        if (ph == 0) continue;
#endif
        const int layer = (ph - 1) / 9, slot = (ph - 1) % 9, j = layer >> 1;
        const bool mla = (layer & 1) == 0;
        float* ss_mix = SS; float* ss_ffn = SS; float* ss_ple = SS;
        float* ss_next = (layer + 1 < DEPTH) ? SS : nullptr;
        const float* hin = (layer == 0) ? P.in[0] : nullptr;
        pg8::StaticOrder S;
        if (slot == 0) {
            if (mla) {
                pg8::Gemm g{hb, wb + WE_DOWN + (size_t)j * LATP * DM, T, LATP, DM, DM}; S.init(T, LATP, G, c);
                pg8::EpiStore<0, 1> E{(bf16_t*)(ws + OFF_FF + FF_LAT), LATP, ss_mix, 1.0f / DM, 16, 0, 16, P.out};
                pg8::gemm_phase(mktid(wv0), ldsl, g, S, E);
            } else {
                pg8::Gemm g{hb, wb + WE_GIN + (size_t)j * ZP * DM, T, ZP, DM, DM}; S.init(T, ZP, G, c);
                pg8::EpiStore<2, 0> E{(bf16_t*)(ws + OFF_FF), ZP, ss_mix, 1.0f / DM, 16, 0, 16, nullptr};
                pg8::gemm_phase(mktid(wv0), ldsl, g, S, E);
            }
        } else if (slot == 1) {
            if (mla) {
                { pg8::Gemm g{(const bf16_t*)(ws + OFF_FF + FF_LAT), wb + WE_UQ + (size_t)j * QP * QLR, T, QP, QLR, LATP}; S.init(T, QP, G, c);
                  pg8::EpiStore<0, 0> E{(bf16_t*)(ws + OFF_FF + FF_Q), QP, P.out, 1.0f / QLR, 24, 0, 12, nullptr};
                  pg8::gemm_phase(mktid(wv0), ldsl, g, S, E); }
                { pg8::Gemm g{(const bf16_t*)(ws + OFF_FF + FF_LAT) + QLR, wb + WE_UKV + (size_t)j * KVP * KVLR, T, KVP, KVLR, LATP}; S.init(T, KVP, G, c);
                  pg8::EpiStore<0, 0> E{(bf16_t*)(ws + OFF_FF + FF_KV), KVP, P.out, 1.0f / KVLR, 24, 12, 20, nullptr};
                  pg8::gemm_phase(mktid(wv0), ldsl, g, S, E); }
            } else {
#ifndef NO_SGU
                sgu_phase(mktid(wv0), P, lds, j);
#endif
            }
        } else if (slot == 2) {
            if (mla) {
#ifndef NO_R2
                r2_phase(mktid(wv0), P, j);
#endif
            } else {
                pg8::Gemm g{(const bf16_t*)(ws + OFF_FF), wb + WE_GOUT + (size_t)j * DM * 2048, T, DM, 2048, ZP}; S.init(T, DM, G, c);
                pg8::EpiRes<0> E{hin, nullptr, hb, ss_ffn, nullptr};
                pg8::gemm_phase(mktid(wv0), ldsl, g, S, E);
            }
        } else if (slot == 3) {
#ifndef NO_ATT
            attn_phase(mktid(wv0), P, lds);
#endif
        } else if (slot == 4) {
            pg8::Gemm g{(const bf16_t*)(ws + OFF_FF + FF_Q), wb + WE_MOUT + (size_t)j * DM * DM, T, DM, DM, QP}; S.init(T, DM, G, c);
            pg8::EpiRes<0> E{hin, nullptr, hb, ss_ffn, nullptr};
            pg8::gemm_phase(mktid(wv0), ldsl, g, S, E);
        } else if (slot == 5) {
            pg8::Gemm g{hb, wb + WE_UP + (size_t)layer * DFF * DM, T, DFF, DM, DM}; S.init(T, DFF, G, c);
            pg8::EpiStore<1, 0> E{(bf16_t*)(ws + OFF_FF), DFF, ss_ffn, 1.0f / DM, 16, 0, 16, nullptr};
            pg8::gemm_phase(mktid(wv0), ldsl, g, S, E);
        } else if (slot == 6) {
            pg8::Gemm g{(const bf16_t*)(ws + OFF_FF), wb + WE_DN + (size_t)layer * DM * DFF, T, DM, DFF, DFF}; S.init(T, DM, G, c);
            pg8::EpiRes<0> E{nullptr, nullptr, hb, ss_ple, nullptr};
            pg8::gemm_phase(mktid(wv0), ldsl, g, S, E);
        } else if (slot == 7) {
            pg8::Gemm g{hb, wb + WE_GATE + (size_t)layer * DM * DM, T, DM, DM, DM}; S.init(T, DM, G, c);
            pg8::EpiStore<3, 0> E{(bf16_t*)(ws + OFF_FF), DM, ss_ple, 1.0f / DM, 16, 0, 16, nullptr};
            pg8::gemm_phase(mktid(wv0), ldsl, g, S, E);
        } else {
            pg8::Gemm g{(const bf16_t*)(ws + OFF_PB) + (size_t)layer * T * PLE, wb + WE_PROJ + (size_t)layer * DM * PLE, T, DM, PLE, PLE}; S.init(T, DM, G, c);
            pg8::EpiRes<1> E{nullptr, (layer == DEPTH - 1) ? P.out : nullptr, hb, ss_next, (const bf16_t*)(ws + OFF_FF)};
            pg8::gemm_phase(mktid(wv0), ldsl, g, S, E);
        }
    }
    asm volatile("s_waitcnt vmcnt(0)" ::: "memory");
    __builtin_amdgcn_fence(__ATOMIC_RELEASE, "agent");
    asm volatile("s_waitcnt vmcnt(0)" ::: "memory");
}


#ifdef DBG_CHECK
__global__ void dbg_check(const bf16_t* A, int lda, const bf16_t* Bt, int K, const bf16_t* C, int ldc, int N, const float* ss, int act, float* out) {
    const unsigned s = blockIdx.x * blockDim.x + threadIdx.x;
    const unsigned hsh = s * 2654435761u; const int row = (hsh >> 8) % T; const int col = (s * 40503u + (hsh >> 3)) % N;
    float acc = 0.f;
    for (int k = 0; k < K; ++k) acc += bf2f(A[(size_t)row * lda + k]) * bf2f(Bt[(size_t)col * K + k]);
    if (ss) acc *= rsqrtf(ss[row] * (1.0f / DM) + EPS);
    if (act == 3) acc = 1.0f / (1.0f + expf(-acc));
    if (act == 1) { acc = fmaxf(acc, 0.f); acc *= acc; }
    const float got = bf2f(C[(size_t)row * ldc + col]);
    if (!(fabsf(got - acc) <= 0.03f + 0.03f * fabsf(acc))) atomicAdd(out + 4096, 1.0f);
}
#endif

#ifdef DBG_CHECK
__global__ void dbg_check_ss(const float* h, const float* ss, float* out) {
    const int row = blockIdx.x * blockDim.x + threadIdx.x; if (row >= T) return;
    float a = 0.f; for (int k = 0; k < DM; ++k) { const float v = h[(size_t)row * DM + k]; a += v * v; }
    const float got = ss[row];
    if (!(fabsf(got - a) <= 1e-3f * fabsf(a))) out[(size_t)row * DM] = 1e30f;
}
#endif

#ifdef DBG_CHECK
__global__ void dbg_zero(float* out) { out[4096 + threadIdx.x] = 0.f; out[8192 + threadIdx.x] = 0.f; }
__global__ void dbg_reduce(float* out) {
    float bc = 0.f, br = 0.f; int ic = 0, ir = 0;
    for (int i = 0; i < 256; ++i) { if (out[4096 + i] > bc) { bc = out[4096 + i]; ic = i; } if (out[8192 + i] > br) { br = out[8192 + i]; ir = i; } }
    float v = 1e6f * out[4096];
    for (int i = 0; i < 256; ++i) { out[4096 + i] = 0.f; out[8192 + i] = 0.f; }
    out[0] = v; out[1] = 1e-3f * bc; out[2] = 1e-3f * br;
}
#endif
constexpr int LDS_BYTES = 131072 + 2048 + 256;
extern "C" void kernel_launch(void* const* d_in, const int* in_sizes, int n_in, void* d_out, int out_size, void* d_ws, size_t ws_size, hipStream_t stream) {
    static int grid = 0;
    if (grid == 0) {
        if (n_in != 26 || out_size != T * DM || ws_size < WS_NEED) { fprintf(stderr, "kernel_launch: unexpected problem (n_in %d out %d ws %zu)\n", n_in, out_size, ws_size); grid = -1; return; }
        int dev = 0, cus = 0, per_cu = 0;
        hipGetDevice(&dev); hipDeviceGetAttribute(&cus, hipDeviceAttributeMultiprocessorCount, dev);
        hipFuncSetAttribute((const void*)fwd_megakernel, hipFuncAttributeMaxDynamicSharedMemorySize, LDS_BYTES);
        hipOccupancyMaxActiveBlocksPerMultiprocessor(&per_cu, (const void*)fwd_megakernel, 512, LDS_BYTES);
        if (per_cu < 1) { fprintf(stderr, "kernel_launch: occupancy query says %d blocks/CU\n", per_cu); per_cu = 1; }
        (void)hipGetLastError();
        grid = cus;
    }
    if (grid < 0) return;
    Params p{};
    for (int i = 0; i < 26; ++i) p.in[i] = (const float*)d_in[i];
    p.out = (float*)d_out; p.ws = (unsigned char*)d_ws;
#if ONE_LAUNCH
    p.ph_lo = 0; p.ph_hi = NPHASE;
    for (int rep = 0; rep < DBG_REPS; ++rep)
    { void* args[] = {&p}; hipError_t e = hipLaunchCooperativeKernel((const void*)fwd_megakernel, dim3(grid), dim3(512), args, LDS_BYTES, stream);
      if (e != hipSuccess) fprintf(stderr, "cooperative launch failed: %s (grid %d)\n", hipGetErrorString(e), grid); }
#else
#ifndef DBG_STOP
#define DBG_STOP (NPHASE - 1)
#endif
    for (int ph = 0; ph <= DBG_STOP; ++ph) {
        if (!phase_nonempty(ph)) continue;
        p.ph_lo = ph; p.ph_hi = ph + 1;
#ifdef DBG_NANFILL
        if (ph == DBG_NANFILL) (void)hipMemsetAsync((char*)d_ws + OFF_FF, 0xFF, 64 * MiB, stream);
#endif
        void* args[] = {&p}; hipError_t e = hipLaunchCooperativeKernel((const void*)fwd_megakernel, dim3(grid), dim3(512), args, LDS_BYTES, stream);
        if (e != hipSuccess) { fprintf(stderr, "cooperative launch failed: %s (grid %d, phase %d)\n", hipGetErrorString(e), grid, ph); break; }
    }
#ifdef DBG_CHECK
    { unsigned char* ws = (unsigned char*)d_ws; bf16_t* wb = (bf16_t*)(ws + OFF_W);
      dbg_zero<<<1, 256, 0, stream>>>((float*)d_out); DBG_CHECK; dbg_reduce<<<1, 1, 0, stream>>>((float*)d_out); }
#endif
#endif
}
```

```cpp
#include <hip/hip_runtime.h>
#include <hip/hip_cooperative_groups.h>
#include <cstdio>
#include <cstdint>
namespace cg = cooperative_groups;

#ifndef ONE_LAUNCH
#define ONE_LAUNCH 1
#endif

#define LAS __attribute__((address_space(3)))
typedef unsigned short bf16_t;
typedef short bf16x8 __attribute__((ext_vector_type(8)));
typedef short s16x4 __attribute__((ext_vector_type(4)));
typedef float f32x4 __attribute__((ext_vector_type(4)));
typedef float f32x2 __attribute__((ext_vector_type(2)));
typedef float f32x16 __attribute__((ext_vector_type(16)));
typedef unsigned u32x4 __attribute__((ext_vector_type(4)));
typedef unsigned u32x2 __attribute__((ext_vector_type(2)));

constexpr int T = 32768, DM = 1024, SEQ = 2048, NB = 16, DFF = 4096, PLE = 256, DEPTH = 4;
constexpr int NH = 8, QLR = 384, KVLR = 256, ROPE = 64, LATP = 768;
constexpr int QP = 1536, KVP = 2048, ZP = 4096;
constexpr float EPS = 1e-6f;
constexpr float QSCALE = 0.07216878364870322f * 1.4426950408889634f;

constexpr size_t MiB = 1u << 20;
constexpr size_t OFF_SS = 0;
constexpr size_t OFF_W = 2621440;
constexpr size_t OFF_HB = 112 * MiB;
constexpr size_t OFF_FF = 176 * MiB;
constexpr size_t OFF_PB = 448 * MiB;
constexpr size_t WS_NEED = 512 * MiB;
constexpr size_t OFF_BAR = 2 * MiB;
#define XCD_BAR_WORDS 3456
constexpr size_t WE_DOWN = 0, WE_UQ = WE_DOWN + 2ull * LATP * DM, WE_UKV = WE_UQ + 2ull * QP * QLR, WE_MOUT = WE_UKV + 2ull * KVP * KVLR,
                 WE_GIN = WE_MOUT + 2ull * DM * DM, WE_GOUT = WE_GIN + 2ull * ZP * DM, WE_UP = WE_GOUT + 2ull * DM * 2048,
                 WE_DN = WE_UP + 4ull * DFF * DM, WE_GATE = WE_DN + 4ull * DM * DFF, WE_PROJ = WE_GATE + 4ull * DM * DM, WE_END = WE_PROJ + 4ull * DM * PLE;
static_assert(OFF_W + WE_END * 2 <= OFF_HB, "weights fit");
constexpr size_t FF_Q = 0, FF_KV = 96 * MiB, FF_LAT = 224 * MiB;

struct Params { const float* in[26]; float* out; unsigned char* ws; int ph_lo, ph_hi; };

typedef __bf16 bf16x2_t __attribute__((ext_vector_type(2)));
__device__ __forceinline__ unsigned cvt_pk_bf16(float lo, float hi) { const f32x2 v = {lo, hi}; return __builtin_bit_cast(unsigned, __builtin_convertvector(v, bf16x2_t)); }
__device__ __forceinline__ float bf2f(unsigned short b) { return __uint_as_float((unsigned)b << 16); }
__device__ __forceinline__ float bflo(unsigned u) { return __uint_as_float(u << 16); }
__device__ __forceinline__ float bfhi(unsigned u) { return __uint_as_float(u & 0xffff0000u); }
__device__ __forceinline__ float fast_rcp(float x) { return __builtin_amdgcn_rcpf(x); }
__device__ __forceinline__ float fast_exp2(float x) { return __builtin_amdgcn_exp2f(x); }
__device__ __forceinline__ float gelu_tanh(float x) { const float y = x + 0.044715f * x * x * x; return x * fast_rcp(1.0f + fast_exp2(-2.3022082f * y)); }
__device__ __forceinline__ float sigmoidf_(float x) { return fast_rcp(1.0f + fast_exp2(-1.4426950409f * x)); }

namespace pg8 {
constexpr int BM = 256, BK = 64, HALF = 128, HTB = HALF * BK * 2, STAGE_BYTES = 8 * HTB, NXCD = 8, WGM = 8;
__host__ __device__ __forceinline__ int lds_byte(int r, int c) { const int st = (r >> 4) * 2 + (c >> 5), rr = r & 15, cc = c & 31, ob = rr * 64 + cc * 2; return st * 1024 + (ob ^ (((ob >> 9) & 1) << 5)); }
__host__ __device__ __forceinline__ void stage_rc(int b, int& R, int& C) { const int st = b / 1024, sb = b % 1024, swz = sb ^ (((sb >> 9) & 1) << 5); R = (st >> 1) * 16 + swz / 64; C = (st & 1) * 32 + (swz % 64) / 2; }
__host__ __device__ __forceinline__ int perm32(int rho) { const int n = rho >> 4, i = rho & 15; return 8 * (i >> 2) + 4 * n + (i & 3); }
struct Unit { int pm, pn; };
struct RsCtx { const LAS float* tab; int pmA, pmB; };
struct Gemm { const bf16_t* A; const bf16_t* Bt; int M, N, K, lda; };
struct StaticOrder {
    int nM, nN, nwg, G, c;
    __device__ void init(int M, int N, int G_, int c_) { nM = M / BM; nN = N / BM; nwg = nM * nN; G = G_; c = c_; }
    __device__ bool next(int i, Unit& u) const {
        const long L = (long)i * G + c; if (L >= nwg) return false;
        int wgid = (int)L; { const int q = nwg / NXCD, r = nwg % NXCD, xcd = wgid % NXCD, off = wgid / NXCD; wgid = (xcd < r ? xcd * (q + 1) : r * (q + 1) + (xcd - r) * q) + off; }
        const int nig = WGM * nN, gid = wgid / nig, fm = gid * WGM, gsz = (nM - fm) < WGM ? (nM - fm) : WGM;
        u.pm = fm + ((wgid % nig) % gsz); u.pn = (wgid % nig) / gsz; return true;
    }
};

template <int ACT, int STATS> struct EpiStore {
    static constexpr bool PERM = true; static constexpr bool HAS_RS = true;
    bf16_t* O; int ldc; const float* ss; float inv_n;
    int sst, s0, s1; float* lst;
    __device__ __forceinline__ float row_scale(int row) const { const float* sp = ss + (size_t)row * sst; float t = 0.f; for (int i = s0; i < s1; ++i) t += sp[i]; return rsqrtf(t * inv_n + EPS); }
    __device__ __forceinline__ void operator()(const f32x4 (&acc)[2][2][4][2], const Unit& u, int wr, int wc, int fr, int fq, const RsCtx& rc) const {
        const int row0 = u.pm * BM + wr * 64 + fr, col0 = u.pn * BM + wc * 32 + 8 * fq;
        const int rslot = (u.pm == rc.pmA) ? 0 : ((u.pm == rc.pmB) ? 1 : -1);
#pragma unroll
        for (int ai = 0; ai < 2; ++ai)
#pragma unroll
            for (int m = 0; m < 4; ++m) {
                const int row = row0 + ai * HALF + m * 16;
                float rs = 1.0f;
                if (ss && rslot >= 0) rs = rc.tab[rslot * 256 + wr * 64 + fr + ai * HALF + m * 16];
                else if (ss) rs = row_scale(row);
#pragma unroll
                for (int bj = 0; bj < 2; ++bj) {
                    f32x4 v0 = acc[ai][bj][m][0] * rs, v1 = acc[ai][bj][m][1] * rs;
                    if (ACT == 1) {
#pragma unroll
                        for (int e = 0; e < 4; ++e) { const float a = fmaxf(v0[e], 0.f), b = fmaxf(v1[e], 0.f); v0[e] = a * a; v1[e] = b * b; }
                    }
                    if (ACT == 2) {
#pragma unroll
                        for (int e = 0; e < 4; ++e) { v0[e] = gelu_tanh(v0[e]); v1[e] = gelu_tanh(v1[e]); }
                    }
                    if (ACT == 3) {
#pragma unroll
                        for (int e = 0; e < 4; ++e) { v0[e] = sigmoidf_(v0[e]); v1[e] = sigmoidf_(v1[e]); }
                    }
                    u32x4 w; w.x = cvt_pk_bf16(v0[0], v0[1]); w.y = cvt_pk_bf16(v0[2], v0[3]); w.z = cvt_pk_bf16(v1[0], v1[1]); w.w = cvt_pk_bf16(v1[2], v1[3]);
                    *(u32x4*)(O + (size_t)row * ldc + col0 + bj * HALF) = w;
                    if (STATS == 1) {
                        float q = (v0[0] * v0[0] + v0[1] * v0[1]) + (v0[2] * v0[2] + v0[3] * v0[3]) + (v1[0] * v1[0] + v1[1] * v1[1]) + (v1[2] * v1[2] + v1[3] * v1[3]);
                        q += __shfl_xor(q, 16); q += __shfl_xor(q, 32);
                        if (fq == 0) lst[(size_t)row * 24 + u.pn * 8 + bj * 4 + wc] = q;
                    }
                }
                asm volatile("" ::: "memory");
            }
    }
};
template <int MODE> struct EpiRes {
    static constexpr bool PERM = true; static constexpr bool HAS_RS = false;
    static constexpr int MB = (MODE == 1) ? 2 : 4;
    const float* hin32; float* hout32; bf16_t* hb; float* ssn; const bf16_t* pp;
    __device__ __forceinline__ void operator()(const f32x4 (&acc)[2][2][4][2], const Unit& u, int wr, int wc, int fr, int fq, const RsCtx&) const {
        const int row0 = u.pm * BM + wr * 64 + fr, col0 = u.pn * BM + wc * 32 + 8 * fq;
#pragma unroll
        for (int ai = 0; ai < 2; ++ai)
#pragma unroll
            for (int mg = 0; mg < 4; mg += MB) {
                f32x4 hv[MB][2][2]; u32x4 pw[MB][2];
#pragma unroll
                for (int mm = 0; mm < MB; ++mm)
#pragma unroll
                    for (int bj = 0; bj < 2; ++bj) {
                        const size_t off = (size_t)(row0 + ai * HALF + (mg + mm) * 16) * DM + col0 + bj * HALF;
                        if (hin32) { hv[mm][bj][0] = *(const f32x4*)(hin32 + off); hv[mm][bj][1] = *(const f32x4*)(hin32 + off + 4); }
                        else { const u32x4 b = *(const u32x4*)(hb + off); hv[mm][bj][0] = (f32x4){bflo(b.x), bfhi(b.x), bflo(b.y), bfhi(b.y)}; hv[mm][bj][1] = (f32x4){bflo(b.z), bfhi(b.z), bflo(b.w), bfhi(b.w)}; }
                        if (MODE == 1) pw[mm][bj] = *(const u32x4*)(pp + off);
                    }
#pragma unroll
                for (int mm = 0; mm < MB; ++mm) {
                    const int m = mg + mm, row = row0 + ai * HALF + m * 16;
                    float q = 0.f;
#pragma unroll
                    for (int bj = 0; bj < 2; ++bj) {
                        const size_t off = (size_t)row * DM + col0 + bj * HALF;
                        f32x4 v0 = acc[ai][bj][m][0], v1 = acc[ai][bj][m][1];
                        if (MODE == 1) {
                            const u32x4 g = pw[mm][bj];
                            v0[0] *= bflo(g.x); v0[1] *= bfhi(g.x); v0[2] *= bflo(g.y); v0[3] *= bfhi(g.y);
                            v1[0] *= bflo(g.z); v1[1] *= bfhi(g.z); v1[2] *= bflo(g.w); v1[3] *= bfhi(g.w);
                        }
                        v0 += hv[mm][bj][0]; v1 += hv[mm][bj][1];
                        if (hout32) { *(f32x4*)(hout32 + off) = v0; *(f32x4*)(hout32 + off + 4) = v1; }
                        else { u32x4 w; w.x = cvt_pk_bf16(v0[0], v0[1]); w.y = cvt_pk_bf16(v0[2], v0[3]); w.z = cvt_pk_bf16(v1[0], v1[1]); w.w = cvt_pk_bf16(v1[2], v1[3]);
                               *(u32x4*)(hb + off) = w; }
                        q += (v0[0] * v0[0] + v0[1] * v0[1]) + (v0[2] * v0[2] + v0[3] * v0[3]) + (v1[0] * v1[0] + v1[1] * v1[1]) + (v1[2] * v1[2] + v1[3] * v1[3]);
                    }
                    if (ssn) { q += __shfl_xor(q, 16); q += __shfl_xor(q, 32); if (fq == 0) ssn[(size_t)row * 16 + u.pn * 4 + wc] = q; }
                }
                asm volatile("" ::: "memory");
            }
    }
};

#ifndef PG8_SP2
#define PG8_SP2 true
#endif
#ifndef PG8_ALIGN
#define PG8_ALIGN true
#endif
template <class Epi, bool ALIGN_EPI = PG8_ALIGN, bool SP2 = PG8_SP2>
__device__ __forceinline__ void gemm_phase(int tid, LAS unsigned char* lds, const Gemm g, const StaticOrder& S, const Epi& E) {
    const int wid = __builtin_amdgcn_readfirstlane(tid >> 6), lane = tid & 63, wr = wid >> 2, wc = wid & 3, fr = lane & 15, fq = lane >> 4;
    const int K = g.K, nt = K / BK, lda = g.lda;
    unsigned voffA[2], voffB[2];
#pragma unroll
    for (int i = 0; i < 2; ++i) { int R, C; stage_rc(tid * 16 + i * 8192, R, C); const int Rb = Epi::PERM ? ((R & ~31) + perm32(R & 31)) : R;
        voffA[i] = (unsigned)(R * lda + C) * 2u; voffB[i] = (unsigned)(Rb * K + C) * 2u; }
    const size_t kstep = (size_t)(BK * 2);
    const size_t hstepA = (size_t)HALF * lda * 2, hstepB = (size_t)HALF * K * 2;
    const size_t tstepA = 2 * hstepA, tstepB = 2 * hstepB;
    const unsigned ldsw = (unsigned)wid * 1024u;
    const int aoff = lds_byte(wr * 64 + fr, fq * 8), boff = lds_byte(wc * 32 + fr, fq * 8);
#define PG8_SA(b, h) (((b) * 2 + (h)) * HTB)
#define PG8_SB(b, h) ((4 + (b) * 2 + (h)) * HTB)
#define PG8_STAGE(bufoff, gbase, voff) do { _Pragma("unroll") for (int _i = 0; _i < 2; ++_i) \
        __builtin_amdgcn_global_load_lds((const unsigned*)((const char*)(gbase) + (voff)[_i]), (LAS unsigned*)(lds + (bufoff) + ldsw + _i * 8192), 16, 0, 0); } while (0)
#define PG8_LDA(dst, b, h) do { _Pragma("unroll") for (int m = 0; m < 4; ++m) _Pragma("unroll") for (int k = 0; k < 2; ++k) dst[m][k] = *(const LAS bf16x8*)(lds + PG8_SA(b, h) + aoff + m * 2048 + k * 1024); } while (0)
#define PG8_LDB(dst, b, h) do { _Pragma("unroll") for (int n = 0; n < 2; ++n) _Pragma("unroll") for (int k = 0; k < 2; ++k) dst[n][k] = *(const LAS bf16x8*)(lds + PG8_SB(b, h) + boff + n * 2048 + k * 1024); } while (0)
#define PG8_MMA(ai, bj, At, Bt) do { __builtin_amdgcn_s_setprio(1); _Pragma("unroll") for (int m = 0; m < 4; ++m) _Pragma("unroll") for (int n = 0; n < 2; ++n) _Pragma("unroll") for (int k = 0; k < 2; ++k) \
        acc[ai][bj][m][n] = __builtin_amdgcn_mfma_f32_16x16x32_bf16(Bt[n][k], At[m][k], acc[ai][bj][m][n], 0, 0, 0); __builtin_amdgcn_s_setprio(0); } while (0)
#define PG8_WAIT_V(n) asm volatile("s_waitcnt vmcnt(" #n ")" ::: "memory")
#define PG8_WAIT_L(n) asm volatile("s_waitcnt lgkmcnt(" #n ")" ::: "memory")
#define PG8_BAR __builtin_amdgcn_s_barrier()
#define PG8_SCHED __builtin_amdgcn_sched_barrier(0)
    Unit cur, nxt; int ui = 0;
    if (!S.next(0, cur)) return;
    RsCtx rc; rc.tab = (const LAS float*)(lds + STAGE_BYTES); rc.pmA = cur.pm; rc.pmB = cur.pm;
    if constexpr (Epi::HAS_RS) {
        if (E.ss) {
            Unit lu = cur; for (int i = 1; S.next(i, nxt); ++i) lu = nxt;
            rc.pmB = lu.pm;
            const int rowl = tid & 255, pmx = (tid >> 8) ? rc.pmB : rc.pmA;
            ((LAS float*)(lds + STAGE_BYTES))[tid] = E.row_scale(pmx * BM + rowl);
            __syncthreads();
        }
    }
    f32x4 acc[2][2][4][2];
#pragma unroll
    for (int a = 0; a < 2; ++a)
#pragma unroll
        for (int b = 0; b < 2; ++b)
#pragma unroll
            for (int m = 0; m < 4; ++m)
#pragma unroll
                for (int n = 0; n < 2; ++n) acc[a][b][m][n] = (f32x4){0.f, 0.f, 0.f, 0.f};
    bf16x8 At[4][2], B0[2][2], B1[2][2];
    const char* cA = (const char*)g.A + (size_t)cur.pm * tstepA; const char* cB = (const char*)g.Bt + (size_t)cur.pn * tstepB;
    if constexpr (SP2) {
    PG8_STAGE(PG8_SB(0, 0), cB, voffB); PG8_STAGE(PG8_SB(0, 1), cB + hstepB, voffB); PG8_STAGE(PG8_SA(0, 0), cA, voffA); PG8_STAGE(PG8_SA(0, 1), cA + hstepA, voffA);
    if (wr == 1) PG8_BAR;
    PG8_WAIT_V(2); PG8_BAR;
    PG8_STAGE(PG8_SB(1, 0), cB + kstep, voffB); PG8_STAGE(PG8_SA(1, 0), cA + kstep, voffA); PG8_STAGE(PG8_SB(1, 1), cB + hstepB + kstep, voffB);
    PG8_WAIT_V(6); PG8_BAR;
    } else {
    PG8_STAGE(PG8_SB(0, 0), cB, voffB); PG8_STAGE(PG8_SA(0, 0), cA, voffA); PG8_STAGE(PG8_SB(0, 1), cB + hstepB, voffB); PG8_STAGE(PG8_SA(0, 1), cA + hstepA, voffA);
    if (wr == 1) PG8_BAR;
    PG8_WAIT_V(4); PG8_BAR;
    PG8_STAGE(PG8_SB(1, 0), cB + kstep, voffB); PG8_STAGE(PG8_SA(1, 0), cA + kstep, voffA); PG8_STAGE(PG8_SB(1, 1), cB + hstepB + kstep, voffB);
    PG8_WAIT_V(6); PG8_BAR;
    }
    for (;;) {
        const bool has_next = S.next(ui + 1, nxt);
        const char* nA = has_next ? (const char*)g.A + (size_t)nxt.pm * tstepA : cA; const char* nB = has_next ? (const char*)g.Bt + (size_t)nxt.pn * tstepB : cB;
        for (int t = 0; t < nt; t += 2) {
            const bool last = (t == nt - 2);
            const char* a1 = cA + (size_t)(t + 1) * kstep;
            const char* a2 = last ? nA : cA + (size_t)(t + 2) * kstep; const char* b2 = last ? nB : cB + (size_t)(t + 2) * kstep;
            const char* a3 = a2 + kstep; const char* b3 = b2 + kstep;
            if constexpr (SP2) {
            PG8_LDB(B0, 0, 0); PG8_LDB(B1, 0, 1); PG8_SCHED; PG8_LDA(At, 0, 0); PG8_STAGE(PG8_SA(1, 1), a1 + hstepA, voffA);
            PG8_WAIT_V(8); PG8_WAIT_L(0); PG8_BAR; PG8_MMA(0, 0, At, B0); PG8_MMA(0, 1, At, B1); PG8_BAR; PG8_SCHED;
            PG8_LDA(At, 0, 1); PG8_STAGE(PG8_SB(0, 0), b2, voffB); PG8_STAGE(PG8_SB(0, 1), b2 + hstepB, voffB); PG8_STAGE(PG8_SA(0, 0), a2, voffA);
            PG8_WAIT_V(8); PG8_WAIT_L(0); PG8_BAR; PG8_MMA(1, 0, At, B0); PG8_MMA(1, 1, At, B1); PG8_BAR; PG8_SCHED;
            PG8_LDB(B0, 1, 0); PG8_LDB(B1, 1, 1); PG8_SCHED; PG8_LDA(At, 1, 0); PG8_STAGE(PG8_SA(0, 1), a2 + hstepA, voffA);
            PG8_WAIT_V(8); PG8_WAIT_L(0); PG8_BAR; PG8_MMA(0, 0, At, B0); PG8_MMA(0, 1, At, B1); PG8_BAR; PG8_SCHED;
            PG8_LDA(At, 1, 1); PG8_STAGE(PG8_SB(1, 0), b3, voffB); PG8_STAGE(PG8_SB(1, 1), b3 + hstepB, voffB); PG8_STAGE(PG8_SA(1, 0), a3, voffA);
            PG8_WAIT_V(8); PG8_WAIT_L(0); PG8_BAR; PG8_MMA(1, 0, At, B0); PG8_MMA(1, 1, At, B1); PG8_BAR; PG8_SCHED;
            } else {
            PG8_LDB(B0, 0, 0); PG8_SCHED; PG8_LDA(At, 0, 0); PG8_STAGE(PG8_SA(1, 1), a1 + hstepA, voffA);
            PG8_WAIT_L(8); PG8_BAR; PG8_WAIT_L(0); PG8_MMA(0, 0, At, B0); PG8_BAR; PG8_SCHED;
            PG8_LDB(B1, 0, 1); PG8_STAGE(PG8_SB(0, 0), b2, voffB);
            PG8_BAR; PG8_WAIT_L(0); PG8_MMA(0, 1, At, B1); PG8_BAR;
            PG8_LDA(At, 0, 1); PG8_STAGE(PG8_SA(0, 0), a2, voffA);
            PG8_BAR; PG8_WAIT_L(0); PG8_MMA(1, 0, At, B0); PG8_BAR; PG8_SCHED;
            PG8_STAGE(PG8_SB(0, 1), b2 + hstepB, voffB);
            PG8_WAIT_V(6); PG8_BAR; PG8_MMA(1, 1, At, B1); PG8_BAR;
            PG8_LDB(B0, 1, 0); PG8_SCHED; PG8_LDA(At, 1, 0); PG8_STAGE(PG8_SA(0, 1), a2 + hstepA, voffA);
            PG8_WAIT_L(8); PG8_BAR; PG8_WAIT_L(0); PG8_MMA(0, 0, At, B0); PG8_BAR; PG8_SCHED;
            PG8_LDB(B1, 1, 1); PG8_STAGE(PG8_SB(1, 0), b3, voffB);
            PG8_BAR; PG8_WAIT_L(0); PG8_MMA(0, 1, At, B1); PG8_BAR;
            PG8_LDA(At, 1, 1); PG8_STAGE(PG8_SA(1, 0), a3, voffA);
            PG8_BAR; PG8_WAIT_L(0); PG8_MMA(1, 0, At, B0); PG8_BAR; PG8_SCHED;
            PG8_STAGE(PG8_SB(1, 1), b3 + hstepB, voffB);
            PG8_WAIT_V(6); PG8_BAR; PG8_MMA(1, 1, At, B1); PG8_BAR;
            }
        }
        if constexpr (ALIGN_EPI) { if (wr == 0) PG8_BAR; }
        E(acc, cur, wr, wc, fr, fq, rc);
        if (!has_next) break;
#pragma unroll
        for (int a = 0; a < 2; ++a)
#pragma unroll
            for (int b = 0; b < 2; ++b)
#pragma unroll
                for (int m = 0; m < 4; ++m)
#pragma unroll
                    for (int n = 0; n < 2; ++n) acc[a][b][m][n] = (f32x4){0.f, 0.f, 0.f, 0.f};
        cur = nxt; cA = nA; cB = nB; ++ui;
        if constexpr (ALIGN_EPI) { if (wr == 1) PG8_BAR; }
    }
    PG8_WAIT_V(0);
    if constexpr (!ALIGN_EPI) { if (wr == 0) PG8_BAR; }
    PG8_BAR;
#undef PG8_SA
#undef PG8_SB
#undef PG8_STAGE
#undef PG8_LDA
#undef PG8_LDB
#undef PG8_MMA
#undef PG8_WAIT_V
#undef PG8_WAIT_L
#undef PG8_BAR
#undef PG8_SCHED
}
}

__constant__ double kInvFreq[32] = {
    1.0, 0.7498942093324559, 0.5623413251903491, 0.4216965034285822, 0.31622776601683794, 0.23713737056616552, 0.1778279410038923, 0.1333521432163324,
    0.1, 0.07498942093324558, 0.05623413251903491, 0.04216965034285822, 0.03162277660168379, 0.023713737056616554, 0.01778279410038923, 0.01333521432163324,
    0.01, 0.007498942093324558, 0.005623413251903491, 0.004216965034285823, 0.0031622776601683794, 0.0023713737056616554, 0.001778279410038923, 0.001333521432163324,
    0.001, 0.0007498942093324559, 0.0005623413251903491, 0.0004216965034285823, 0.00031622776601683794, 0.00023713737056616554, 0.0001778279410038923, 0.0001333521432163324};

__device__ __forceinline__ float wave_sum(float v) {
#pragma unroll
    for (int o = 1; o < 64; o <<= 1) v += __shfl_xor(v, o);
    return v;
}
__device__ __forceinline__ void unpack8(const u32x4 w, float (&f)[8]) { f[0] = bflo(w.x); f[1] = bfhi(w.x); f[2] = bflo(w.y); f[3] = bfhi(w.y); f[4] = bflo(w.z); f[5] = bfhi(w.z); f[6] = bflo(w.w); f[7] = bfhi(w.w); }
__device__ __forceinline__ u32x4 pack8(const float (&f)[8]) { u32x4 w; w.x = cvt_pk_bf16(f[0], f[1]); w.y = cvt_pk_bf16(f[2], f[3]); w.z = cvt_pk_bf16(f[4], f[5]); w.w = cvt_pk_bf16(f[6], f[7]); return w; }

struct WDesc { const float* W; const float* gamma; bf16_t* dst; int K, N, Npad, mode, items; };
__device__ __forceinline__ WDesc wdesc(const Params& P, int id) {
    WDesc d; bf16_t* wb = (bf16_t*)(P.ws + OFF_W); d.gamma = nullptr; d.mode = 0;
    if (id < 12) {
        const int j = id & 1, f = id >> 1;
        switch (f) {
            case 0: d.W = P.in[6] + (size_t)j * DM * 704; d.K = DM; d.N = 704; d.Npad = LATP; d.dst = wb + WE_DOWN + (size_t)j * LATP * DM; d.gamma = P.in[3] + (2 * j) * DM; break;
            case 1: d.W = P.in[9] + (size_t)j * QLR * QP; d.K = QLR; d.N = QP; d.Npad = QP; d.dst = wb + WE_UQ + (size_t)j * QP * QLR; d.gamma = P.in[7] + j * QLR; d.mode = 1; break;
            case 2: d.W = P.in[10] + (size_t)j * KVLR * KVP; d.K = KVLR; d.N = KVP; d.Npad = KVP; d.dst = wb + WE_UKV + (size_t)j * KVP * KVLR; d.gamma = P.in[8] + j * KVLR; break;
            case 3: d.W = P.in[15] + (size_t)j * DM * DM; d.K = DM; d.N = DM; d.Npad = DM; d.dst = wb + WE_MOUT + (size_t)j * DM * DM; break;
            case 4: d.W = P.in[16] + (size_t)j * DM * ZP; d.K = DM; d.N = ZP; d.Npad = ZP; d.dst = wb + WE_GIN + (size_t)j * ZP * DM; d.gamma = P.in[3] + (2 * j + 1) * DM; break;
            default: d.W = P.in[21] + (size_t)j * 2048 * DM; d.K = 2048; d.N = DM; d.Npad = DM; d.dst = wb + WE_GOUT + (size_t)j * DM * 2048; break;
        }
    } else {
        const int i = (id - 12) & 3, f = (id - 12) >> 2;
        switch (f) {
            case 0: d.W = P.in[22] + (size_t)i * DM * DFF; d.K = DM; d.N = DFF; d.Npad = DFF; d.dst = wb + WE_UP + (size_t)i * DFF * DM; d.gamma = P.in[4] + i * DM; break;
            case 1: d.W = P.in[23] + (size_t)i * DFF * DM; d.K = DFF; d.N = DM; d.Npad = DM; d.dst = wb + WE_DN + (size_t)i * DM * DFF; break;
            case 2: d.W = P.in[24] + (size_t)i * DM * DM; d.K = DM; d.N = DM; d.Npad = DM; d.dst = wb + WE_GATE + (size_t)i * DM * DM; d.gamma = P.in[5] + i * DM; break;
            default: d.W = P.in[25] + (size_t)i * PLE * DM; d.K = PLE; d.N = DM; d.Npad = DM; d.dst = wb + WE_PROJ + (size_t)i * DM * PLE; break;
        }
    }
    d.items = (d.K / 64) * (d.Npad / 64);
    return d;
}
__device__ __forceinline__ void conv_item(const WDesc& d, int item, float* scr, int lane) {
    const int nblk = d.Npad / 64, kb = item / nblk, nb = item % nblk, k0 = 64 * kb, n0 = 64 * nb;
    int sn0 = n0;
    if (d.mode == 1) { if (n0 < 1024) sn0 = (n0 >> 7) * 192 + (n0 & 127); else { const int r = n0 - 1024; sn0 = (r >> 6) * 192 + 128 + (r & 63); } }
    const bool valid = sn0 < d.N;
    const float* src = d.W + (size_t)k0 * d.N + sn0 + lane;
#pragma unroll
    for (int h = 0; h < 2; ++h) {
        float v[32];
#pragma unroll
        for (int i = 0; i < 32; ++i) v[i] = valid ? src[(size_t)(32 * h + i) * d.N] : 0.f;
#pragma unroll
        for (int i = 0; i < 32; ++i) scr[(32 * h + i) * 65 + lane] = v[i];
    }
    asm volatile("s_waitcnt lgkmcnt(0)" ::: "memory");
    const int c = lane & 7;
    f32x4 ga = {1.f, 1.f, 1.f, 1.f}, gb = {1.f, 1.f, 1.f, 1.f};
    if (d.gamma) { ga = *(const f32x4*)(d.gamma + k0 + 8 * c); gb = *(const f32x4*)(d.gamma + k0 + 8 * c + 4); }
#pragma unroll
    for (int j = 0; j < 8; ++j) { const int n = (lane >> 3) + 8 * j; const float* s = scr + (8 * c) * 65 + n;
        u32x4 o; o.x = cvt_pk_bf16(s[0 * 65] * ga[0], s[1 * 65] * ga[1]); o.y = cvt_pk_bf16(s[2 * 65] * ga[2], s[3 * 65] * ga[3]); o.z = cvt_pk_bf16(s[4 * 65] * gb[0], s[5 * 65] * gb[1]); o.w = cvt_pk_bf16(s[6 * 65] * gb[2], s[7 * 65] * gb[3]);
        *(u32x4*)(d.dst + (size_t)(n0 + n) * d.K + k0 + 8 * c) = o; }
    asm volatile("s_waitcnt lgkmcnt(0)" ::: "memory");
}
__device__ __forceinline__ void p0_prologue(int tid, const Params& P, unsigned char* lds) {
    const int lane = tid & 63, wave = __builtin_amdgcn_readfirstlane(tid >> 6);
    const int gw = blockIdx.x * 8 + wave, NGW = gridDim.x * 8;
    const size_t gt = (size_t)blockIdx.x * 512 + tid, NGT = (size_t)gridDim.x * 512;
    float* scr = (float*)(lds + wave * 16640);
    int total = 0;
    for (int id = 0; id < 28; ++id) total += wdesc(P, id).items;
    for (int it = gw; it < total; it += NGW) {
        int r = it, id = 0; WDesc d = wdesc(P, 0);
        while (r >= d.items) { r -= d.items; ++id; d = wdesc(P, id); }
        conv_item(d, r, scr, lane);
    }
    { unsigned* bw = (unsigned*)(P.ws + OFF_BAR); for (size_t i = gt; i < XCD_BAR_WORDS; i += NGT) bw[i] = 0u; }
    { const f32x4* src = (const f32x4*)P.in[1]; u32x4* dst = (u32x4*)(P.ws + OFF_PB); const size_t n8 = (size_t)DEPTH * T * PLE / 8;
      for (size_t i0 = gt; i0 < n8; i0 += 4 * NGT) {
          f32x4 a[4], b[4];
#pragma unroll
          for (int u = 0; u < 4; ++u) { const size_t i = i0 + u * NGT; if (i < n8) { a[u] = src[2 * i]; b[u] = src[2 * i + 1]; } }
#pragma unroll
          for (int u = 0; u < 4; ++u) { const size_t i = i0 + u * NGT; if (i < n8) { u32x4 w; w.x = cvt_pk_bf16(a[u][0], a[u][1]); w.y = cvt_pk_bf16(a[u][2], a[u][3]); w.z = cvt_pk_bf16(b[u][0], b[u][1]); w.w = cvt_pk_bf16(b[u][2], b[u][3]); dst[i] = w; } } } }
    { float* ssp = (float*)(P.ws + OFF_SS); bf16_t* hb = (bf16_t*)(P.ws + OFF_HB);
#pragma unroll 2
      for (int row = gw; row < T; row += NGW) {
          const f32x4* xr = (const f32x4*)(P.in[0] + (size_t)row * DM) + lane; float s = 0.f;
          unsigned long long* o8 = (unsigned long long*)(hb + (size_t)row * DM) + lane;
#pragma unroll
          for (int j = 0; j < 4; ++j) { const f32x4 v = xr[64 * j]; s += (v[0] * v[0] + v[1] * v[1]) + (v[2] * v[2] + v[3] * v[3]);
              o8[64 * j] = (unsigned long long)cvt_pk_bf16(v[0], v[1]) | ((unsigned long long)cvt_pk_bf16(v[2], v[3]) << 32); }
          s = wave_sum(s); if (lane < 16) ssp[(size_t)row * 16 + lane] = (lane == 0) ? s : 0.f; } }
}

__device__ __forceinline__ void r2_phase(int tid, const Params& P, int j) {
    const int lane = tid & 63, wave = __builtin_amdgcn_readfirstlane(tid >> 6);
    const int gw = blockIdx.x * 8 + wave, NGW = gridDim.x * 8;
    bf16_t* Q = (bf16_t*)(P.ws + OFF_FF + FF_Q); bf16_t* KV = (bf16_t*)(P.ws + OFF_FF + FF_KV); bf16_t* LAT = (bf16_t*)(P.ws + OFF_FF + FF_LAT);
    const float* gqn = P.in[11] + j * 128; const float* gqr = P.in[12] + j * 64; const float* gkn = P.in[13] + j * 128; const float* gkr = P.in[14] + j * 64;
    const int* pos = (const int*)P.in[2];
    float g_qn[2][8], g_kn[2][8], g_qr[8], g_kr[8];
#pragma unroll
    for (int i = 0; i < 2; ++i)
#pragma unroll
        for (int e = 0; e < 8; ++e) { const int d = (8 * lane + 512 * i + e) & 127; g_qn[i][e] = gqn[d] * QSCALE; g_kn[i][e] = gkn[d]; }
#pragma unroll
    for (int e = 0; e < 8; ++e) { const int r = 8 * (lane & 7) + e; g_qr[e] = gqr[r] * QSCALE; g_kr[e] = gkr[r]; }
    const double invf = kInvFreq[lane & 31];
#pragma unroll 2
    for (int row = gw; row < T; row += NGW) {
        const double ang = (double)pos[row] * invf; double rev = ang * 0.15915494309189535; rev -= floor(rev);
        const float cs = __builtin_amdgcn_cosf((float)rev), sn = __builtin_amdgcn_sinf((float)rev);
        float cj[8], sj[8];
#pragma unroll
        for (int e = 0; e < 8; ++e) { cj[e] = __shfl(cs, 8 * (lane & 3) + e); sj[e] = __shfl(sn, 8 * (lane & 3) + e); }
#pragma unroll
        for (int i = 0; i < 2; ++i) {
            const int idx = 8 * lane + 512 * i, head = idx >> 7, d = idx & 127;
            u32x4* qp = (u32x4*)(Q + (size_t)row * QP + idx); u32x4* kp = (u32x4*)(KV + (size_t)row * KVP + head * 256 + d);
            float a[8], b[8]; unpack8(*qp, a); unpack8(*kp, b);
            float sa = 0.f, sb = 0.f;
#pragma unroll
            for (int e = 0; e < 8; ++e) { sa += a[e] * a[e]; sb += b[e] * b[e]; }
#pragma unroll
            for (int o = 1; o < 16; o <<= 1) { sa += __shfl_xor(sa, o); sb += __shfl_xor(sb, o); }
            const float ra = rsqrtf(sa * (1.0f / 128) + EPS), rb = rsqrtf(sb * (1.0f / 128) + EPS);
#pragma unroll
            for (int e = 0; e < 8; ++e) { a[e] = a[e] * ra * g_qn[i][e]; b[e] = b[e] * rb * g_kn[i][e]; }
            *qp = pack8(a); *kp = pack8(b);
        }
        {
            u32x4* qp = (u32x4*)(Q + (size_t)row * QP + 1024 + 8 * lane); u32x4* kp = (u32x4*)(LAT + (size_t)row * LATP + 640 + 8 * (lane & 7));
            float a[8], b[8]; unpack8(*qp, a); unpack8(*kp, b);
            float sa = 0.f, sb = 0.f;
#pragma unroll
            for (int e = 0; e < 8; ++e) { sa += a[e] * a[e]; sb += b[e] * b[e]; }
#pragma unroll
            for (int o = 1; o < 8; o <<= 1) { sa += __shfl_xor(sa, o); sb += __shfl_xor(sb, o); }
            const float ra = rsqrtf(sa * (1.0f / 64) + EPS), rb = rsqrtf(sb * (1.0f / 64) + EPS);
            const bool hi = (lane & 4) != 0;
#pragma unroll
            for (int e = 0; e < 8; ++e) {
                const float ya = a[e] * ra * g_qr[e], yb = b[e] * rb * g_kr[e];
                const float pa = __shfl_xor(ya, 4), pb = __shfl_xor(yb, 4);
                a[e] = hi ? (ya * cj[e] + pa * sj[e]) : (ya * cj[e] - pa * sj[e]);
                b[e] = hi ? (yb * cj[e] + pb * sj[e]) : (yb * cj[e] - pb * sj[e]);
            }
            *qp = pack8(a); if (lane < 8) *kp = pack8(b);
        }
    }
}

constexpr int KROW = 400, VROW = 288, KTILE = 64 * KROW, VTILE = 64 * VROW;
__device__ __forceinline__ void attn_unit(int tid, unsigned char* lds, const bf16_t* Q, const bf16_t* KV, const bf16_t* KR, bf16_t* O, int b, int h, int qb) {
    const int lane = tid & 63, w = __builtin_amdgcn_readfirstlane(tid >> 6), r = lane & 15, g = lane >> 4;
    const int row0 = b * SEQ + qb * 256, qrow = row0 + 32 * w + r;
    bf16x8 qf[2][6];
#pragma unroll
    for (int rg = 0; rg < 2; ++rg) {
#pragma unroll
        for (int ks = 0; ks < 4; ++ks) qf[rg][ks] = *(const bf16x8*)(Q + (size_t)(qrow + 16 * rg) * QP + h * 128 + 32 * ks + 8 * g);
#pragma unroll
        for (int ks = 0; ks < 2; ++ks) qf[rg][4 + ks] = *(const bf16x8*)(Q + (size_t)(qrow + 16 * rg) * QP + 1024 + h * 64 + 32 * ks + 8 * g);
    }
    const int ntiles = 4 * qb + 4, last_tile = 4 * qb + (w >> 1);
    const int kn_row0 = tid >> 4, kn_ch = tid & 15;
    const int kr_row = tid >> 3, kr_ch = tid & 7;
    const bf16_t* gk = KV + (size_t)(b * SEQ) * KVP + h * 256;
    const bf16_t* gr = KR + (size_t)(b * SEQ) * LATP;
    u32x4 sk0, sk1, sr, sv0, sv1;
#define ATT_LOAD(t) do { const size_t kb = (size_t)(t) * 64; \
        sk0 = *(const u32x4*)(gk + (kb + kn_row0) * KVP + kn_ch * 8); sk1 = *(const u32x4*)(gk + (kb + kn_row0 + 32) * KVP + kn_ch * 8); \
        sv0 = *(const u32x4*)(gk + (kb + kn_row0) * KVP + 128 + kn_ch * 8); sv1 = *(const u32x4*)(gk + (kb + kn_row0 + 32) * KVP + 128 + kn_ch * 8); \
        sr = *(const u32x4*)(gr + (kb + kr_row) * LATP + kr_ch * 8); } while (0)
#define ATT_STORE(buf) do { unsigned char* kb_ = lds + (buf) * KTILE; unsigned char* vb_ = lds + 2 * KTILE + (buf) * VTILE; \
        *(u32x4*)(kb_ + kn_row0 * KROW + kn_ch * 16) = sk0; *(u32x4*)(kb_ + (kn_row0 + 32) * KROW + kn_ch * 16) = sk1; \
        *(u32x4*)(kb_ + kr_row * KROW + 256 + kr_ch * 16) = sr; \
        *(u32x4*)(vb_ + kn_row0 * VROW + kn_ch * 16) = sv0; *(u32x4*)(vb_ + (kn_row0 + 32) * VROW + kn_ch * 16) = sv1; } while (0)
    f32x4 o[2][8];
#pragma unroll
    for (int rg = 0; rg < 2; ++rg)
#pragma unroll
        for (int i = 0; i < 8; ++i) o[rg][i] = (f32x4){0.f, 0.f, 0.f, 0.f};
    float m[2] = {-1e30f, -1e30f}, l[2] = {0.f, 0.f};
    ATT_LOAD(0); ATT_STORE(0);
    __syncthreads();
    const int q4 = r >> 2, p4 = lane & 3;
    const int vtr_off = (4 * g + q4) * VROW + (4 * p4) * 2;
    const int qidx = qb * 256 + 32 * w + r;
    for (int t = 0; t < ntiles; ++t) {
        const bool more = (t + 1 < ntiles);
        if (more) ATT_LOAD(t + 1);
        if (t <= last_tile) {
            const unsigned char* Kb = lds + (t & 1) * KTILE; const unsigned char* Vb = lds + 2 * KTILE + (t & 1) * VTILE;
            f32x4 p[2][4];
#pragma unroll
            for (int kb = 0; kb < 4; ++kb) {
                p[0][kb] = (f32x4){0.f, 0.f, 0.f, 0.f}; p[1][kb] = (f32x4){0.f, 0.f, 0.f, 0.f};
#pragma unroll
                for (int ks = 0; ks < 6; ++ks) {
                    const bf16x8 a = *(const bf16x8*)(Kb + (16 * kb + r) * KROW + ks * 64 + g * 16);
                    p[0][kb] = __builtin_amdgcn_mfma_f32_16x16x32_bf16(a, qf[0][ks], p[0][kb], 0, 0, 0);
                    p[1][kb] = __builtin_amdgcn_mfma_f32_16x16x32_bf16(a, qf[1][ks], p[1][kb], 0, 0, 0);
                }
            }
            const bool diag = (t * 64 + 63 > qb * 256 + 32 * w);
            bf16x8 pb[2][2];
#pragma unroll
            for (int rg = 0; rg < 2; ++rg) {
                if (diag) {
#pragma unroll
                    for (int kb = 0; kb < 4; ++kb)
#pragma unroll
                        for (int i = 0; i < 4; ++i) { const int kk = t * 64 + 16 * kb + 4 * g + i; if (kk > qidx + 16 * rg) p[rg][kb][i] = -1e30f; }
                }
                float mx = fmaxf(fmaxf(p[rg][0][0], p[rg][0][1]), fmaxf(p[rg][0][2], p[rg][0][3]));
#pragma unroll
                for (int kb = 1; kb < 4; ++kb) mx = fmaxf(mx, fmaxf(fmaxf(p[rg][kb][0], p[rg][kb][1]), fmaxf(p[rg][kb][2], p[rg][kb][3])));
                mx = fmaxf(mx, __shfl_xor(mx, 16)); mx = fmaxf(mx, __shfl_xor(mx, 32));
                if (!__all(mx <= m[rg] + 8.0f)) {
                    const float mn = fmaxf(m[rg], mx), alpha = fast_exp2(m[rg] - mn); m[rg] = mn;
                    l[rg] *= alpha;
#pragma unroll
                    for (int i = 0; i < 8; ++i) o[rg][i] *= alpha;
                }
                const float mref = m[rg];
                float rsum = 0.f;
#pragma unroll
                for (int kb = 0; kb < 4; ++kb)
#pragma unroll
                    for (int i = 0; i < 4; ++i) { p[rg][kb][i] = fast_exp2(p[rg][kb][i] - mref); rsum += p[rg][kb][i]; }
                l[rg] += rsum;
#pragma unroll
                for (int kk = 0; kk < 2; ++kk) {
                    u32x4 pw; pw.x = cvt_pk_bf16(p[rg][2 * kk][0], p[rg][2 * kk][1]); pw.y = cvt_pk_bf16(p[rg][2 * kk][2], p[rg][2 * kk][3]);
                    pw.z = cvt_pk_bf16(p[rg][2 * kk + 1][0], p[rg][2 * kk + 1][1]); pw.w = cvt_pk_bf16(p[rg][2 * kk + 1][2], p[rg][2 * kk + 1][3]);
                    pb[rg][kk] = __builtin_bit_cast(bf16x8, pw);
                }
            }
#pragma unroll
            for (int db = 0; db < 8; ++db)
#pragma unroll
                for (int kk = 0; kk < 2; ++kk) {
                    const LAS unsigned char* vp = (const LAS unsigned char*)(Vb + vtr_off + (32 * kk) * VROW + db * 32);
                    const s16x4 lo = __builtin_bit_cast(s16x4, __builtin_amdgcn_ds_read_tr16_b64_v4i16((LAS s16x4*)vp));
                    const s16x4 hi = __builtin_bit_cast(s16x4, __builtin_amdgcn_ds_read_tr16_b64_v4i16((LAS s16x4*)(vp + 16 * VROW)));
                    const bf16x8 vf = __builtin_shufflevector(lo, hi, 0, 1, 2, 3, 4, 5, 6, 7);
                    o[0][db] = __builtin_amdgcn_mfma_f32_16x16x32_bf16(vf, pb[0][kk], o[0][db], 0, 0, 0);
                    o[1][db] = __builtin_amdgcn_mfma_f32_16x16x32_bf16(vf, pb[1][kk], o[1][db], 0, 0, 0);
                }
        }
        if (more) ATT_STORE((t + 1) & 1);
        __syncthreads();
    }
#pragma unroll
    for (int rg = 0; rg < 2; ++rg) {
        float ls = l[rg]; ls += __shfl_xor(ls, 16); ls += __shfl_xor(ls, 32);
        const float inv = fast_rcp(ls);
        bf16_t* orow = O + (size_t)(qrow + 16 * rg) * QP + h * 128 + 4 * g;
#pragma unroll
        for (int db = 0; db < 8; ++db) {
            u32x2 wv; wv.x = cvt_pk_bf16(o[rg][db][0] * inv, o[rg][db][1] * inv); wv.y = cvt_pk_bf16(o[rg][db][2] * inv, o[rg][db][3] * inv);
            *(u32x2*)(orow + 16 * db) = wv;
        }
    }
#undef ATT_LOAD
#undef ATT_STORE
}
__device__ __forceinline__ void attn_phase(int tid, const Params& P, unsigned char* lds) {
    bf16_t* Q = (bf16_t*)(P.ws + OFF_FF + FF_Q); const bf16_t* KV = (const bf16_t*)(P.ws + OFF_FF + FF_KV); const bf16_t* KR = (const bf16_t*)(P.ws + OFF_FF + FF_LAT) + 640;
    const int nwg8 = (gridDim.x % 8 == 0) ? gridDim.x / 8 : 0;
    for (int it = 0;; ++it) {
        int pr;
        if (nwg8) { const int idx = (int)(blockIdx.x >> 3) + it * nwg8; if (idx >= 64) break; pr = (int)(blockIdx.x & 7) * 64 + idx; }
        else { pr = blockIdx.x + it * gridDim.x; if (pr >= 512) break; }
        const int bh = pr >> 2, x = pr & 3, b = bh >> 3, h = bh & 7;
        attn_unit(tid, lds, Q, KV, KR, Q, b, h, 7 - x);
        attn_unit(tid, lds, Q, KV, KR, Q, b, h, x);
    }
}

constexpr int SROW = 576;
constexpr int SGU_STAT_OFF = 128 * SROW;
constexpr int SGU_W_OFF = SGU_STAT_OFF + 2048, SWROW = 272;
__device__ __forceinline__ void sgu_phase(int tid, const Params& P, unsigned char* lds, int j) {
    const int lane = tid & 63, w = __builtin_amdgcn_readfirstlane(tid >> 6), r = lane & 31, hh = lane >> 5;
    bf16_t* Z = (bf16_t*)(P.ws + OFF_FF);
    const float* lng = P.in[17] + j * 2048; const float* lnb = P.in[18] + j * 2048;
    const float* wsp = P.in[19] + (size_t)j * 8 * 128 * 128; const float* bsp = P.in[20] + j * 8 * 128;
    const int q4 = (lane & 15) >> 2, p4 = lane & 3, colblk = (lane >> 4) & 1;
    f32x2* stl = (f32x2*)(lds + SGU_STAT_OFF);
    for (int unit = blockIdx.x; unit < 256; unit += gridDim.x) {
        const int row0 = unit * 128;
        for (int rr0 = 0; rr0 < 16; rr0 += 4) {
            u32x4 raw[4][4];
#pragma unroll
            for (int a = 0; a < 4; ++a)
#pragma unroll
                for (int i = 0; i < 4; ++i) raw[a][i] = *(const u32x4*)(Z + (size_t)(row0 + 16 * w + rr0 + a) * ZP + 2048 + 8 * lane + 512 * i);
#pragma unroll
            for (int a = 0; a < 4; ++a) {
                float s1 = 0.f, s2 = 0.f;
#pragma unroll
                for (int i = 0; i < 4; ++i) { float v[8]; unpack8(raw[a][i], v);
#pragma unroll
                    for (int e = 0; e < 8; ++e) { s1 += v[e]; s2 += v[e] * v[e]; } }
                s1 = wave_sum(s1); s2 = wave_sum(s2);
                const float mu = s1 * (1.0f / 2048), var = s2 * (1.0f / 2048) - mu * mu;
                if (lane == 0) stl[16 * w + rr0 + a] = (f32x2){mu, rsqrtf(fmaxf(var, 0.f) + EPS)};
            }
        }
        __syncthreads();
        for (int g = 0; g < 8; ++g) {
#pragma unroll 2
            for (int i = 0; i < 8; ++i) {
                const int chunk = tid + 512 * i, row = chunk >> 5, ch = chunk & 31, col = g * 256 + ch * 8;
                float v[8]; unpack8(*(const u32x4*)(Z + (size_t)(row0 + row) * ZP + 2048 + col), v);
                const f32x2 st = stl[row]; const float mu = st.x, rstd = st.y;
                const f32x4 g0 = *(const f32x4*)(lng + col), g1 = *(const f32x4*)(lng + col + 4), b0 = *(const f32x4*)(lnb + col), b1 = *(const f32x4*)(lnb + col + 4);
#pragma unroll
                for (int e = 0; e < 4; ++e) { v[e] = (v[e] - mu) * rstd * g0[e] + b0[e]; v[4 + e] = (v[4 + e] - mu) * rstd * g1[e] + b1[e]; }
                *(u32x4*)(lds + row * SROW + ch * 16) = pack8(v);
            }
            {
                const float* wg = wsp + (size_t)g * 128 * 128;
                f32x4 w0[4], w1[4];
#pragma unroll
                for (int i = 0; i < 4; ++i) { const int c = tid + 512 * i, t = c >> 4, s0 = (c & 15) * 8; w0[i] = *(const f32x4*)(wg + t * 128 + s0); w1[i] = *(const f32x4*)(wg + t * 128 + s0 + 4); }
#pragma unroll
                for (int i = 0; i < 4; ++i) { const int c = tid + 512 * i, t = c >> 4, s0 = (c & 15) * 8;
                    float wv[8] = {w0[i][0], w0[i][1], w0[i][2], w0[i][3], w1[i][0], w1[i][1], w1[i][2], w1[i][3]};
#pragma unroll
                    for (int e = 0; e < 8; ++e) if (s0 + e > t) wv[e] = 0.f;
                    *(u32x4*)(lds + SGU_W_OFF + t * SWROW + s0 * 2) = pack8(wv); }
            }
            __syncthreads();
            bf16x8 af[8];
#pragma unroll
            for (int ks = 0; ks < 8; ++ks) {
                const LAS unsigned char* vp = (const LAS unsigned char*)(lds + (16 * ks + 8 * hh + q4) * SROW + (32 * w + 16 * colblk + 4 * p4) * 2);
                const s16x4 lo = __builtin_bit_cast(s16x4, __builtin_amdgcn_ds_read_tr16_b64_v4i16((LAS s16x4*)vp));
                const s16x4 hi = __builtin_bit_cast(s16x4, __builtin_amdgcn_ds_read_tr16_b64_v4i16((LAS s16x4*)(vp + 4 * SROW)));
                af[ks] = __builtin_shufflevector(lo, hi, 0, 1, 2, 3, 4, 5, 6, 7);
            }
#pragma unroll
            for (int tb = 0; tb < 4; ++tb) {
                f32x16 acc;
#pragma unroll
                for (int e = 0; e < 16; ++e) acc[e] = 0.f;
                const int t = 32 * tb + r;
#pragma unroll
                for (int ks = 0; ks < 8; ++ks) {
                    if (ks <= 2 * tb + 1) {
                        const bf16x8 bfr = *(const bf16x8*)(lds + SGU_W_OFF + t * SWROW + (16 * ks + 8 * hh) * 2);
                        acc = __builtin_amdgcn_mfma_f32_32x32x16_bf16(af[ks], bfr, acc, 0, 0, 0);
                    }
                }
                const float bias = bsp[g * 128 + t];
                bf16_t* up = Z + (size_t)(row0 + t) * ZP + g * 256 + 32 * w + 4 * hh;
#pragma unroll
                for (int i4 = 0; i4 < 4; ++i4) {
                    const u32x2 uu = *(const u32x2*)(up + 8 * i4);
                    u32x2 y; y.x = cvt_pk_bf16(bflo(uu.x) * (acc[4 * i4] + bias), bfhi(uu.x) * (acc[4 * i4 + 1] + bias));
                    y.y = cvt_pk_bf16(bflo(uu.y) * (acc[4 * i4 + 2] + bias), bfhi(uu.y) * (acc[4 * i4 + 3] + bias));
                    *(u32x2*)(up + 8 * i4) = y;
                }
            }
            __syncthreads();
        }
    }
}


#define XB_TMO      128
#define XB_XCNT(j)  (256  + 64 * (j))
#define XB_XSUB(j)  (1280 + 64 * (j))
#define XB_XGEN(j)  (2304 + 64 * (j))
#define XB_TOP      3328
#define XB_TOPGEN   3392
#define XB_SPIN_CAP (1u << 22)
__device__ __forceinline__ unsigned xb_ld(unsigned* p)              { return __hip_atomic_load(p, __ATOMIC_RELAXED, __HIP_MEMORY_SCOPE_AGENT); }
__device__ __forceinline__ unsigned xb_add(unsigned* p, unsigned v) { return __hip_atomic_fetch_add(p, v, __ATOMIC_RELAXED, __HIP_MEMORY_SCOPE_AGENT); }
__device__ __forceinline__ unsigned xb_xcc_id() { return (unsigned)__builtin_amdgcn_s_getreg((3 << 11) | 20) & 0xFu; }
#define XB_SPIN(cond, bar) do { unsigned _sp = 0; while (cond) { __builtin_amdgcn_s_sleep(1); \
    if ((++_sp & 255u) == 0u) { if (xb_ld(&(bar)[XB_TMO])) break; if (_sp > XB_SPIN_CAP) { atomicAdd(&(bar)[XB_TMO], 1u); break; } } } } while (0)
__device__ __forceinline__ void xcd_barrier_complete(unsigned* bar, unsigned x, unsigned& nloc, unsigned& nx) {
    const unsigned G = gridDim.x;
    unsigned sum, cnt, mine, sp = 0u;
    for (;;) {
        sum = 0u; cnt = 0u; mine = 0u;
#pragma unroll
        for (unsigned j = 0; j < 16; ++j) { const unsigned c = xb_ld(&bar[XB_XCNT(j)]); sum += c; cnt += (c > 0u) ? 1u : 0u; mine = (j == x) ? c : mine; }
        if (sum == G) break;
        __builtin_amdgcn_s_sleep(1);
        if ((++sp & 255u) == 0u) { if (xb_ld(&bar[XB_TMO])) break; if (sp > XB_SPIN_CAP) { atomicAdd(&bar[XB_TMO], 1u); break; } }
    }
    nloc = mine > 0u ? mine : 1u; nx = cnt > 0u ? cnt : 1u;
}
__device__ __forceinline__ void xcd_barrier(unsigned* bar, unsigned x, volatile LAS unsigned* st) {
    asm volatile("s_waitcnt vmcnt(0)" ::: "memory");
    __syncthreads();
    if (threadIdx.x == 0) {
        __builtin_amdgcn_s_waitcnt(0);
        unsigned nloc = st[0], nx = st[1];
        if (nloc == 0u) { xcd_barrier_complete(bar, x, nloc, nx); st[0] = nloc; st[1] = nx; }
        const unsigned old = xb_add(&bar[XB_XSUB(x)], 1u);
        const unsigned gen = old / nloc;
        if (old + 1u == (gen + 1u) * nloc) {
            __builtin_amdgcn_fence(__ATOMIC_RELEASE, "agent");
            asm volatile("s_waitcnt vmcnt(0)" ::: "memory");
            const unsigned og = xb_add(&bar[XB_TOP], 1u);
            const unsigned tg = og / nx;
            if (og + 1u == (tg + 1u) * nx) xb_add(&bar[XB_TOPGEN], 1u);
            else XB_SPIN(xb_ld(&bar[XB_TOPGEN]) == tg, bar);
            __builtin_amdgcn_fence(__ATOMIC_ACQUIRE, "agent");
            xb_add(&bar[XB_XGEN(x)], 1u);
            asm volatile("s_waitcnt vmcnt(0)" ::: "memory");
        } else {
            XB_SPIN(xb_ld(&bar[XB_XGEN(x)]) == gen, bar);
            __builtin_amdgcn_fence(__ATOMIC_ACQUIRE, "agent");
            asm volatile("s_waitcnt vmcnt(0)" ::: "memory");
        }
    }
    __syncthreads();
}

constexpr int NPHASE = 1 + 9 * DEPTH;
__device__ __forceinline__ int mktid(int wv0) { int t; asm volatile("v_mbcnt_lo_u32_b32 %0, -1, 0\n\tv_mbcnt_hi_u32_b32 %0, -1, %0" : "=v"(t)); return (t + wv0 * 64) & 511; }
__device__ __forceinline__ Params load_params() {
    Params P{};
#if defined(__HIP_DEVICE_COMPILE__)
    typedef const __attribute__((address_space(4))) unsigned long long* kp_t;
    kp_t kp = (kp_t)__builtin_amdgcn_kernarg_segment_ptr(); asm volatile("" : "+s"(kp));
#pragma unroll
    for (int i = 0; i < 26; ++i) P.in[i] = (const float*)kp[i];
    P.out = (float*)kp[26]; P.ws = (unsigned char*)kp[27];
#endif
    return P;
}
__host__ __device__ __forceinline__ bool phase_nonempty(int ph) {
    if (ph == 0) return true;
    const int layer = (ph - 1) / 9, slot = (ph - 1) % 9;
    if ((layer & 1) && (slot == 3 || slot == 4)) return false;
    return true;
}

__global__ void __launch_bounds__(512) fwd_megakernel(Params Parg) {
    extern __shared__ __attribute__((aligned(16))) unsigned char lds[];
    LAS unsigned char* ldsl = (LAS unsigned char*)lds;
    const int wv0 = __builtin_amdgcn_readfirstlane((int)threadIdx.x >> 6);
    volatile LAS unsigned* bst = (volatile LAS unsigned*)(ldsl + 133120);
    if (threadIdx.x == 0) { bst[0] = 0u; bst[1] = 0u; }
    __syncthreads();
    unsigned* const bar = (unsigned*)(Parg.ws + OFF_BAR);
    const unsigned xcc = xb_xcc_id();
    int nseam = 0;
    bool first = true;
    for (int ph = Parg.ph_lo; ph < Parg.ph_hi; ++ph) {
        if (!phase_nonempty(ph)) continue;
        if (!first) {
            if (nseam == 0) { cg::this_grid().sync(); if (threadIdx.x == 0) (void)xb_add(&bar[XB_XCNT(xcc)], 1u); }
            else xcd_barrier(bar, xcc, bst);
            ++nseam;
        }
        first = false;
        const Params P = load_params();
        unsigned char* ws = P.ws;
        bf16_t* wb = (bf16_t*)(ws + OFF_W);
        bf16_t* hb = (bf16_t*)(ws + OFF_HB);
        float* SS = (float*)(ws + OFF_SS);
        const int G = gridDim.x, c = blockIdx.x;
        if (ph == 0) { p0_prologue(mktid(wv0), P, lds); continue; }
        const int layer = (ph - 1) / 9, slot = (ph - 1) % 9, j = layer >> 1;
        const bool mla = (layer & 1) == 0;
        float* ss_mix = SS; float* ss_ffn = SS; float* ss_ple = SS;
        float* ss_next = (layer + 1 < DEPTH) ? SS : nullptr;
        const float* hin = (layer == 0) ? P.in[0] : nullptr;
        pg8::StaticOrder S;
        if (slot == 0) {
            if (mla) {
                pg8::Gemm g{hb, wb + WE_DOWN + (size_t)j * LATP * DM, T, LATP, DM, DM}; S.init(T, LATP, G, c);
                pg8::EpiStore<0, 1> E{(bf16_t*)(ws + OFF_FF + FF_LAT), LATP, ss_mix, 1.0f / DM, 16, 0, 16, P.out};
                pg8::gemm_phase(mktid(wv0), ldsl, g, S, E);
            } else {
                pg8::Gemm g{hb, wb + WE_GIN + (size_t)j * ZP * DM, T, ZP, DM, DM}; S.init(T, ZP, G, c);
                pg8::EpiStore<2, 0> E{(bf16_t*)(ws + OFF_FF), ZP, ss_mix, 1.0f / DM, 16, 0, 16, nullptr};
                pg8::gemm_phase(mktid(wv0), ldsl, g, S, E);
            }
        } else if (slot == 1) {
            if (mla) {
                { pg8::Gemm g{(const bf16_t*)(ws + OFF_FF + FF_LAT), wb + WE_UQ + (size_t)j * QP * QLR, T, QP, QLR, LATP}; S.init(T, QP, G, c);
                  pg8::EpiStore<0, 0> E{(bf16_t*)(ws + OFF_FF + FF_Q), QP, P.out, 1.0f / QLR, 24, 0, 12, nullptr};
                  pg8::gemm_phase(mktid(wv0), ldsl, g, S, E); }
                { pg8::Gemm g{(const bf16_t*)(ws + OFF_FF + FF_LAT) + QLR, wb + WE_UKV + (size_t)j * KVP * KVLR, T, KVP, KVLR, LATP}; S.init(T, KVP, G, c);
                  pg8::EpiStore<0, 0> E{(bf16_t*)(ws + OFF_FF + FF_KV), KVP, P.out, 1.0f / KVLR, 24, 12, 20, nullptr};
                  pg8::gemm_phase(mktid(wv0), ldsl, g, S, E); }
            } else {
                sgu_phase(mktid(wv0), P, lds, j);
            }
        } else if (slot == 2) {
            if (mla) {
                r2_phase(mktid(wv0), P, j);
            } else {
                pg8::Gemm g{(const bf16_t*)(ws + OFF_FF), wb + WE_GOUT + (size_t)j * DM * 2048, T, DM, 2048, ZP}; S.init(T, DM, G, c);
                pg8::EpiRes<0> E{hin, nullptr, hb, ss_ffn, nullptr};
                pg8::gemm_phase(mktid(wv0), ldsl, g, S, E);
            }
        } else if (slot == 3) {
            attn_phase(mktid(wv0), P, lds);
        } else if (slot == 4) {
            pg8::Gemm g{(const bf16_t*)(ws + OFF_FF + FF_Q), wb + WE_MOUT + (size_t)j * DM * DM, T, DM, DM, QP}; S.init(T, DM, G, c);
            pg8::EpiRes<0> E{hin, nullptr, hb, ss_ffn, nullptr};
            pg8::gemm_phase(mktid(wv0), ldsl, g, S, E);
        } else if (slot == 5) {
            pg8::Gemm g{hb, wb + WE_UP + (size_t)layer * DFF * DM, T, DFF, DM, DM}; S.init(T, DFF, G, c);
            pg8::EpiStore<1, 0> E{(bf16_t*)(ws + OFF_FF), DFF, ss_ffn, 1.0f / DM, 16, 0, 16, nullptr};
            pg8::gemm_phase(mktid(wv0), ldsl, g, S, E);
        } else if (slot == 6) {
            pg8::Gemm g{(const bf16_t*)(ws + OFF_FF), wb + WE_DN + (size_t)layer * DM * DFF, T, DM, DFF, DFF}; S.init(T, DM, G, c);
            pg8::EpiRes<0> E{nullptr, nullptr, hb, ss_ple, nullptr};
            pg8::gemm_phase(mktid(wv0), ldsl, g, S, E);
        } else if (slot == 7) {
            pg8::Gemm g{hb, wb + WE_GATE + (size_t)layer * DM * DM, T, DM, DM, DM}; S.init(T, DM, G, c);
            pg8::EpiStore<3, 0> E{(bf16_t*)(ws + OFF_FF), DM, ss_ple, 1.0f / DM, 16, 0, 16, nullptr};
            pg8::gemm_phase(mktid(wv0), ldsl, g, S, E);
        } else {
            pg8::Gemm g{(const bf16_t*)(ws + OFF_PB) + (size_t)layer * T * PLE, wb + WE_PROJ + (size_t)layer * DM * PLE, T, DM, PLE, PLE}; S.init(T, DM, G, c);
            pg8::EpiRes<1> E{nullptr, (layer == DEPTH - 1) ? P.out : nullptr, hb, ss_next, (const bf16_t*)(ws + OFF_FF)};
            pg8::gemm_phase(mktid(wv0), ldsl, g, S, E);
        }
    }
    asm volatile("s_waitcnt vmcnt(0)" ::: "memory");
    __builtin_amdgcn_fence(__ATOMIC_RELEASE, "agent");
    asm volatile("s_waitcnt vmcnt(0)" ::: "memory");
}


constexpr int LDS_BYTES = 131072 + 2048 + 256;
extern "C" void kernel_launch(void* const* d_in, const int* in_sizes, int n_in, void* d_out, int out_size, void* d_ws, size_t ws_size, hipStream_t stream) {
    static int grid = 0;
    if (grid == 0) {
        if (n_in != 26 || out_size != T * DM || ws_size < WS_NEED) { fprintf(stderr, "kernel_launch: unexpected problem (n_in %d out %d ws %zu)\n", n_in, out_size, ws_size); grid = -1; return; }
        int dev = 0, cus = 0, per_cu = 0;
        hipGetDevice(&dev); hipDeviceGetAttribute(&cus, hipDeviceAttributeMultiprocessorCount, dev);
        hipFuncSetAttribute((const void*)fwd_megakernel, hipFuncAttributeMaxDynamicSharedMemorySize, LDS_BYTES);
        hipOccupancyMaxActiveBlocksPerMultiprocessor(&per_cu, (const void*)fwd_megakernel, 512, LDS_BYTES);
        if (per_cu < 1) { fprintf(stderr, "kernel_launch: occupancy query says %d blocks/CU\n", per_cu); per_cu = 1; }
        (void)hipGetLastError();
        grid = cus;
    }
    if (grid < 0) return;
    Params p{};
    for (int i = 0; i < 26; ++i) p.in[i] = (const float*)d_in[i];
    p.out = (float*)d_out; p.ws = (unsigned char*)d_ws;
#if ONE_LAUNCH
    p.ph_lo = 0; p.ph_hi = NPHASE;
    { void* args[] = {&p}; hipError_t e = hipLaunchCooperativeKernel((const void*)fwd_megakernel, dim3(grid), dim3(512), args, LDS_BYTES, stream);
      if (e != hipSuccess) fprintf(stderr, "cooperative launch failed: %s (grid %d)\n", hipGetErrorString(e), grid); }
#else
    for (int ph = 0; ph < NPHASE; ++ph) {
        if (!phase_nonempty(ph)) continue;
        p.ph_lo = ph; p.ph_hi = ph + 1;
        void* args[] = {&p}; hipError_t e = hipLaunchCooperativeKernel((const void*)fwd_megakernel, dim3(grid), dim3(512), args, LDS_BYTES, stream);
        if (e != hipSuccess) { fprintf(stderr, "cooperative launch failed: %s (grid %d, phase %d)\n", hipGetErrorString(e), grid, ph); break; }
    }
#endif
}
```

```cpp
#include <hip/hip_runtime.h>
#include <hip/hip_cooperative_groups.h>
#include <cstdio>
#include <cstdint>
namespace cg = cooperative_groups;

#ifndef ONE_LAUNCH
#define ONE_LAUNCH 1
#endif

#define LAS __attribute__((address_space(3)))
typedef unsigned short bf16_t;
typedef short bf16x8 __attribute__((ext_vector_type(8)));
typedef short s16x4 __attribute__((ext_vector_type(4)));
typedef float f32x4 __attribute__((ext_vector_type(4)));
typedef float f32x2 __attribute__((ext_vector_type(2)));
typedef float f32x16 __attribute__((ext_vector_type(16)));
typedef unsigned u32x4 __attribute__((ext_vector_type(4)));
typedef unsigned u32x2 __attribute__((ext_vector_type(2)));

constexpr int T = 32768, DM = 1024, SEQ = 2048, NB = 16, DFF = 4096, PLE = 256, DEPTH = 4;
constexpr int NH = 8, QLR = 384, KVLR = 256, ROPE = 64, LATP = 768;
constexpr int QP = 1536, KVP = 2048, ZP = 4096;
constexpr float EPS = 1e-6f;
constexpr float QSCALE = 0.07216878364870322f * 1.4426950408889634f;

constexpr size_t MiB = 1u << 20;
constexpr size_t OFF_SS = 0;
constexpr size_t OFF_W = 2621440;
constexpr size_t OFF_HB = 112 * MiB;
constexpr size_t OFF_FF = 176 * MiB;
constexpr size_t OFF_PB = 448 * MiB;
constexpr size_t WS_NEED = 512 * MiB;
constexpr size_t OFF_BAR = 2 * MiB;
#define XCD_BAR_WORDS 3456
constexpr size_t OFF_PCNT = OFF_BAR + 16384;
constexpr int CTL_ZERO_WORDS = 4096 + DEPTH * 128 * 16;
constexpr size_t WE_DOWN = 0, WE_UQ = WE_DOWN + 2ull * LATP * DM, WE_UKV = WE_UQ + 2ull * QP * QLR, WE_MOUT = WE_UKV + 2ull * KVP * KVLR,
                 WE_GIN = WE_MOUT + 2ull * DM * DM, WE_GOUT = WE_GIN + 2ull * ZP * DM, WE_UP = WE_GOUT + 2ull * DM * 2048,
                 WE_DN = WE_UP + 4ull * DFF * DM, WE_GATE = WE_DN + 4ull * DM * DFF, WE_PROJ = WE_GATE + 4ull * DM * DM, WE_END = WE_PROJ + 4ull * DM * PLE;
static_assert(OFF_W + WE_END * 2 <= OFF_HB, "weights fit");
constexpr size_t FF_Q = 0, FF_KV = 96 * MiB, FF_LAT = 224 * MiB;

struct Params { const float* in[26]; float* out; unsigned char* ws; int ph_lo, ph_hi; };

typedef __bf16 bf16x2_t __attribute__((ext_vector_type(2)));
__device__ __forceinline__ unsigned cvt_pk_bf16(float lo, float hi) { const f32x2 v = {lo, hi}; return __builtin_bit_cast(unsigned, __builtin_convertvector(v, bf16x2_t)); }
__device__ __forceinline__ float bf2f(unsigned short b) { return __uint_as_float((unsigned)b << 16); }
__device__ __forceinline__ float bflo(unsigned u) { return __uint_as_float(u << 16); }
__device__ __forceinline__ float bfhi(unsigned u) { return __uint_as_float(u & 0xffff0000u); }
__device__ __forceinline__ float fast_rcp(float x) { return __builtin_amdgcn_rcpf(x); }
__device__ __forceinline__ float fast_exp2(float x) { return __builtin_amdgcn_exp2f(x); }
__device__ __forceinline__ float gelu_tanh(float x) { const float y = x + 0.044715f * x * x * x; return x * fast_rcp(1.0f + fast_exp2(-2.3022082f * y)); }
__device__ __forceinline__ float sigmoidf_(float x) { return fast_rcp(1.0f + fast_exp2(-1.4426950409f * x)); }

namespace pg8 {
constexpr int BM = 256, BK = 64, HALF = 128, HTB = HALF * BK * 2, STAGE_BYTES = 8 * HTB, NXCD = 8, WGM = 8;
__host__ __device__ __forceinline__ int lds_byte(int r, int c) { const int st = (r >> 4) * 2 + (c >> 5), rr = r & 15, cc = c & 31, ob = rr * 64 + cc * 2; return st * 1024 + (ob ^ (((ob >> 9) & 1) << 5)); }
__host__ __device__ __forceinline__ void stage_rc(int b, int& R, int& C) { const int st = b / 1024, sb = b % 1024, swz = sb ^ (((sb >> 9) & 1) << 5); R = (st >> 1) * 16 + swz / 64; C = (st & 1) * 32 + (swz % 64) / 2; }
__host__ __device__ __forceinline__ int perm32(int rho) { const int n = rho >> 4, i = rho & 15; return 8 * (i >> 2) + 4 * n + (i & 3); }
struct Unit { int pm, pn; };
struct RsCtx { const LAS float* tab; int pmA, pmB; };
struct Gemm { const bf16_t* A; const bf16_t* Bt; int M, N, K, lda; unsigned* sig; unsigned* wt; };
struct StaticOrder {
    int nM, nN, nwg, G, c;
    __device__ void init(int M, int N, int G_, int c_) { nM = M / BM; nN = N / BM; nwg = nM * nN; G = G_; c = c_; }
    __device__ bool next(int i, Unit& u) const {
        const long L = (long)i * G + c; if (L >= nwg) return false;
        int wgid = (int)L; { const int q = nwg / NXCD, r = nwg % NXCD, xcd = wgid % NXCD, off = wgid / NXCD; wgid = (xcd < r ? xcd * (q + 1) : r * (q + 1) + (xcd - r) * q) + off; }
        const int nig = WGM * nN, gid = wgid / nig, fm = gid * WGM, gsz = (nM - fm) < WGM ? (nM - fm) : WGM;
        u.pm = fm + ((wgid % nig) % gsz); u.pn = (wgid % nig) / gsz; return true;
    }
};

template <int ACT, int STATS> struct EpiStore {
    static constexpr bool PERM = true; static constexpr bool HAS_RS = true;
    bf16_t* O; int ldc; const float* ss; float inv_n;
    int sst, s0, s1; float* lst;
    __device__ __forceinline__ float row_scale(int row) const { const float* sp = ss + (size_t)row * sst; float t = 0.f; for (int i = s0; i < s1; ++i) t += sp[i]; return rsqrtf(t * inv_n + EPS); }
    __device__ __forceinline__ void operator()(const f32x4 (&acc)[2][2][4][2], const Unit& u, int wr, int wc, int fr, int fq, const RsCtx& rc) const {
        const int row0 = u.pm * BM + wr * 64 + fr, col0 = u.pn * BM + wc * 32 + 8 * fq;
        const int rslot = (u.pm == rc.pmA) ? 0 : ((u.pm == rc.pmB) ? 1 : -1);
#pragma unroll
        for (int ai = 0; ai < 2; ++ai)
#pragma unroll
            for (int m = 0; m < 4; ++m) {
                const int row = row0 + ai * HALF + m * 16;
                float rs = 1.0f;
                if (ss && rslot >= 0) rs = rc.tab[rslot * 256 + wr * 64 + fr + ai * HALF + m * 16];
                else if (ss) rs = row_scale(row);
#pragma unroll
                for (int bj = 0; bj < 2; ++bj) {
                    f32x4 v0 = acc[ai][bj][m][0] * rs, v1 = acc[ai][bj][m][1] * rs;
                    if (ACT == 1) {
#pragma unroll
                        for (int e = 0; e < 4; ++e) { const float a = fmaxf(v0[e], 0.f), b = fmaxf(v1[e], 0.f); v0[e] = a * a; v1[e] = b * b; }
                    }
                    if (ACT == 2) {
#pragma unroll
                        for (int e = 0; e < 4; ++e) { v0[e] = gelu_tanh(v0[e]); v1[e] = gelu_tanh(v1[e]); }
                    }
                    if (ACT == 3) {
#pragma unroll
                        for (int e = 0; e < 4; ++e) { v0[e] = sigmoidf_(v0[e]); v1[e] = sigmoidf_(v1[e]); }
                    }
                    u32x4 w; w.x = cvt_pk_bf16(v0[0], v0[1]); w.y = cvt_pk_bf16(v0[2], v0[3]); w.z = cvt_pk_bf16(v1[0], v1[1]); w.w = cvt_pk_bf16(v1[2], v1[3]);
                    *(u32x4*)(O + (size_t)row * ldc + col0 + bj * HALF) = w;
                    if (STATS == 1) {
                        float q = (v0[0] * v0[0] + v0[1] * v0[1]) + (v0[2] * v0[2] + v0[3] * v0[3]) + (v1[0] * v1[0] + v1[1] * v1[1]) + (v1[2] * v1[2] + v1[3] * v1[3]);
                        q += __shfl_xor(q, 16); q += __shfl_xor(q, 32);
                        if (fq == 0) lst[(size_t)row * 24 + u.pn * 8 + bj * 4 + wc] = q;
                    }
                }
                asm volatile("" ::: "memory");
            }
    }
};
template <int MODE> struct EpiRes {
    static constexpr bool PERM = true; static constexpr bool HAS_RS = false;
    static constexpr int MB = (MODE == 1) ? 2 : 4;
    const float* hin32; float* hout32; bf16_t* hb; float* ssn; const bf16_t* pp;
    __device__ __forceinline__ void operator()(const f32x4 (&acc)[2][2][4][2], const Unit& u, int wr, int wc, int fr, int fq, const RsCtx&) const {
        const int row0 = u.pm * BM + wr * 64 + fr, col0 = u.pn * BM + wc * 32 + 8 * fq;
#pragma unroll
        for (int ai = 0; ai < 2; ++ai)
#pragma unroll
            for (int mg = 0; mg < 4; mg += MB) {
                f32x4 hv[MB][2][2]; u32x4 pw[MB][2];
#pragma unroll
                for (int mm = 0; mm < MB; ++mm)
#pragma unroll
                    for (int bj = 0; bj < 2; ++bj) {
                        const size_t off = (size_t)(row0 + ai * HALF + (mg + mm) * 16) * DM + col0 + bj * HALF;
                        if (hin32) { hv[mm][bj][0] = *(const f32x4*)(hin32 + off); hv[mm][bj][1] = *(const f32x4*)(hin32 + off + 4); }
                        else { const u32x4 b = *(const u32x4*)(hb + off); hv[mm][bj][0] = (f32x4){bflo(b.x), bfhi(b.x), bflo(b.y), bfhi(b.y)}; hv[mm][bj][1] = (f32x4){bflo(b.z), bfhi(b.z), bflo(b.w), bfhi(b.w)}; }
                        if (MODE == 1) pw[mm][bj] = *(const u32x4*)(pp + off);
                    }
#pragma unroll
                for (int mm = 0; mm < MB; ++mm) {
                    const int m = mg + mm, row = row0 + ai * HALF + m * 16;
                    float q = 0.f;
#pragma unroll
                    for (int bj = 0; bj < 2; ++bj) {
                        const size_t off = (size_t)row * DM + col0 + bj * HALF;
                        f32x4 v0 = acc[ai][bj][m][0], v1 = acc[ai][bj][m][1];
                        if (MODE == 1) {
                            const u32x4 g = pw[mm][bj];
                            v0[0] *= bflo(g.x); v0[1] *= bfhi(g.x); v0[2] *= bflo(g.y); v0[3] *= bfhi(g.y);
                            v1[0] *= bflo(g.z); v1[1] *= bfhi(g.z); v1[2] *= bflo(g.w); v1[3] *= bfhi(g.w);
                        }
                        v0 += hv[mm][bj][0]; v1 += hv[mm][bj][1];
                        if (hout32) { *(f32x4*)(hout32 + off) = v0; *(f32x4*)(hout32 + off + 4) = v1; }
                        else { u32x4 w; w.x = cvt_pk_bf16(v0[0], v0[1]); w.y = cvt_pk_bf16(v0[2], v0[3]); w.z = cvt_pk_bf16(v1[0], v1[1]); w.w = cvt_pk_bf16(v1[2], v1[3]);
                               *(u32x4*)(hb + off) = w; }
                        q += (v0[0] * v0[0] + v0[1] * v0[1]) + (v0[2] * v0[2] + v0[3] * v0[3]) + (v1[0] * v1[0] + v1[1] * v1[1]) + (v1[2] * v1[2] + v1[3] * v1[3]);
                    }
                    if (ssn) { q += __shfl_xor(q, 16); q += __shfl_xor(q, 32); if (fq == 0) ssn[(size_t)row * 16 + u.pn * 4 + wc] = q; }
                }
                asm volatile("" ::: "memory");
            }
    }
};

#ifndef PG8_SP2
#define PG8_SP2 true
#endif
#ifndef PG8_ALIGN
#define PG8_ALIGN true
#endif
template <class Epi, bool ALIGN_EPI = PG8_ALIGN, bool SP2 = PG8_SP2>
__device__ __forceinline__ void gemm_phase(int tid, LAS unsigned char* lds, const Gemm g, const StaticOrder& S, const Epi& E) {
    const int wid = __builtin_amdgcn_readfirstlane(tid >> 6), lane = tid & 63, wr = wid >> 2, wc = wid & 3, fr = lane & 15, fq = lane >> 4;
    const int K = g.K, nt = K / BK, lda = g.lda;
    unsigned voffA[2], voffB[2];
#pragma unroll
    for (int i = 0; i < 2; ++i) { int R, C; stage_rc(tid * 16 + i * 8192, R, C); const int Rb = Epi::PERM ? ((R & ~31) + perm32(R & 31)) : R;
        voffA[i] = (unsigned)(R * lda + C) * 2u; voffB[i] = (unsigned)(Rb * K + C) * 2u; }
    const size_t kstep = (size_t)(BK * 2);
    const size_t hstepA = (size_t)HALF * lda * 2, hstepB = (size_t)HALF * K * 2;
    const size_t tstepA = 2 * hstepA, tstepB = 2 * hstepB;
    const unsigned ldsw = (unsigned)wid * 1024u;
    const int aoff = lds_byte(wr * 64 + fr, fq * 8), boff = lds_byte(wc * 32 + fr, fq * 8);
#define PG8_SA(b, h) (((b) * 2 + (h)) * HTB)
#define PG8_SB(b, h) ((4 + (b) * 2 + (h)) * HTB)
#define PG8_STAGE(bufoff, gbase, voff) do { _Pragma("unroll") for (int _i = 0; _i < 2; ++_i) \
        __builtin_amdgcn_global_load_lds((const unsigned*)((const char*)(gbase) + (voff)[_i]), (LAS unsigned*)(lds + (bufoff) + ldsw + _i * 8192), 16, 0, 0); } while (0)
#define PG8_LDA(dst, b, h) do { _Pragma("unroll") for (int m = 0; m < 4; ++m) _Pragma("unroll") for (int k = 0; k < 2; ++k) dst[m][k] = *(const LAS bf16x8*)(lds + PG8_SA(b, h) + aoff + m * 2048 + k * 1024); } while (0)
#define PG8_LDB(dst, b, h) do { _Pragma("unroll") for (int n = 0; n < 2; ++n) _Pragma("unroll") for (int k = 0; k < 2; ++k) dst[n][k] = *(const LAS bf16x8*)(lds + PG8_SB(b, h) + boff + n * 2048 + k * 1024); } while (0)
#define PG8_MMA(ai, bj, At, Bt) do { __builtin_amdgcn_s_setprio(1); _Pragma("unroll") for (int m = 0; m < 4; ++m) _Pragma("unroll") for (int n = 0; n < 2; ++n) _Pragma("unroll") for (int k = 0; k < 2; ++k) \
        acc[ai][bj][m][n] = __builtin_amdgcn_mfma_f32_16x16x32_bf16(Bt[n][k], At[m][k], acc[ai][bj][m][n], 0, 0, 0); __builtin_amdgcn_s_setprio(0); } while (0)
#define PG8_WAIT_V(n) asm volatile("s_waitcnt vmcnt(" #n ")" ::: "memory")
#define PG8_WAIT_L(n) asm volatile("s_waitcnt lgkmcnt(" #n ")" ::: "memory")
#define PG8_BAR __builtin_amdgcn_s_barrier()
#define PG8_SCHED __builtin_amdgcn_sched_barrier(0)
    Unit cur, nxt; int ui = 0;
    if (!S.next(0, cur)) return;
    RsCtx rc; rc.tab = (const LAS float*)(lds + STAGE_BYTES); rc.pmA = cur.pm; rc.pmB = cur.pm;
    if constexpr (Epi::HAS_RS) {
        if (E.ss) {
            Unit lu = cur; for (int i = 1; S.next(i, nxt); ++i) lu = nxt;
            rc.pmB = lu.pm;
            const int rowl = tid & 255, pmx = (tid >> 8) ? rc.pmB : rc.pmA;
            ((LAS float*)(lds + STAGE_BYTES))[tid] = E.row_scale(pmx * BM + rowl);
            __syncthreads();
        }
    }
    f32x4 acc[2][2][4][2];
#pragma unroll
    for (int a = 0; a < 2; ++a)
#pragma unroll
        for (int b = 0; b < 2; ++b)
#pragma unroll
            for (int m = 0; m < 4; ++m)
#pragma unroll
                for (int n = 0; n < 2; ++n) acc[a][b][m][n] = (f32x4){0.f, 0.f, 0.f, 0.f};
    bf16x8 At[4][2], B0[2][2], B1[2][2];
    const char* cA = (const char*)g.A + (size_t)cur.pm * tstepA; const char* cB = (const char*)g.Bt + (size_t)cur.pn * tstepB;
    if constexpr (SP2) {
    PG8_STAGE(PG8_SB(0, 0), cB, voffB); PG8_STAGE(PG8_SB(0, 1), cB + hstepB, voffB); PG8_STAGE(PG8_SA(0, 0), cA, voffA); PG8_STAGE(PG8_SA(0, 1), cA + hstepA, voffA);
    if (wr == 1) PG8_BAR;
    PG8_WAIT_V(2); PG8_BAR;
    PG8_STAGE(PG8_SB(1, 0), cB + kstep, voffB); PG8_STAGE(PG8_SA(1, 0), cA + kstep, voffA); PG8_STAGE(PG8_SB(1, 1), cB + hstepB + kstep, voffB);
    PG8_WAIT_V(6); PG8_BAR;
    } else {
    PG8_STAGE(PG8_SB(0, 0), cB, voffB); PG8_STAGE(PG8_SA(0, 0), cA, voffA); PG8_STAGE(PG8_SB(0, 1), cB + hstepB, voffB); PG8_STAGE(PG8_SA(0, 1), cA + hstepA, voffA);
    if (wr == 1) PG8_BAR;
    PG8_WAIT_V(4); PG8_BAR;
    PG8_STAGE(PG8_SB(1, 0), cB + kstep, voffB); PG8_STAGE(PG8_SA(1, 0), cA + kstep, voffA); PG8_STAGE(PG8_SB(1, 1), cB + hstepB + kstep, voffB);
    PG8_WAIT_V(6); PG8_BAR;
    }
    for (;;) {
        const bool has_next = S.next(ui + 1, nxt);
        const char* nA = has_next ? (const char*)g.A + (size_t)nxt.pm * tstepA : cA; const char* nB = has_next ? (const char*)g.Bt + (size_t)nxt.pn * tstepB : cB;
        for (int t = 0; t < nt; t += 2) {
            const bool last = (t == nt - 2);
            const char* a1 = cA + (size_t)(t + 1) * kstep;
            const char* a2 = last ? nA : cA + (size_t)(t + 2) * kstep; const char* b2 = last ? nB : cB + (size_t)(t + 2) * kstep;
            const char* a3 = a2 + kstep; const char* b3 = b2 + kstep;
            if constexpr (SP2) {
            PG8_LDB(B0, 0, 0); PG8_LDB(B1, 0, 1); PG8_SCHED; PG8_LDA(At, 0, 0); PG8_STAGE(PG8_SA(1, 1), a1 + hstepA, voffA);
            PG8_WAIT_V(8); PG8_WAIT_L(0); PG8_BAR; PG8_MMA(0, 0, At, B0); PG8_MMA(0, 1, At, B1); PG8_BAR; PG8_SCHED;
            PG8_LDA(At, 0, 1); PG8_STAGE(PG8_SB(0, 0), b2, voffB); PG8_STAGE(PG8_SB(0, 1), b2 + hstepB, voffB); PG8_STAGE(PG8_SA(0, 0), a2, voffA);
            PG8_WAIT_V(8); PG8_WAIT_L(0); PG8_BAR; PG8_MMA(1, 0, At, B0); PG8_MMA(1, 1, At, B1); PG8_BAR; PG8_SCHED;
            PG8_LDB(B0, 1, 0); PG8_LDB(B1, 1, 1); PG8_SCHED; PG8_LDA(At, 1, 0); PG8_STAGE(PG8_SA(0, 1), a2 + hstepA, voffA);
            PG8_WAIT_V(8); PG8_WAIT_L(0); PG8_BAR; PG8_MMA(0, 0, At, B0); PG8_MMA(0, 1, At, B1); PG8_BAR; PG8_SCHED;
            PG8_LDA(At, 1, 1); PG8_STAGE(PG8_SB(1, 0), b3, voffB); PG8_STAGE(PG8_SB(1, 1), b3 + hstepB, voffB); PG8_STAGE(PG8_SA(1, 0), a3, voffA);
            PG8_WAIT_V(8); PG8_WAIT_L(0); PG8_BAR; PG8_MMA(1, 0, At, B0); PG8_MMA(1, 1, At, B1); PG8_BAR; PG8_SCHED;
            } else {
            PG8_LDB(B0, 0, 0); PG8_SCHED; PG8_LDA(At, 0, 0); PG8_STAGE(PG8_SA(1, 1), a1 + hstepA, voffA);
            PG8_WAIT_L(8); PG8_BAR; PG8_WAIT_L(0); PG8_MMA(0, 0, At, B0); PG8_BAR; PG8_SCHED;
            PG8_LDB(B1, 0, 1); PG8_STAGE(PG8_SB(0, 0), b2, voffB);
            PG8_BAR; PG8_WAIT_L(0); PG8_MMA(0, 1, At, B1); PG8_BAR;
            PG8_LDA(At, 0, 1); PG8_STAGE(PG8_SA(0, 0), a2, voffA);
            PG8_BAR; PG8_WAIT_L(0); PG8_MMA(1, 0, At, B0); PG8_BAR; PG8_SCHED;
            PG8_STAGE(PG8_SB(0, 1), b2 + hstepB, voffB);
            PG8_WAIT_V(6); PG8_BAR; PG8_MMA(1, 1, At, B1); PG8_BAR;
            PG8_LDB(B0, 1, 0); PG8_SCHED; PG8_LDA(At, 1, 0); PG8_STAGE(PG8_SA(0, 1), a2 + hstepA, voffA);
            PG8_WAIT_L(8); PG8_BAR; PG8_WAIT_L(0); PG8_MMA(0, 0, At, B0); PG8_BAR; PG8_SCHED;
            PG8_LDB(B1, 1, 1); PG8_STAGE(PG8_SB(1, 0), b3, voffB);
            PG8_BAR; PG8_WAIT_L(0); PG8_MMA(0, 1, At, B1); PG8_BAR;
            PG8_LDA(At, 1, 1); PG8_STAGE(PG8_SA(1, 0), a3, voffA);
            PG8_BAR; PG8_WAIT_L(0); PG8_MMA(1, 0, At, B0); PG8_BAR; PG8_SCHED;
            PG8_STAGE(PG8_SB(1, 1), b3 + hstepB, voffB);
            PG8_WAIT_V(6); PG8_BAR; PG8_MMA(1, 1, At, B1); PG8_BAR;
            }
        }
        if constexpr (ALIGN_EPI) { if (wr == 0) PG8_BAR; }
        if (g.wt) {
            if (tid == 0) { unsigned* cw = g.wt + cur.pm * 16; const unsigned want = (unsigned)(g.N / BM); unsigned sp = 0u;
                while (__hip_atomic_load(cw, __ATOMIC_RELAXED, __HIP_MEMORY_SCOPE_AGENT) < want) { __builtin_amdgcn_s_sleep(1); if (++sp > (1u << 22)) break; } }
            PG8_BAR;
        }
        E(acc, cur, wr, wc, fr, fq, rc);
        if (g.sig) { if (tid == 0) (void)__hip_atomic_fetch_add(g.sig + cur.pm * 16, 1u, __ATOMIC_RELAXED, __HIP_MEMORY_SCOPE_AGENT); }
        if (!has_next) break;
#pragma unroll
        for (int a = 0; a < 2; ++a)
#pragma unroll
            for (int b = 0; b < 2; ++b)
#pragma unroll
                for (int m = 0; m < 4; ++m)
#pragma unroll
                    for (int n = 0; n < 2; ++n) acc[a][b][m][n] = (f32x4){0.f, 0.f, 0.f, 0.f};
        cur = nxt; cA = nA; cB = nB; ++ui;
        if constexpr (ALIGN_EPI) { if (wr == 1) PG8_BAR; }
    }
    PG8_WAIT_V(0);
    if constexpr (!ALIGN_EPI) { if (wr == 0) PG8_BAR; }
    PG8_BAR;
#undef PG8_SA
#undef PG8_SB
#undef PG8_STAGE
#undef PG8_LDA
#undef PG8_LDB
#undef PG8_MMA
#undef PG8_WAIT_V
#undef PG8_WAIT_L
#undef PG8_BAR
#undef PG8_SCHED
}
}

__constant__ double kInvFreq[32] = {
    1.0, 0.7498942093324559, 0.5623413251903491, 0.4216965034285822, 0.31622776601683794, 0.23713737056616552, 0.1778279410038923, 0.1333521432163324,
    0.1, 0.07498942093324558, 0.05623413251903491, 0.04216965034285822, 0.03162277660168379, 0.023713737056616554, 0.01778279410038923, 0.01333521432163324,
    0.01, 0.007498942093324558, 0.005623413251903491, 0.004216965034285823, 0.0031622776601683794, 0.0023713737056616554, 0.001778279410038923, 0.001333521432163324,
    0.001, 0.0007498942093324559, 0.0005623413251903491, 0.0004216965034285823, 0.00031622776601683794, 0.00023713737056616554, 0.0001778279410038923, 0.0001333521432163324};

__device__ __forceinline__ float wave_sum(float v) {
#pragma unroll
    for (int o = 1; o < 64; o <<= 1) v += __shfl_xor(v, o);
    return v;
}
__device__ __forceinline__ void unpack8(const u32x4 w, float (&f)[8]) { f[0] = bflo(w.x); f[1] = bfhi(w.x); f[2] = bflo(w.y); f[3] = bfhi(w.y); f[4] = bflo(w.z); f[5] = bfhi(w.z); f[6] = bflo(w.w); f[7] = bfhi(w.w); }
__device__ __forceinline__ u32x4 pack8(const float (&f)[8]) { u32x4 w; w.x = cvt_pk_bf16(f[0], f[1]); w.y = cvt_pk_bf16(f[2], f[3]); w.z = cvt_pk_bf16(f[4], f[5]); w.w = cvt_pk_bf16(f[6], f[7]); return w; }

struct WDesc { const float* W; const float* gamma; bf16_t* dst; int K, N, Npad, mode, items; };
__device__ __forceinline__ WDesc wdesc(const Params& P, int id) {
    WDesc d; bf16_t* wb = (bf16_t*)(P.ws + OFF_W); d.gamma = nullptr; d.mode = 0;
    if (id < 12) {
        const int j = id & 1, f = id >> 1;
        switch (f) {
            case 0: d.W = P.in[6] + (size_t)j * DM * 704; d.K = DM; d.N = 704; d.Npad = LATP; d.dst = wb + WE_DOWN + (size_t)j * LATP * DM; d.gamma = P.in[3] + (2 * j) * DM; break;
            case 1: d.W = P.in[9] + (size_t)j * QLR * QP; d.K = QLR; d.N = QP; d.Npad = QP; d.dst = wb + WE_UQ + (size_t)j * QP * QLR; d.gamma = P.in[7] + j * QLR; d.mode = 1; break;
            case 2: d.W = P.in[10] + (size_t)j * KVLR * KVP; d.K = KVLR; d.N = KVP; d.Npad = KVP; d.dst = wb + WE_UKV + (size_t)j * KVP * KVLR; d.gamma = P.in[8] + j * KVLR; break;
            case 3: d.W = P.in[15] + (size_t)j * DM * DM; d.K = DM; d.N = DM; d.Npad = DM; d.dst = wb + WE_MOUT + (size_t)j * DM * DM; break;
            case 4: d.W = P.in[16] + (size_t)j * DM * ZP; d.K = DM; d.N = ZP; d.Npad = ZP; d.dst = wb + WE_GIN + (size_t)j * ZP * DM; d.gamma = P.in[3] + (2 * j + 1) * DM; break;
            default: d.W = P.in[21] + (size_t)j * 2048 * DM; d.K = 2048; d.N = DM; d.Npad = DM; d.dst = wb + WE_GOUT + (size_t)j * DM * 2048; break;
        }
    } else {
        const int i = (id - 12) & 3, f = (id - 12) >> 2;
        switch (f) {
            case 0: d.W = P.in[22] + (size_t)i * DM * DFF; d.K = DM; d.N = DFF; d.Npad = DFF; d.dst = wb + WE_UP + (size_t)i * DFF * DM; d.gamma = P.in[4] + i * DM; break;
            case 1: d.W = P.in[23] + (size_t)i * DFF * DM; d.K = DFF; d.N = DM; d.Npad = DM; d.dst = wb + WE_DN + (size_t)i * DM * DFF; break;
            case 2: d.W = P.in[24] + (size_t)i * DM * DM; d.K = DM; d.N = DM; d.Npad = DM; d.dst = wb + WE_GATE + (size_t)i * DM * DM; d.gamma = P.in[5] + i * DM; break;
            default: d.W = P.in[25] + (size_t)i * PLE * DM; d.K = PLE; d.N = DM; d.Npad = DM; d.dst = wb + WE_PROJ + (size_t)i * DM * PLE; break;
        }
    }
    d.items = (d.K / 64) * (d.Npad / 64);
    return d;
}
__device__ __forceinline__ void conv_item(const WDesc& d, int item, float* scr, int lane) {
    const int nblk = d.Npad / 64, kb = item / nblk, nb = item % nblk, k0 = 64 * kb, n0 = 64 * nb;
    int sn0 = n0;
    if (d.mode == 1) { if (n0 < 1024) sn0 = (n0 >> 7) * 192 + (n0 & 127); else { const int r = n0 - 1024; sn0 = (r >> 6) * 192 + 128 + (r & 63); } }
    const bool valid = sn0 < d.N;
    const float* src = d.W + (size_t)k0 * d.N + sn0 + lane;
#pragma unroll
    for (int h = 0; h < 2; ++h) {
        float v[32];
#pragma unroll
        for (int i = 0; i < 32; ++i) v[i] = valid ? src[(size_t)(32 * h + i) * d.N] : 0.f;
#pragma unroll
        for (int i = 0; i < 32; ++i) scr[(32 * h + i) * 65 + lane] = v[i];
    }
    asm volatile("s_waitcnt lgkmcnt(0)" ::: "memory");
    const int c = lane & 7;
    f32x4 ga = {1.f, 1.f, 1.f, 1.f}, gb = {1.f, 1.f, 1.f, 1.f};
    if (d.gamma) { ga = *(const f32x4*)(d.gamma + k0 + 8 * c); gb = *(const f32x4*)(d.gamma + k0 + 8 * c + 4); }
#pragma unroll
    for (int j = 0; j < 8; ++j) { const int n = (lane >> 3) + 8 * j; const float* s = scr + (8 * c) * 65 + n;
        u32x4 o; o.x = cvt_pk_bf16(s[0 * 65] * ga[0], s[1 * 65] * ga[1]); o.y = cvt_pk_bf16(s[2 * 65] * ga[2], s[3 * 65] * ga[3]); o.z = cvt_pk_bf16(s[4 * 65] * gb[0], s[5 * 65] * gb[1]); o.w = cvt_pk_bf16(s[6 * 65] * gb[2], s[7 * 65] * gb[3]);
        *(u32x4*)(d.dst + (size_t)(n0 + n) * d.K + k0 + 8 * c) = o; }
    asm volatile("s_waitcnt lgkmcnt(0)" ::: "memory");
}
__device__ __forceinline__ void p0_prologue(int tid, const Params& P, unsigned char* lds) {
    const int lane = tid & 63, wave = __builtin_amdgcn_readfirstlane(tid >> 6);
    const int gw = blockIdx.x * 8 + wave, NGW = gridDim.x * 8;
    const size_t gt = (size_t)blockIdx.x * 512 + tid, NGT = (size_t)gridDim.x * 512;
    float* scr = (float*)(lds + wave * 16640);
    int total = 0;
    for (int id = 0; id < 28; ++id) total += wdesc(P, id).items;
    for (int it = gw; it < total; it += NGW) {
        int r = it, id = 0; WDesc d = wdesc(P, 0);
        while (r >= d.items) { r -= d.items; ++id; d = wdesc(P, id); }
        conv_item(d, r, scr, lane);
    }
    { unsigned* bw = (unsigned*)(P.ws + OFF_BAR); for (size_t i = gt; i < CTL_ZERO_WORDS; i += NGT) bw[i] = 0u; }
    { const f32x4* src = (const f32x4*)P.in[1]; u32x4* dst = (u32x4*)(P.ws + OFF_PB); const size_t n8 = (size_t)DEPTH * T * PLE / 8;
      for (size_t i0 = gt; i0 < n8; i0 += 4 * NGT) {
          f32x4 a[4], b[4];
#pragma unroll
          for (int u = 0; u < 4; ++u) { const size_t i = i0 + u * NGT; if (i < n8) { a[u] = src[2 * i]; b[u] = src[2 * i + 1]; } }
#pragma unroll
          for (int u = 0; u < 4; ++u) { const size_t i = i0 + u * NGT; if (i < n8) { u32x4 w; w.x = cvt_pk_bf16(a[u][0], a[u][1]); w.y = cvt_pk_bf16(a[u][2], a[u][3]); w.z = cvt_pk_bf16(b[u][0], b[u][1]); w.w = cvt_pk_bf16(b[u][2], b[u][3]); dst[i] = w; } } } }
    { float* ssp = (float*)(P.ws + OFF_SS); bf16_t* hb = (bf16_t*)(P.ws + OFF_HB);
#pragma unroll 2
      for (int row = gw; row < T; row += NGW) {
          const f32x4* xr = (const f32x4*)(P.in[0] + (size_t)row * DM) + lane; float s = 0.f;
          unsigned long long* o8 = (unsigned long long*)(hb + (size_t)row * DM) + lane;
#pragma unroll
          for (int j = 0; j < 4; ++j) { const f32x4 v = xr[64 * j]; s += (v[0] * v[0] + v[1] * v[1]) + (v[2] * v[2] + v[3] * v[3]);
              o8[64 * j] = (unsigned long long)cvt_pk_bf16(v[0], v[1]) | ((unsigned long long)cvt_pk_bf16(v[2], v[3]) << 32); }
          s = wave_sum(s); if (lane < 16) ssp[(size_t)row * 16 + lane] = (lane == 0) ? s : 0.f; } }
}

__device__ __forceinline__ void r2_phase(int tid, const Params& P, int j) {
    const int lane = tid & 63, wave = __builtin_amdgcn_readfirstlane(tid >> 6);
    const int gw = blockIdx.x * 8 + wave, NGW = gridDim.x * 8;
    bf16_t* Q = (bf16_t*)(P.ws + OFF_FF + FF_Q); bf16_t* KV = (bf16_t*)(P.ws + OFF_FF + FF_KV); bf16_t* LAT = (bf16_t*)(P.ws + OFF_FF + FF_LAT);
    const float* gqn = P.in[11] + j * 128; const float* gqr = P.in[12] + j * 64; const float* gkn = P.in[13] + j * 128; const float* gkr = P.in[14] + j * 64;
    const int* pos = (const int*)P.in[2];
    float g_qn[2][8], g_kn[2][8], g_qr[8], g_kr[8];
#pragma unroll
    for (int i = 0; i < 2; ++i)
#pragma unroll
        for (int e = 0; e < 8; ++e) { const int d = (8 * lane + 512 * i + e) & 127; g_qn[i][e] = gqn[d] * QSCALE; g_kn[i][e] = gkn[d]; }
#pragma unroll
    for (int e = 0; e < 8; ++e) { const int r = 8 * (lane & 7) + e; g_qr[e] = gqr[r] * QSCALE; g_kr[e] = gkr[r]; }
    const double invf = kInvFreq[lane & 31];
#pragma unroll 2
    for (int row = gw; row < T; row += NGW) {
        const double ang = (double)pos[row] * invf; double rev = ang * 0.15915494309189535; rev -= floor(rev);
        const float cs = __builtin_amdgcn_cosf((float)rev), sn = __builtin_amdgcn_sinf((float)rev);
        float cj[8], sj[8];
#pragma unroll
        for (int e = 0; e < 8; ++e) { cj[e] = __shfl(cs, 8 * (lane & 3) + e); sj[e] = __shfl(sn, 8 * (lane & 3) + e); }
#pragma unroll
        for (int i = 0; i < 2; ++i) {
            const int idx = 8 * lane + 512 * i, head = idx >> 7, d = idx & 127;
            u32x4* qp = (u32x4*)(Q + (size_t)row * QP + idx); u32x4* kp = (u32x4*)(KV + (size_t)row * KVP + head * 256 + d);
            float a[8], b[8]; unpack8(*qp, a); unpack8(*kp, b);
            float sa = 0.f, sb = 0.f;
#pragma unroll
            for (int e = 0; e < 8; ++e) { sa += a[e] * a[e]; sb += b[e] * b[e]; }
#pragma unroll
            for (int o = 1; o < 16; o <<= 1) { sa += __shfl_xor(sa, o); sb += __shfl_xor(sb, o); }
            const float ra = rsqrtf(sa * (1.0f / 128) + EPS), rb = rsqrtf(sb * (1.0f / 128) + EPS);
#pragma unroll
            for (int e = 0; e < 8; ++e) { a[e] = a[e] * ra * g_qn[i][e]; b[e] = b[e] * rb * g_kn[i][e]; }
            *qp = pack8(a); *kp = pack8(b);
        }
        {
            u32x4* qp = (u32x4*)(Q + (size_t)row * QP + 1024 + 8 * lane); u32x4* kp = (u32x4*)(LAT + (size_t)row * LATP + 640 + 8 * (lane & 7));
            float a[8], b[8]; unpack8(*qp, a); unpack8(*kp, b);
            float sa = 0.f, sb = 0.f;
#pragma unroll
            for (int e = 0; e < 8; ++e) { sa += a[e] * a[e]; sb += b[e] * b[e]; }
#pragma unroll
            for (int o = 1; o < 8; o <<= 1) { sa += __shfl_xor(sa, o); sb += __shfl_xor(sb, o); }
            const float ra = rsqrtf(sa * (1.0f / 64) + EPS), rb = rsqrtf(sb * (1.0f / 64) + EPS);
            const bool hi = (lane & 4) != 0;
#pragma unroll
            for (int e = 0; e < 8; ++e) {
                const float ya = a[e] * ra * g_qr[e], yb = b[e] * rb * g_kr[e];
                const float pa = __shfl_xor(ya, 4), pb = __shfl_xor(yb, 4);
                a[e] = hi ? (ya * cj[e] + pa * sj[e]) : (ya * cj[e] - pa * sj[e]);
                b[e] = hi ? (yb * cj[e] + pb * sj[e]) : (yb * cj[e] - pb * sj[e]);
            }
            *qp = pack8(a); if (lane < 8) *kp = pack8(b);
        }
    }
}

constexpr int KROW = 400, VROW = 288, KTILE = 64 * KROW, VTILE = 64 * VROW;
__device__ __forceinline__ void attn_unit(int tid, unsigned char* lds, const bf16_t* Q, const bf16_t* KV, const bf16_t* KR, bf16_t* O, int b, int h, int qb) {
    const int lane = tid & 63, w = __builtin_amdgcn_readfirstlane(tid >> 6), r = lane & 15, g = lane >> 4;
    const int row0 = b * SEQ + qb * 256, qrow = row0 + 32 * w + r;
    bf16x8 qf[2][6];
#pragma unroll
    for (int rg = 0; rg < 2; ++rg) {
#pragma unroll
        for (int ks = 0; ks < 4; ++ks) qf[rg][ks] = *(const bf16x8*)(Q + (size_t)(qrow + 16 * rg) * QP + h * 128 + 32 * ks + 8 * g);
#pragma unroll
        for (int ks = 0; ks < 2; ++ks) qf[rg][4 + ks] = *(const bf16x8*)(Q + (size_t)(qrow + 16 * rg) * QP + 1024 + h * 64 + 32 * ks + 8 * g);
    }
    const int ntiles = 4 * qb + 4, last_tile = 4 * qb + (w >> 1);
    const int kn_row0 = tid >> 4, kn_ch = tid & 15;
    const int kr_row = tid >> 3, kr_ch = tid & 7;
    const bf16_t* gk = KV + (size_t)(b * SEQ) * KVP + h * 256;
    const bf16_t* gr = KR + (size_t)(b * SEQ) * LATP;
    u32x4 sk0, sk1, sr, sv0, sv1;
#define ATT_LOAD(t) do { const size_t kb = (size_t)(t) * 64; \
        sk0 = *(const u32x4*)(gk + (kb + kn_row0) * KVP + kn_ch * 8); sk1 = *(const u32x4*)(gk + (kb + kn_row0 + 32) * KVP + kn_ch * 8); \
        sv0 = *(const u32x4*)(gk + (kb + kn_row0) * KVP + 128 + kn_ch * 8); sv1 = *(const u32x4*)(gk + (kb + kn_row0 + 32) * KVP + 128 + kn_ch * 8); \
        sr = *(const u32x4*)(gr + (kb + kr_row) * LATP + kr_ch * 8); } while (0)
#define ATT_STORE(buf) do { unsigned char* kb_ = lds + (buf) * KTILE; unsigned char* vb_ = lds + 2 * KTILE + (buf) * VTILE; \
        *(u32x4*)(kb_ + kn_row0 * KROW + kn_ch * 16) = sk0; *(u32x4*)(kb_ + (kn_row0 + 32) * KROW + kn_ch * 16) = sk1; \
        *(u32x4*)(kb_ + kr_row * KROW + 256 + kr_ch * 16) = sr; \
        *(u32x4*)(vb_ + kn_row0 * VROW + kn_ch * 16) = sv0; *(u32x4*)(vb_ + (kn_row0 + 32) * VROW + kn_ch * 16) = sv1; } while (0)
    f32x4 o[2][8];
#pragma unroll
    for (int rg = 0; rg < 2; ++rg)
#pragma unroll
        for (int i = 0; i < 8; ++i) o[rg][i] = (f32x4){0.f, 0.f, 0.f, 0.f};
    float m[2] = {-1e30f, -1e30f}, l[2] = {0.f, 0.f};
    ATT_LOAD(0); ATT_STORE(0);
    __syncthreads();
    const int q4 = r >> 2, p4 = lane & 3;
    const int vtr_off = (4 * g + q4) * VROW + (4 * p4) * 2;
    const int qidx = qb * 256 + 32 * w + r;
    for (int t = 0; t < ntiles; ++t) {
        const bool more = (t + 1 < ntiles);
        if (more) ATT_LOAD(t + 1);
        if (t <= last_tile) {
            const unsigned char* Kb = lds + (t & 1) * KTILE; const unsigned char* Vb = lds + 2 * KTILE + (t & 1) * VTILE;
            f32x4 p[2][4];
#pragma unroll
            for (int kb = 0; kb < 4; ++kb) {
                p[0][kb] = (f32x4){0.f, 0.f, 0.f, 0.f}; p[1][kb] = (f32x4){0.f, 0.f, 0.f, 0.f};
#pragma unroll
                for (int ks = 0; ks < 6; ++ks) {
                    const bf16x8 a = *(const bf16x8*)(Kb + (16 * kb + r) * KROW + ks * 64 + g * 16);
                    p[0][kb] = __builtin_amdgcn_mfma_f32_16x16x32_bf16(a, qf[0][ks], p[0][kb], 0, 0, 0);
                    p[1][kb] = __builtin_amdgcn_mfma_f32_16x16x32_bf16(a, qf[1][ks], p[1][kb], 0, 0, 0);
                }
            }
            const bool diag = (t * 64 + 63 > qb * 256 + 32 * w);
            bf16x8 pb[2][2];
#pragma unroll
            for (int rg = 0; rg < 2; ++rg) {
                if (diag) {
#pragma unroll
                    for (int kb = 0; kb < 4; ++kb)
#pragma unroll
                        for (int i = 0; i < 4; ++i) { const int kk = t * 64 + 16 * kb + 4 * g + i; if (kk > qidx + 16 * rg) p[rg][kb][i] = -1e30f; }
                }
                float mx = fmaxf(fmaxf(p[rg][0][0], p[rg][0][1]), fmaxf(p[rg][0][2], p[rg][0][3]));
#pragma unroll
                for (int kb = 1; kb < 4; ++kb) mx = fmaxf(mx, fmaxf(fmaxf(p[rg][kb][0], p[rg][kb][1]), fmaxf(p[rg][kb][2], p[rg][kb][3])));
                mx = fmaxf(mx, __shfl_xor(mx, 16)); mx = fmaxf(mx, __shfl_xor(mx, 32));
                if (!__all(mx <= m[rg] + 8.0f)) {
                    const float mn = fmaxf(m[rg], mx), alpha = fast_exp2(m[rg] - mn); m[rg] = mn;
                    l[rg] *= alpha;
#pragma unroll
                    for (int i = 0; i < 8; ++i) o[rg][i] *= alpha;
                }
                const float mref = m[rg];
                float rsum = 0.f;
#pragma unroll
                for (int kb = 0; kb < 4; ++kb)
#pragma unroll
                    for (int i = 0; i < 4; ++i) { p[rg][kb][i] = fast_exp2(p[rg][kb][i] - mref); rsum += p[rg][kb][i]; }
                l[rg] += rsum;
#pragma unroll
                for (int kk = 0; kk < 2; ++kk) {
                    u32x4 pw; pw.x = cvt_pk_bf16(p[rg][2 * kk][0], p[rg][2 * kk][1]); pw.y = cvt_pk_bf16(p[rg][2 * kk][2], p[rg][2 * kk][3]);
                    pw.z = cvt_pk_bf16(p[rg][2 * kk + 1][0], p[rg][2 * kk + 1][1]); pw.w = cvt_pk_bf16(p[rg][2 * kk + 1][2], p[rg][2 * kk + 1][3]);
                    pb[rg][kk] = __builtin_bit_cast(bf16x8, pw);
                }
            }
#pragma unroll
            for (int db = 0; db < 8; ++db)
#pragma unroll
                for (int kk = 0; kk < 2; ++kk) {
                    const LAS unsigned char* vp = (const LAS unsigned char*)(Vb + vtr_off + (32 * kk) * VROW + db * 32);
                    const s16x4 lo = __builtin_bit_cast(s16x4, __builtin_amdgcn_ds_read_tr16_b64_v4i16((LAS s16x4*)vp));
                    const s16x4 hi = __builtin_bit_cast(s16x4, __builtin_amdgcn_ds_read_tr16_b64_v4i16((LAS s16x4*)(vp + 16 * VROW)));
                    const bf16x8 vf = __builtin_shufflevector(lo, hi, 0, 1, 2, 3, 4, 5, 6, 7);
                    o[0][db] = __builtin_amdgcn_mfma_f32_16x16x32_bf16(vf, pb[0][kk], o[0][db], 0, 0, 0);
                    o[1][db] = __builtin_amdgcn_mfma_f32_16x16x32_bf16(vf, pb[1][kk], o[1][db], 0, 0, 0);
                }
        }
        if (more) ATT_STORE((t + 1) & 1);
        __syncthreads();
    }
#pragma unroll
    for (int rg = 0; rg < 2; ++rg) {
        float ls = l[rg]; ls += __shfl_xor(ls, 16); ls += __shfl_xor(ls, 32);
        const float inv = fast_rcp(ls);
        bf16_t* orow = O + (size_t)(qrow + 16 * rg) * QP + h * 128 + 4 * g;
#pragma unroll
        for (int db = 0; db < 8; ++db) {
            u32x2 wv; wv.x = cvt_pk_bf16(o[rg][db][0] * inv, o[rg][db][1] * inv); wv.y = cvt_pk_bf16(o[rg][db][2] * inv, o[rg][db][3] * inv);
            *(u32x2*)(orow + 16 * db) = wv;
        }
    }
#undef ATT_LOAD
#undef ATT_STORE
}
__device__ __forceinline__ void attn_phase(int tid, const Params& P, unsigned char* lds) {
    bf16_t* Q = (bf16_t*)(P.ws + OFF_FF + FF_Q); const bf16_t* KV = (const bf16_t*)(P.ws + OFF_FF + FF_KV); const bf16_t* KR = (const bf16_t*)(P.ws + OFF_FF + FF_LAT) + 640;
    const int nwg8 = (gridDim.x % 8 == 0) ? gridDim.x / 8 : 0;
    for (int it = 0;; ++it) {
        int pr;
        if (nwg8) { const int idx = (int)(blockIdx.x >> 3) + it * nwg8; if (idx >= 64) break; pr = (int)(blockIdx.x & 7) * 64 + idx; }
        else { pr = blockIdx.x + it * gridDim.x; if (pr >= 512) break; }
        const int bh = pr >> 2, x = pr & 3, b = bh >> 3, h = bh & 7;
        attn_unit(tid, lds, Q, KV, KR, Q, b, h, 7 - x);
        attn_unit(tid, lds, Q, KV, KR, Q, b, h, x);
    }
}

constexpr int SROW = 576;
constexpr int SGU_STAT_OFF = 128 * SROW;
constexpr int SGU_W_OFF = SGU_STAT_OFF + 2048, SWROW = 272;
__device__ __forceinline__ void sgu_phase(int tid, const Params& P, unsigned char* lds, int j) {
    const int lane = tid & 63, w = __builtin_amdgcn_readfirstlane(tid >> 6), r = lane & 31, hh = lane >> 5;
    bf16_t* Z = (bf16_t*)(P.ws + OFF_FF);
    const float* lng = P.in[17] + j * 2048; const float* lnb = P.in[18] + j * 2048;
    const float* wsp = P.in[19] + (size_t)j * 8 * 128 * 128; const float* bsp = P.in[20] + j * 8 * 128;
    const int q4 = (lane & 15) >> 2, p4 = lane & 3, colblk = (lane >> 4) & 1;
    f32x2* stl = (f32x2*)(lds + SGU_STAT_OFF);
    for (int unit = blockIdx.x; unit < 256; unit += gridDim.x) {
        const int row0 = unit * 128;
        for (int rr0 = 0; rr0 < 16; rr0 += 4) {
            u32x4 raw[4][4];
#pragma unroll
            for (int a = 0; a < 4; ++a)
#pragma unroll
                for (int i = 0; i < 4; ++i) raw[a][i] = *(const u32x4*)(Z + (size_t)(row0 + 16 * w + rr0 + a) * ZP + 2048 + 8 * lane + 512 * i);
#pragma unroll
            for (int a = 0; a < 4; ++a) {
                float s1 = 0.f, s2 = 0.f;
#pragma unroll
                for (int i = 0; i < 4; ++i) { float v[8]; unpack8(raw[a][i], v);
#pragma unroll
                    for (int e = 0; e < 8; ++e) { s1 += v[e]; s2 += v[e] * v[e]; } }
                s1 = wave_sum(s1); s2 = wave_sum(s2);
                const float mu = s1 * (1.0f / 2048), var = s2 * (1.0f / 2048) - mu * mu;
                if (lane == 0) stl[16 * w + rr0 + a] = (f32x2){mu, rsqrtf(fmaxf(var, 0.f) + EPS)};
            }
        }
        __syncthreads();
        for (int g = 0; g < 8; ++g) {
#pragma unroll 2
            for (int i = 0; i < 8; ++i) {
                const int chunk = tid + 512 * i, row = chunk >> 5, ch = chunk & 31, col = g * 256 + ch * 8;
                float v[8]; unpack8(*(const u32x4*)(Z + (size_t)(row0 + row) * ZP + 2048 + col), v);
                const f32x2 st = stl[row]; const float mu = st.x, rstd = st.y;
                const f32x4 g0 = *(const f32x4*)(lng + col), g1 = *(const f32x4*)(lng + col + 4), b0 = *(const f32x4*)(lnb + col), b1 = *(const f32x4*)(lnb + col + 4);
#pragma unroll
                for (int e = 0; e < 4; ++e) { v[e] = (v[e] - mu) * rstd * g0[e] + b0[e]; v[4 + e] = (v[4 + e] - mu) * rstd * g1[e] + b1[e]; }
                *(u32x4*)(lds + row * SROW + ch * 16) = pack8(v);
            }
            {
                const float* wg = wsp + (size_t)g * 128 * 128;
                f32x4 w0[4], w1[4];
#pragma unroll
                for (int i = 0; i < 4; ++i) { const int c = tid + 512 * i, t = c >> 4, s0 = (c & 15) * 8; w0[i] = *(const f32x4*)(wg + t * 128 + s0); w1[i] = *(const f32x4*)(wg + t * 128 + s0 + 4); }
#pragma unroll
                for (int i = 0; i < 4; ++i) { const int c = tid + 512 * i, t = c >> 4, s0 = (c & 15) * 8;
                    float wv[8] = {w0[i][0], w0[i][1], w0[i][2], w0[i][3], w1[i][0], w1[i][1], w1[i][2], w1[i][3]};
#pragma unroll
                    for (int e = 0; e < 8; ++e) if (s0 + e > t) wv[e] = 0.f;
                    *(u32x4*)(lds + SGU_W_OFF + t * SWROW + s0 * 2) = pack8(wv); }
            }
            __syncthreads();
            bf16x8 af[8];
#pragma unroll
            for (int ks = 0; ks < 8; ++ks) {
                const LAS unsigned char* vp = (const LAS unsigned char*)(lds + (16 * ks + 8 * hh + q4) * SROW + (32 * w + 16 * colblk + 4 * p4) * 2);
                const s16x4 lo = __builtin_bit_cast(s16x4, __builtin_amdgcn_ds_read_tr16_b64_v4i16((LAS s16x4*)vp));
                const s16x4 hi = __builtin_bit_cast(s16x4, __builtin_amdgcn_ds_read_tr16_b64_v4i16((LAS s16x4*)(vp + 4 * SROW)));
                af[ks] = __builtin_shufflevector(lo, hi, 0, 1, 2, 3, 4, 5, 6, 7);
            }
#pragma unroll
            for (int tb = 0; tb < 4; ++tb) {
                f32x16 acc;
#pragma unroll
                for (int e = 0; e < 16; ++e) acc[e] = 0.f;
                const int t = 32 * tb + r;
#pragma unroll
                for (int ks = 0; ks < 8; ++ks) {
                    if (ks <= 2 * tb + 1) {
                        const bf16x8 bfr = *(const bf16x8*)(lds + SGU_W_OFF + t * SWROW + (16 * ks + 8 * hh) * 2);
                        acc = __builtin_amdgcn_mfma_f32_32x32x16_bf16(af[ks], bfr, acc, 0, 0, 0);
                    }
                }
                const float bias = bsp[g * 128 + t];
                bf16_t* up = Z + (size_t)(row0 + t) * ZP + g * 256 + 32 * w + 4 * hh;
#pragma unroll
                for (int i4 = 0; i4 < 4; ++i4) {
                    const u32x2 uu = *(const u32x2*)(up + 8 * i4);
                    u32x2 y; y.x = cvt_pk_bf16(bflo(uu.x) * (acc[4 * i4] + bias), bfhi(uu.x) * (acc[4 * i4 + 1] + bias));
                    y.y = cvt_pk_bf16(bflo(uu.y) * (acc[4 * i4 + 2] + bias), bfhi(uu.y) * (acc[4 * i4 + 3] + bias));
                    *(u32x2*)(up + 8 * i4) = y;
                }
            }
            __syncthreads();
        }
    }
}


#define XB_TMO      128
#define XB_XCNT(j)  (256  + 64 * (j))
#define XB_XSUB(j)  (1280 + 64 * (j))
#define XB_XGEN(j)  (2304 + 64 * (j))
#define XB_TOP      3328
#define XB_TOPGEN   3392
#define XB_SPIN_CAP (1u << 22)
__device__ __forceinline__ unsigned xb_ld(unsigned* p)              { return __hip_atomic_load(p, __ATOMIC_RELAXED, __HIP_MEMORY_SCOPE_AGENT); }
__device__ __forceinline__ unsigned xb_add(unsigned* p, unsigned v) { return __hip_atomic_fetch_add(p, v, __ATOMIC_RELAXED, __HIP_MEMORY_SCOPE_AGENT); }
__device__ __forceinline__ unsigned xb_xcc_id() { return (unsigned)__builtin_amdgcn_s_getreg((3 << 11) | 20) & 0xFu; }
#define XB_SPIN(cond, bar) do { unsigned _sp = 0; while (cond) { __builtin_amdgcn_s_sleep(1); \
    if ((++_sp & 255u) == 0u) { if (xb_ld(&(bar)[XB_TMO])) break; if (_sp > XB_SPIN_CAP) { atomicAdd(&(bar)[XB_TMO], 1u); break; } } } } while (0)
__device__ __forceinline__ void xcd_barrier_complete(unsigned* bar, unsigned x, unsigned& nloc, unsigned& nx) {
    const unsigned G = gridDim.x;
    unsigned sum, cnt, mine, sp = 0u;
    for (;;) {
        sum = 0u; cnt = 0u; mine = 0u;
#pragma unroll
        for (unsigned j = 0; j < 16; ++j) { const unsigned c = xb_ld(&bar[XB_XCNT(j)]); sum += c; cnt += (c > 0u) ? 1u : 0u; mine = (j == x) ? c : mine; }
        if (sum == G) break;
        __builtin_amdgcn_s_sleep(1);
        if ((++sp & 255u) == 0u) { if (xb_ld(&bar[XB_TMO])) break; if (sp > XB_SPIN_CAP) { atomicAdd(&bar[XB_TMO], 1u); break; } }
    }
    nloc = mine > 0u ? mine : 1u; nx = cnt > 0u ? cnt : 1u;
}
__device__ __forceinline__ void xcd_barrier(unsigned* bar, unsigned x, volatile LAS unsigned* st) {
    asm volatile("s_waitcnt vmcnt(0)" ::: "memory");
    __syncthreads();
    if (threadIdx.x == 0) {
        __builtin_amdgcn_s_waitcnt(0);
        unsigned nloc = st[0], nx = st[1];
        if (nloc == 0u) { xcd_barrier_complete(bar, x, nloc, nx); st[0] = nloc; st[1] = nx; }
        const unsigned old = xb_add(&bar[XB_XSUB(x)], 1u);
        const unsigned gen = old / nloc;
        if (old + 1u == (gen + 1u) * nloc) {
            __builtin_amdgcn_fence(__ATOMIC_RELEASE, "agent");
            asm volatile("s_waitcnt vmcnt(0)" ::: "memory");
            const unsigned og = xb_add(&bar[XB_TOP], 1u);
            const unsigned tg = og / nx;
            if (og + 1u == (tg + 1u) * nx) xb_add(&bar[XB_TOPGEN], 1u);
            else XB_SPIN(xb_ld(&bar[XB_TOPGEN]) == tg, bar);
            __builtin_amdgcn_fence(__ATOMIC_ACQUIRE, "agent");
            xb_add(&bar[XB_XGEN(x)], 1u);
            asm volatile("s_waitcnt vmcnt(0)" ::: "memory");
        } else {
            XB_SPIN(xb_ld(&bar[XB_XGEN(x)]) == gen, bar);
            __builtin_amdgcn_fence(__ATOMIC_ACQUIRE, "agent");
            asm volatile("s_waitcnt vmcnt(0)" ::: "memory");
        }
    }
    __syncthreads();
}

constexpr int NPHASE = 1 + 9 * DEPTH;
__device__ __forceinline__ int mktid(int wv0) { int t; asm volatile("v_mbcnt_lo_u32_b32 %0, -1, 0\n\tv_mbcnt_hi_u32_b32 %0, -1, %0" : "=v"(t)); return (t + wv0 * 64) & 511; }
__device__ __forceinline__ Params load_params() {
    Params P{};
#if defined(__HIP_DEVICE_COMPILE__)
    typedef const __attribute__((address_space(4))) unsigned long long* kp_t;
    kp_t kp = (kp_t)__builtin_amdgcn_kernarg_segment_ptr(); asm volatile("" : "+s"(kp));
#pragma unroll
    for (int i = 0; i < 26; ++i) P.in[i] = (const float*)kp[i];
    P.out = (float*)kp[26]; P.ws = (unsigned char*)kp[27];
#endif
    return P;
}
__host__ __device__ __forceinline__ bool phase_nonempty(int ph) {
    if (ph == 0) return true;
    const int layer = (ph - 1) / 9, slot = (ph - 1) % 9;
    if ((layer & 1) && (slot == 3 || slot == 4)) return false;
    return true;
}

__global__ void __launch_bounds__(512) fwd_megakernel(Params Parg) {
    extern __shared__ __attribute__((aligned(16))) unsigned char lds[];
    LAS unsigned char* ldsl = (LAS unsigned char*)lds;
    const int wv0 = __builtin_amdgcn_readfirstlane((int)threadIdx.x >> 6);
    volatile LAS unsigned* bst = (volatile LAS unsigned*)(ldsl + 133120);
    if (threadIdx.x == 0) { bst[0] = 0u; bst[1] = 0u; }
    __syncthreads();
    unsigned* const bar = (unsigned*)(Parg.ws + OFF_BAR);
    const unsigned xcc = xb_xcc_id();
    int nseam = 0;
    bool first = true;
    for (int ph = Parg.ph_lo; ph < Parg.ph_hi; ++ph) {
        if (!phase_nonempty(ph)) continue;
        if (!first && !(ph > 0 && (ph - 1) % 9 == 8)) {
            if (nseam == 0) { cg::this_grid().sync(); if (threadIdx.x == 0) (void)xb_add(&bar[XB_XCNT(xcc)], 1u); }
            else xcd_barrier(bar, xcc, bst);
            ++nseam;
        }
        first = false;
        const Params P = load_params();
        unsigned char* ws = P.ws;
        bf16_t* wb = (bf16_t*)(ws + OFF_W);
        bf16_t* hb = (bf16_t*)(ws + OFF_HB);
        float* SS = (float*)(ws + OFF_SS);
        const int G = gridDim.x, c = blockIdx.x;
        if (ph == 0) { p0_prologue(mktid(wv0), P, lds); continue; }
        const int layer = (ph - 1) / 9, slot = (ph - 1) % 9, j = layer >> 1;
        const bool mla = (layer & 1) == 0;
        float* ss_mix = SS; float* ss_ffn = SS; float* ss_ple = SS;
        float* ss_next = (layer + 1 < DEPTH) ? SS : nullptr;
        const float* hin = (layer == 0) ? P.in[0] : nullptr;
        pg8::StaticOrder S;
        if (slot == 0) {
            if (mla) {
                pg8::Gemm g{hb, wb + WE_DOWN + (size_t)j * LATP * DM, T, LATP, DM, DM}; S.init(T, LATP, G, c);
                pg8::EpiStore<0, 1> E{(bf16_t*)(ws + OFF_FF + FF_LAT), LATP, ss_mix, 1.0f / DM, 16, 0, 16, P.out};
                pg8::gemm_phase(mktid(wv0), ldsl, g, S, E);
            } else {
                pg8::Gemm g{hb, wb + WE_GIN + (size_t)j * ZP * DM, T, ZP, DM, DM}; S.init(T, ZP, G, c);
                pg8::EpiStore<2, 0> E{(bf16_t*)(ws + OFF_FF), ZP, ss_mix, 1.0f / DM, 16, 0, 16, nullptr};
                pg8::gemm_phase(mktid(wv0), ldsl, g, S, E);
            }
        } else if (slot == 1) {
            if (mla) {
                { pg8::Gemm g{(const bf16_t*)(ws + OFF_FF + FF_LAT), wb + WE_UQ + (size_t)j * QP * QLR, T, QP, QLR, LATP}; S.init(T, QP, G, c);
                  pg8::EpiStore<0, 0> E{(bf16_t*)(ws + OFF_FF + FF_Q), QP, P.out, 1.0f / QLR, 24, 0, 12, nullptr};
                  pg8::gemm_phase(mktid(wv0), ldsl, g, S, E); }
                { pg8::Gemm g{(const bf16_t*)(ws + OFF_FF + FF_LAT) + QLR, wb + WE_UKV + (size_t)j * KVP * KVLR, T, KVP, KVLR, LATP}; S.init(T, KVP, G, c);
                  pg8::EpiStore<0, 0> E{(bf16_t*)(ws + OFF_FF + FF_KV), KVP, P.out, 1.0f / KVLR, 24, 12, 20, nullptr};
                  pg8::gemm_phase(mktid(wv0), ldsl, g, S, E); }
            } else {
                sgu_phase(mktid(wv0), P, lds, j);
            }
        } else if (slot == 2) {
            if (mla) {
                r2_phase(mktid(wv0), P, j);
            } else {
                pg8::Gemm g{(const bf16_t*)(ws + OFF_FF), wb + WE_GOUT + (size_t)j * DM * 2048, T, DM, 2048, ZP}; S.init(T, DM, G, c);
                pg8::EpiRes<0> E{hin, nullptr, hb, ss_ffn, nullptr};
                pg8::gemm_phase(mktid(wv0), ldsl, g, S, E);
            }
        } else if (slot == 3) {
            attn_phase(mktid(wv0), P, lds);
        } else if (slot == 4) {
            pg8::Gemm g{(const bf16_t*)(ws + OFF_FF + FF_Q), wb + WE_MOUT + (size_t)j * DM * DM, T, DM, DM, QP}; S.init(T, DM, G, c);
            pg8::EpiRes<0> E{hin, nullptr, hb, ss_ffn, nullptr};
            pg8::gemm_phase(mktid(wv0), ldsl, g, S, E);
        } else if (slot == 5) {
            pg8::Gemm g{hb, wb + WE_UP + (size_t)layer * DFF * DM, T, DFF, DM, DM}; S.init(T, DFF, G, c);
            pg8::EpiStore<1, 0> E{(bf16_t*)(ws + OFF_FF), DFF, ss_ffn, 1.0f / DM, 16, 0, 16, nullptr};
            pg8::gemm_phase(mktid(wv0), ldsl, g, S, E);
        } else if (slot == 6) {
            pg8::Gemm g{(const bf16_t*)(ws + OFF_FF), wb + WE_DN + (size_t)layer * DM * DFF, T, DM, DFF, DFF}; S.init(T, DM, G, c);
            pg8::EpiRes<0> E{nullptr, nullptr, hb, ss_ple, nullptr};
            pg8::gemm_phase(mktid(wv0), ldsl, g, S, E);
        } else if (slot == 7) {
            pg8::Gemm g{hb, wb + WE_GATE + (size_t)layer * DM * DM, T, DM, DM, DM, (unsigned*)(ws + OFF_PCNT) + (size_t)layer * 128 * 16, nullptr}; S.init(T, DM, G, c);
            pg8::EpiStore<3, 0> E{(bf16_t*)(ws + OFF_FF), DM, ss_ple, 1.0f / DM, 16, 0, 16, nullptr};
            pg8::gemm_phase(mktid(wv0), ldsl, g, S, E);
        } else {
            pg8::Gemm g{(const bf16_t*)(ws + OFF_PB) + (size_t)layer * T * PLE, wb + WE_PROJ + (size_t)layer * DM * PLE, T, DM, PLE, PLE, nullptr, (unsigned*)(ws + OFF_PCNT) + (size_t)layer * 128 * 16}; S.init(T, DM, G, c);
            pg8::EpiRes<1> E{nullptr, (layer == DEPTH - 1) ? P.out : nullptr, hb, ss_next, (const bf16_t*)(ws + OFF_FF)};
            pg8::gemm_phase(mktid(wv0), ldsl, g, S, E);
        }
    }
    asm volatile("s_waitcnt vmcnt(0)" ::: "memory");
    __builtin_amdgcn_fence(__ATOMIC_RELEASE, "agent");
    asm volatile("s_waitcnt vmcnt(0)" ::: "memory");
}


constexpr int LDS_BYTES = 131072 + 2048 + 256;
extern "C" void kernel_launch(void* const* d_in, const int* in_sizes, int n_in, void* d_out, int out_size, void* d_ws, size_t ws_size, hipStream_t stream) {
    static int grid = 0;
    if (grid == 0) {
        if (n_in != 26 || out_size != T * DM || ws_size < WS_NEED) { fprintf(stderr, "kernel_launch: unexpected problem (n_in %d out %d ws %zu)\n", n_in, out_size, ws_size); grid = -1; return; }
        int dev = 0, cus = 0, per_cu = 0;
        hipGetDevice(&dev); hipDeviceGetAttribute(&cus, hipDeviceAttributeMultiprocessorCount, dev);
        hipFuncSetAttribute((const void*)fwd_megakernel, hipFuncAttributeMaxDynamicSharedMemorySize, LDS_BYTES);
        hipOccupancyMaxActiveBlocksPerMultiprocessor(&per_cu, (const void*)fwd_megakernel, 512, LDS_BYTES);
        if (per_cu < 1) { fprintf(stderr, "kernel_launch: occupancy query says %d blocks/CU\n", per_cu); per_cu = 1; }
        (void)hipGetLastError();
        grid = cus;
    }
    if (grid < 0) return;
    Params p{};
    for (int i = 0; i < 26; ++i) p.in[i] = (const float*)d_in[i];
    p.out = (float*)d_out; p.ws = (unsigned char*)d_ws;
#if ONE_LAUNCH
    p.ph_lo = 0; p.ph_hi = NPHASE;
    { void* args[] = {&p}; hipError_t e = hipLaunchCooperativeKernel((const void*)fwd_megakernel, dim3(grid), dim3(512), args, LDS_BYTES, stream);
      if (e != hipSuccess) fprintf(stderr, "cooperative launch failed: %s (grid %d)\n", hipGetErrorString(e), grid); }
#else
    for (int ph = 0; ph < NPHASE; ++ph) {
        if (!phase_nonempty(ph)) continue;
        p.ph_lo = ph; p.ph_hi = ph + 1;
        void* args[] = {&p}; hipError_t e = hipLaunchCooperativeKernel((const void*)fwd_megakernel, dim3(grid), dim3(512), args, LDS_BYTES, stream);
        if (e != hipSuccess) { fprintf(stderr, "cooperative launch failed: %s (grid %d, phase %d)\n", hipGetErrorString(e), grid, ph); break; }
    }
#endif
}
```
